# Optimizing an MI355X kernel written in HIP

```python
import jax
import jax.numpy as jnp
from jax import lax
import numpy as np

D_MODEL = 1024
BATCH = 16
SEQ = 4096
DEPTH = 1

D_FF = 2816
MACARON_WEIGHT = 0.5
NORM_EPS = 1e-6
CONV_WIDTH = 4
MLSTM_HEADS = 4
MLSTM_HEAD_DIM = 128
MLSTM_WIDTH = MLSTM_HEADS * MLSTM_HEAD_DIM
MLSTM_CHUNK = 64
NSA_HEADS = 8
NSA_KV_GROUPS = 2
NSA_HEADS_PER_GROUP = NSA_HEADS // NSA_KV_GROUPS
NSA_HEAD_DIM = 64
NSA_WIDTH = NSA_HEADS * NSA_HEAD_DIM
NSA_KV_WIDTH = NSA_KV_GROUPS * NSA_HEAD_DIM
CMP_BLOCK = 32
CMP_STRIDE = 16
CMP_HIDDEN = 256
SEL_BLOCK = 64
N_SELECT = 16
WINDOW = 256
NSA_QUERY_BLOCK = 32
FORCE_SCORE = 1e4
NEG_BIG = -1e30
IN_SPLITS = (MLSTM_WIDTH, MLSTM_WIDTH, MLSTM_WIDTH, MLSTM_WIDTH, 2 * MLSTM_HEADS,
             NSA_WIDTH, NSA_KV_WIDTH, NSA_KV_WIDTH, NSA_KV_WIDTH, NSA_KV_WIDTH, NSA_KV_WIDTH, NSA_KV_WIDTH,
             3 * NSA_HEADS, D_MODEL, D_MODEL)
D_IN = sum(IN_SPLITS)

kernel_name = "hybrid_mlstm_nsa_macaron_block"


def rmsnorm(x, gain):
    x32 = x.astype(jnp.float32)
    y = x32 * lax.rsqrt(jnp.mean(x32 * x32, axis=-1, keepdims=True) + NORM_EPS)
    return (y * gain.astype(jnp.float32)).astype(x.dtype)


def swiglu(u, wg, wu, wd):
    return (jax.nn.silu(u @ wg) * (u @ wu)) @ wd


def sandwich(h, fn, ada, s, g_pre, g_post, resid):
    shift, scale, gate = ada[:, s, 0, None, :], ada[:, s, 1, None, :], ada[:, s, 2, None, :]
    u = rmsnorm(h, g_pre) * (1 + scale) + shift
    return h + resid * gate * rmsnorm(fn(u), g_post)


def causal_depthwise_conv(x, w, b):
    y = lax.conv_general_dilated(x, w, window_strides=(1,), padding=[(CONV_WIDTH - 1, 0)],
                                 dimension_numbers=('NWC', 'WIO', 'NWC'),
                                 feature_group_count=x.shape[-1])
    return y + b


def masked_softmax(s, mask):
    s = jnp.where(mask, s.astype(jnp.float32), NEG_BIG)
    m = jnp.max(s, axis=-1, keepdims=True)
    e = jnp.where(mask, jnp.exp(s - m), 0.0)
    return e / jnp.maximum(jnp.sum(e, axis=-1, keepdims=True), 1e-30)


def mlstm_chunkwise(q, k, v, ig, logf):
    B, H, S, dh = q.shape
    L = MLSTM_CHUNK
    nc = S // L

    def chunks(t):
        return jnp.moveaxis(t.reshape(t.shape[:2] + (nc, L) + t.shape[3:]), 2, 0)

    causal = jnp.tril(jnp.ones((L, L), dtype=bool))

    def step(carry, xs):
        C, n, m = carry
        qc, kc, vc, ic, fc = xs
        b = jnp.cumsum(fc, axis=-1)
        log_d = jnp.where(causal, b[..., :, None] - b[..., None, :] + ic[..., None, :], -jnp.inf)
        a = b + m[..., None]
        m_t = jnp.maximum(a, jnp.max(log_d, axis=-1))
        s = jnp.einsum('bhtd,bhsd->bhts', qc, kc) * jnp.exp(log_d - m_t[..., None])
        w_inter = jnp.exp(a - m_t)
        num = jnp.einsum('bhts,bhsd->bhtd', s, vc) + w_inter[..., None] * jnp.einsum('bhtd,bhde->bhte', qc, C)
        den = jnp.sum(s, axis=-1) + w_inter * jnp.einsum('bhtd,bhd->bht', qc, n)
        h = num / jnp.maximum(jnp.abs(den), jnp.exp(-m_t))[..., None]
        b_last = b[..., -1]
        g = b_last[..., None] - b + ic
        m_new = jnp.maximum(b_last + m, jnp.max(g, axis=-1))
        decay = jnp.exp(b_last + m - m_new)
        w = jnp.exp(g - m_new[..., None])
        C_new = decay[..., None, None] * C + jnp.einsum('bhs,bhsd,bhse->bhde', w, kc, vc)
        n_new = decay[..., None] * n + jnp.einsum('bhs,bhsd->bhd', w, kc)
        return (C_new, n_new, m_new), h

    init = (jnp.zeros((B, H, dh, dh), jnp.float32), jnp.zeros((B, H, dh), jnp.float32),
            jnp.zeros((B, H), jnp.float32))
    _, hs = lax.scan(step, init, (chunks(q), chunks(k), chunks(v), chunks(ig), chunks(logf)))
    return jnp.moveaxis(hs, 0, 2).reshape(B, H, S, dh)


def mlstm_mixer(q, k, v, o_pre, if_pre, conv_w, conv_b, gate_b, head_gain):
    B, S, _ = q.shape
    qk = jax.nn.silu(causal_depthwise_conv(jnp.concatenate([q, k], axis=-1), conv_w, conv_b))
    q, k = jnp.split(qk, 2, axis=-1)

    def heads(t):
        return t.reshape(B, S, MLSTM_HEADS, MLSTM_HEAD_DIM).transpose(0, 2, 1, 3).astype(jnp.float32)

    gates = (if_pre + gate_b).astype(jnp.float32)
    ig = gates[..., :MLSTM_HEADS].transpose(0, 2, 1)
    logf = jax.nn.log_sigmoid(gates[..., MLSTM_HEADS:]).transpose(0, 2, 1)
    h = mlstm_chunkwise(heads(q), heads(k) * (MLSTM_HEAD_DIM ** -0.5), heads(v), ig, logf)
    h = h.transpose(0, 2, 1, 3)
    h = h * lax.rsqrt(jnp.mean(h * h, axis=-1, keepdims=True) + NORM_EPS)
    h = h.reshape(B, S, MLSTM_WIDTH) * head_gain.astype(jnp.float32)
    return (jax.nn.sigmoid(o_pre.astype(jnp.float32)) * h).astype(q.dtype)


def compress(k, pe, w1, b1, w2, b2):
    B, S, G, dh = k.shape
    r = CMP_BLOCK // CMP_STRIDE
    nch = S // CMP_STRIDE
    ch = k.reshape(B, nch, CMP_STRIDE, G, dh)
    blocks = jnp.concatenate([ch[:, j:nch - r + 1 + j] for j in range(r)], axis=2)
    blocks = blocks + pe[:, None, :]
    n_cmp = blocks.shape[1]
    flat = blocks.transpose(0, 1, 3, 2, 4).reshape(B, n_cmp, G, CMP_BLOCK * dh)
    hid = jax.nn.silu(flat @ w1 + b1)
    return (hid @ w2 + b2).transpose(0, 2, 1, 3)


def nsa_mixer(q, kc, vc, ks, vs, kw, vw, g, cmp_pe, cmp_w1, cmp_b1, cmp_w2, cmp_b2):
    B, S, _ = q.shape
    G, HG, dh, QB = NSA_KV_GROUPS, NSA_HEADS_PER_GROUP, NSA_HEAD_DIM, NSA_QUERY_BLOCK
    qh = q.reshape(B, S, G, HG, dh).transpose(0, 2, 3, 1, 4) * (dh ** -0.5)
    gates = jax.nn.sigmoid(g.astype(jnp.float32)).reshape(B, S, G, HG, 3).transpose(0, 2, 3, 1, 4)

    def kv(t):
        return t.reshape(B, S, G, dh)

    k_cmp = compress(kv(kc), cmp_pe[0], cmp_w1[0], cmp_b1[0], cmp_w2[0], cmp_b2[0])
    v_cmp = compress(kv(vc), cmp_pe[1], cmp_w1[1], cmp_b1[1], cmp_w2[1], cmp_b2[1])
    n_cmp = k_cmp.shape[2]
    cmp_start = jnp.arange(n_cmp) * CMP_STRIDE
    cmp_end = cmp_start + CMP_BLOCK - 1
    n_sel = S // SEL_BLOCK
    n_top = min(N_SELECT, n_sel)
    sel_start = jnp.arange(n_sel) * SEL_BLOCK
    overlap = ((cmp_start[:, None] < sel_start[None, :] + SEL_BLOCK)
               & (cmp_start[:, None] + CMP_BLOCK > sel_start[None, :])).astype(jnp.float32)

    def sel_blocks(t):
        return kv(t).reshape(B, n_sel, SEL_BLOCK, G, dh).transpose(0, 3, 1, 2, 4)

    k_sel, v_sel = sel_blocks(ks), sel_blocks(vs)

    def win_pad(t):
        return jnp.pad(kv(t).transpose(0, 2, 1, 3), ((0, 0), (0, 0), (WINDOW, 0), (0, 0)))

    k_win, v_win = win_pad(kw), win_pad(vw)
    b_idx = jnp.arange(B)[:, None, None, None]
    g_idx = jnp.arange(G)[None, :, None, None]
    sel_offsets = jnp.arange(SEL_BLOCK)
    win_offsets = jnp.arange(WINDOW + QB)
    blk = jnp.arange(n_sel)

    def query_block(qi):
        q0 = qi * QB
        t = q0 + jnp.arange(QB)
        qb = lax.dynamic_slice_in_dim(qh, q0, QB, axis=3)
        gb = lax.dynamic_slice_in_dim(gates, q0, QB, axis=3)
        p_cmp = masked_softmax(jnp.einsum('bghqd,bgnd->bghqn', qb, k_cmp), cmp_end[None, :] <= t[:, None])
        o_cmp = jnp.einsum('bghqn,bgnd->bghqd', p_cmp, v_cmp)
        imp = jnp.einsum('bghqn,nj->bgqj', p_cmp, overlap)
        cur = t // SEL_BLOCK
        forced = (blk[None, :] == 0) | (blk[None, :] == cur[:, None]) | (blk[None, :] == cur[:, None] - 1)
        causal_blk = blk[None, :] * SEL_BLOCK <= t[:, None]
        imp = jnp.where(causal_blk, jnp.where(forced, FORCE_SCORE, imp), -1.0)
        _, idx = lax.top_k(imp, n_top)
        k_g = k_sel[b_idx, g_idx, idx].reshape(B, G, QB, n_top * SEL_BLOCK, dh)
        v_g = v_sel[b_idx, g_idx, idx].reshape(B, G, QB, n_top * SEL_BLOCK, dh)
        pos = (idx[..., None] * SEL_BLOCK + sel_offsets).reshape(B, G, QB, n_top * SEL_BLOCK)
        p_sel = masked_softmax(jnp.einsum('bghqd,bgqnd->bghqn', qb, k_g), (pos <= t[:, None])[:, :, None])
        o_sel = jnp.einsum('bghqn,bgqnd->bghqd', p_sel, v_g)
        k_w = lax.dynamic_slice_in_dim(k_win, q0, WINDOW + QB, axis=2)
        v_w = lax.dynamic_slice_in_dim(v_win, q0, WINDOW + QB, axis=2)
        pos_w = q0 - WINDOW + win_offsets
        mask_w = (pos_w[None, :] >= 0) & (pos_w[None, :] <= t[:, None]) & (pos_w[None, :] > t[:, None] - WINDOW)
        p_w = masked_softmax(jnp.einsum('bghqd,bgnd->bghqn', qb, k_w), mask_w)
        o_w = jnp.einsum('bghqn,bgnd->bghqd', p_w, v_w)
        return gb[..., 0:1] * o_cmp + gb[..., 1:2] * o_sel + gb[..., 2:3] * o_w

    out = lax.map(query_block, jnp.arange(S // QB))
    return out.transpose(1, 0, 4, 2, 3, 5).reshape(B, S, NSA_WIDTH)


def token_mixer(u, w_in, conv_w, conv_b, gate_b, head_gain, cmp_pe, cmp_w1, cmp_b1, cmp_w2, cmp_b2,
                w_up_m, w_up_n, w_out):
    proj = u @ w_in
    offsets = [int(o) for o in np.cumsum(IN_SPLITS)[:-1]]
    (q_m, k_m, v_m, o_m, if_m, q_n, kc, vc, ks, vs, kw, vw, g_n, gate_m, gate_n) = jnp.split(proj, offsets, axis=-1)
    y_m = mlstm_mixer(q_m, k_m, v_m, o_m, if_m, conv_w, conv_b, gate_b, head_gain) @ w_up_m
    y_n = nsa_mixer(q_n, kc, vc, ks, vs, kw, vw, g_n, cmp_pe, cmp_w1, cmp_b1, cmp_w2, cmp_b2).astype(u.dtype) @ w_up_n
    merged = jax.nn.sigmoid(gate_m) * y_m + jax.nn.sigmoid(gate_n) * y_n
    return merged @ w_out


def setup_inputs(seed: int = 0) -> dict:
    key = jax.random.key(seed)
    ks = jax.random.split(key, 24)

    def nrm(k, shape, scale):
        return jax.random.normal(k, shape, jnp.float32) * scale

    L, D, F = DEPTH, D_MODEL, D_FF
    gate_b = jnp.concatenate([nrm(ks[10], (L, MLSTM_HEADS), 0.1),
                              jnp.linspace(3.0, 6.0, MLSTM_HEADS)[None, :] + nrm(ks[11], (L, MLSTM_HEADS), 0.1)], axis=-1)
    return {
        "x": nrm(ks[0], (BATCH, SEQ, D), 1.0),
        "c": nrm(ks[1], (BATCH, D), 1.0),
        "w_ada": nrm(ks[2], (L, D, 9 * D), D ** -0.5),
        "b_ada": nrm(ks[3], (L, 9 * D), 0.02),
        "norm_gains": 1.0 + nrm(ks[4], (L, 6, D), 0.05),
        "ffn_wg": nrm(ks[5], (L, 2, D, F), D ** -0.5),
        "ffn_wu": nrm(ks[6], (L, 2, D, F), D ** -0.5),
        "ffn_wd": nrm(ks[7], (L, 2, F, D), F ** -0.5),
        "w_in": nrm(ks[8], (L, D, D_IN), D ** -0.5),
        "mlstm_conv_w": nrm(ks[9], (L, CONV_WIDTH, 1, 2 * MLSTM_WIDTH), CONV_WIDTH ** -0.5),
        "mlstm_conv_b": nrm(ks[12], (L, 2 * MLSTM_WIDTH), 0.02),
        "mlstm_gate_b": gate_b,
        "mlstm_head_gain": 1.0 + nrm(ks[13], (L, MLSTM_WIDTH), 0.05),
        "cmp_pe": nrm(ks[14], (L, 2, CMP_BLOCK, NSA_HEAD_DIM), 0.1),
        "cmp_w1": nrm(ks[15], (L, 2, CMP_BLOCK * NSA_HEAD_DIM, CMP_HIDDEN), (CMP_BLOCK * NSA_HEAD_DIM) ** -0.5),
        "cmp_b1": nrm(ks[16], (L, 2, CMP_HIDDEN), 0.02),
        "cmp_w2": nrm(ks[17], (L, 2, CMP_HIDDEN, NSA_HEAD_DIM), CMP_HIDDEN ** -0.5),
        "cmp_b2": nrm(ks[18], (L, 2, NSA_HEAD_DIM), 0.02),
        "w_up_mlstm": nrm(ks[19], (L, MLSTM_WIDTH, D), MLSTM_WIDTH ** -0.5),
        "w_up_nsa": nrm(ks[20], (L, NSA_WIDTH, D), NSA_WIDTH ** -0.5),
        "w_out": nrm(ks[21], (L, D, D), D ** -0.5),
    }


def reference(x, c, w_ada, b_ada, norm_gains, ffn_wg, ffn_wu, ffn_wd, w_in, mlstm_conv_w, mlstm_conv_b,
              mlstm_gate_b, mlstm_head_gain, cmp_pe, cmp_w1, cmp_b1, cmp_w2, cmp_b2, w_up_mlstm, w_up_nsa, w_out):
    B = x.shape[0]
    h = x
    for l in range(DEPTH):
        ada = (jax.nn.silu(c) @ w_ada[l] + b_ada[l]).reshape(B, 3, 3, D_MODEL)
        h = sandwich(h, lambda u: swiglu(u, ffn_wg[l, 0], ffn_wu[l, 0], ffn_wd[l, 0]), ada, 0,
                     norm_gains[l, 0], norm_gains[l, 1], MACARON_WEIGHT)
        h = sandwich(h, lambda u: token_mixer(u, w_in[l], mlstm_conv_w[l], mlstm_conv_b[l], mlstm_gate_b[l],
                                               mlstm_head_gain[l], cmp_pe[l], cmp_w1[l], cmp_b1[l], cmp_w2[l],
                                               cmp_b2[l], w_up_mlstm[l], w_up_nsa[l], w_out[l]),
                     ada, 1, norm_gains[l, 2], norm_gains[l, 3], 1.0)
        h = sandwich(h, lambda u: swiglu(u, ffn_wg[l, 1], ffn_wu[l, 1], ffn_wd[l, 1]), ada, 2,
                     norm_gains[l, 4], norm_gains[l, 5], MACARON_WEIGHT)
    return h.astype(x.dtype)
```

```cpp
#include <hip/hip_runtime.h>
#include <cstdio>
#include <cstdint>

#define GAS __attribute__((address_space(1)))
#define LAS __attribute__((address_space(3)))
typedef unsigned short bf16;
typedef unsigned v4u __attribute__((ext_vector_type(4)));
typedef unsigned v2u __attribute__((ext_vector_type(2)));
typedef float f32x4 __attribute__((ext_vector_type(4)));
typedef short bf16x8 __attribute__((ext_vector_type(8)));
typedef GAS unsigned gu32;

#ifndef MK_N_LAUNCHES
#define MK_N_LAUNCHES 1
#endif

constexpr int DM = 1024, NB = 16, SEQ = 4096, T = NB * SEQ, DFF = 2816;
constexpr int MH = 4, MDH = 128, MW = 512, CHUNK = 64, NCHUNK = SEQ / CHUNK;
constexpr int NSW = 512, NG = 2, NHG = 4, NDH = 64;
constexpr int NCMP = 255, NSEL = 64;
constexpr int NPROJ = 5632;
constexpr float EPS = 1e-6f;
constexpr int NPHASE = 15;

constexpr size_t MiB = 1u << 20;
constexpr size_t WS_CTL = 0, CTL_ZERO_BYTES = 1 * MiB;
constexpr size_t WS_W1T = 1 * MiB;
constexpr size_t WS_W1D = WS_W1T + 2 * (size_t)NPROJ * DM * 2;
constexpr size_t WS_WIN = WS_W1D + 2 * (size_t)DM * DFF * 2;
constexpr size_t WS_WUPM = WS_WIN + (size_t)NPROJ * DM * 2;
constexpr size_t WS_WUPN = WS_WUPM + (size_t)DM * MW * 2;
constexpr size_t WS_WOUT = WS_WUPN + (size_t)DM * NSW * 2;
constexpr size_t WS_WC1 = WS_WOUT + (size_t)DM * DM * 2;
constexpr size_t WS_ADA = WS_WC1 + 2 * (size_t)512 * 1024 * 2;
constexpr size_t WS_B1P = WS_ADA + (size_t)NB * 9 * DM * 4;
constexpr size_t WS_KCMP = WS_B1P + 32768;
constexpr size_t WS_CSC = WS_KCMP + 2 * (size_t)32 * 256 * 64 * 2;
constexpr size_t WS_MPREV = WS_CSC + 4096 * 8;
constexpr size_t WS_NST = WS_MPREV + 4096 * 4;
constexpr size_t WS_SMALL_END = WS_NST + (size_t)4096 * 128 * 4;
constexpr size_t WS_RA = 64 * MiB;
constexpr size_t WS_RB = WS_RA + 128 * MiB;
constexpr size_t WS_RC = WS_RB + 128 * MiB;
static_assert(WS_SMALL_END <= WS_RA, "small buffers");
constexpr size_t RC_QM = 0, RC_KM = 64 * MiB, RC_VM = 128 * MiB, RC_OM = 192 * MiB, RC_QN = 256 * MiB;
constexpr size_t RC_KV = 320 * MiB;
constexpr size_t RC_GM = 416 * MiB, RC_GN = 544 * MiB, RC_IF = 672 * MiB, RC_GG = 674 * MiB, RC_END = 680 * MiB;
constexpr size_t RC_MERGED = RC_VM;
constexpr size_t WS_END = WS_RC + RC_END;
static_assert(WS_END <= 1024 * MiB, "workspace");
static_assert((size_t)T * DFF * 2 <= 512 * MiB && 512 * MiB + (size_t)T * DM * 2 <= RC_END, "hid and the bf16 residual copy fit");

constexpr int CW_TMO = 0, CW_CODE = 1, CW_QUEUE = 64;
constexpr int CW_BAR = 4096;

constexpr int LDS_BYTES = 159744;
constexpr int MISC_OFF = LDS_BYTES - 256;
constexpr int NWAVES = 8, NTHREADS = 512;

#define RLX_AGENT __ATOMIC_RELAXED, __HIP_MEMORY_SCOPE_AGENT
#define LDS_WAIT() asm volatile("s_waitcnt lgkmcnt(0)" ::: "memory")
#define VM_WAIT() asm volatile("s_waitcnt vmcnt(0)" ::: "memory")
__device__ __forceinline__ unsigned f2bf(float f) { unsigned u = __builtin_bit_cast(unsigned, f); return (u + 0x7fffu + ((u >> 16) & 1u)) >> 16; }
__device__ __forceinline__ unsigned pk2(float lo, float hi) { return f2bf(lo) | (f2bf(hi) << 16); }
__device__ __forceinline__ float bf2f(unsigned short b) { return __builtin_bit_cast(float, (unsigned)b << 16); }
__device__ __forceinline__ float bflo(unsigned w) { return __builtin_bit_cast(float, w << 16); }
__device__ __forceinline__ float bfhi(unsigned w) { return __builtin_bit_cast(float, w & 0xffff0000u); }
__device__ __forceinline__ float sigmoidf_(float x) { return __builtin_amdgcn_rcpf(1.f + __builtin_amdgcn_exp2f(-1.4426950408889634f * x)); }
__device__ __forceinline__ float siluf_(float x) { return x * __builtin_amdgcn_rcpf(1.f + __builtin_amdgcn_exp2f(-1.4426950408889634f * x)); }
__device__ __forceinline__ void unpack8(const v4u w, float (&x)[8]) { x[0] = bflo(w.x); x[1] = bfhi(w.x); x[2] = bflo(w.y); x[3] = bfhi(w.y); x[4] = bflo(w.z); x[5] = bfhi(w.z); x[6] = bflo(w.w); x[7] = bfhi(w.w); }
__device__ __forceinline__ float wave_sum(float v) {
#pragma unroll
    for (int o = 1; o < 64; o <<= 1) v += __shfl_xor(v, o);
    return v;
}
__device__ __forceinline__ float wave_max(float v) {
#pragma unroll
    for (int o = 1; o < 64; o <<= 1) v = fmaxf(v, __shfl_xor(v, o));
    return v;
}

namespace pg8 {
#define PG8_LAS __attribute__((address_space(3)))
typedef unsigned short bf16_t;
typedef unsigned u32x4 __attribute__((ext_vector_type(4)));
constexpr int BM = 256, BK = 64, HALF = 128, HTB = HALF * BK * 2, STAGE_BYTES = 8 * HTB, NXCD = 8, WGM = 4;

__host__ __device__ __forceinline__ int lds_byte(int r, int c) { const int st = (r >> 4) * 2 + (c >> 5), rr = r & 15, cc = c & 31, ob = rr * 64 + cc * 2; return st * 1024 + (ob ^ (((ob >> 9) & 1) << 5)); }
__host__ __device__ __forceinline__ void stage_rc(int b, int& R, int& C) { const int st = b / 1024, sb = b % 1024, swz = sb ^ (((sb >> 9) & 1) << 5); R = (st >> 1) * 16 + swz / 64; C = (st & 1) * 32 + (swz % 64) / 2; }
__host__ __device__ __forceinline__ int perm32(int rho) { const int n = rho >> 4, i = rho & 15; return 8 * (i >> 2) + 4 * n + (i & 3); }

struct Unit { int pm, pn, seg; };
struct Gemm { const bf16_t* A; const bf16_t* Bt; int M, N, K; int lda, ldb, segbytes; };

struct StaticOrder {
    int nM, nN, nwg, G, c;
    __host__ __device__ void init(int M, int N, int G_, int c_) { nM = M / BM; nN = N / BM; nwg = nM * nN; G = G_; c = c_; }
    __host__ __device__ bool next(int i, Unit& u) const {
        const long L = (long)i * G + c; if (L >= nwg) return false;
        int wgid = (int)L; { const int q = nwg / NXCD, r = nwg % NXCD, xcd = wgid % NXCD, off = wgid / NXCD; wgid = (xcd < r ? xcd * (q + 1) : r * (q + 1) + (xcd - r) * q) + off; }
        const int nig = WGM * nN, gid = wgid / nig, fm = gid * WGM, gsz = (nM - fm) < WGM ? (nM - fm) : WGM;
        u.pm = fm + ((wgid % nig) % gsz); u.pn = (wgid % nig) / gsz; u.seg = 0; return true;
    }
    __device__ __forceinline__ void a_ready(const Unit&) const {}
    __device__ __forceinline__ void done(const Unit&) const {}
};
struct SegOrder : StaticOrder {
    __host__ __device__ bool next(int i, Unit& u) const { if (!StaticOrder::next(i >> 1, u)) return false; u.seg = i & 1; return true; }
};

template <class Epi, class Sched, bool ALIGN_EPI = false, bool SP2 = false>
__device__ __forceinline__ void gemm_phase(PG8_LAS unsigned char* lds, const Gemm g, const Sched& S, const Epi& E) {
    const int tid = threadIdx.x, wid = __builtin_amdgcn_readfirstlane(tid >> 6), lane = tid & 63, wr = wid >> 2, wc = wid & 3, fr = lane & 15, fq = lane >> 4;
    const int K = g.K, nt = K / BK;
    unsigned voffA[2], voffB[2];
#pragma unroll
    for (int i = 0; i < 2; ++i) { int R, C; stage_rc(tid * 16 + i * 8192, R, C); const int Rb = ((R & ~31) + perm32(R & 31));
        voffA[i] = (unsigned)(R * g.lda + C) * 2u; voffB[i] = (unsigned)(Rb * g.ldb + C) * 2u; }
    const size_t kstep = (size_t)(BK * 2);
    const size_t hstepA = (size_t)HALF * g.lda * 2, hstepB = (size_t)HALF * g.ldb * 2;
    const size_t tstepA = 2 * hstepA, tstepB = 2 * hstepB;
    const unsigned ldsw = (unsigned)wid * 1024u;
    const int aoff = lds_byte(wr * 64 + fr, fq * 8), boff = lds_byte(wc * 32 + fr, fq * 8);
#define PG8_SA(b, h) (((b) * 2 + (h)) * HTB)
#define PG8_SB(b, h) ((4 + (b) * 2 + (h)) * HTB)
#define PG8_STAGE(bufoff, gbase, voff) do { _Pragma("unroll") for (int _i = 0; _i < 2; ++_i) \
        __builtin_amdgcn_global_load_lds((const unsigned*)((const char*)(gbase) + (voff)[_i]), (PG8_LAS unsigned*)(lds + (bufoff) + ldsw + _i * 8192), 16, 0, 0); } while (0)
#define PG8_LDA(dst, b, h) do { _Pragma("unroll") for (int m = 0; m < 4; ++m) _Pragma("unroll") for (int k = 0; k < 2; ++k) dst[m][k] = *(const PG8_LAS bf16x8*)(lds + PG8_SA(b, h) + aoff + m * 2048 + k * 1024); } while (0)
#define PG8_LDB(dst, b, h) do { _Pragma("unroll") for (int n = 0; n < 2; ++n) _Pragma("unroll") for (int k = 0; k < 2; ++k) dst[n][k] = *(const PG8_LAS bf16x8*)(lds + PG8_SB(b, h) + boff + n * 2048 + k * 1024); } while (0)
#define PG8_MMA(ai, bj, At, Bt) do { __builtin_amdgcn_s_setprio(1); _Pragma("unroll") for (int m = 0; m < 4; ++m) _Pragma("unroll") for (int n = 0; n < 2; ++n) _Pragma("unroll") for (int k = 0; k < 2; ++k) \
        acc[ai][bj][m][n] = __builtin_amdgcn_mfma_f32_16x16x32_bf16(Bt[n][k], At[m][k], acc[ai][bj][m][n], 0, 0, 0); __builtin_amdgcn_s_setprio(0); } while (0)
#define PG8_WAIT_V(n) asm volatile("s_waitcnt vmcnt(" #n ")" ::: "memory")
#define PG8_WAIT_L(n) asm volatile("s_waitcnt lgkmcnt(" #n ")" ::: "memory")
#define PG8_BAR __builtin_amdgcn_s_barrier()
#define PG8_SCHED __builtin_amdgcn_sched_barrier(0)
    Unit cur, nxt; int ui = 0;
    if (!S.next(0, cur)) return;
    f32x4 acc[2][2][4][2];
#pragma unroll
    for (int a = 0; a < 2; ++a)
#pragma unroll
        for (int b = 0; b < 2; ++b)
#pragma unroll
            for (int m = 0; m < 4; ++m)
#pragma unroll
                for (int n = 0; n < 2; ++n) acc[a][b][m][n] = (f32x4){0.f, 0.f, 0.f, 0.f};
    bf16x8 At[4][2], B0[2][2], B1[2][2];
    const char* cA = (const char*)g.A + (size_t)cur.pm * tstepA + (size_t)cur.seg * g.segbytes; const char* cB = (const char*)g.Bt + (size_t)cur.pn * tstepB + (size_t)cur.seg * g.segbytes;
    S.a_ready(cur);
    if constexpr (SP2) {
        PG8_STAGE(PG8_SB(0, 0), cB, voffB); PG8_STAGE(PG8_SB(0, 1), cB + hstepB, voffB); PG8_STAGE(PG8_SA(0, 0), cA, voffA); PG8_STAGE(PG8_SA(0, 1), cA + hstepA, voffA);
        if (wr == 1) PG8_BAR;
        PG8_WAIT_V(2); PG8_BAR;
        PG8_STAGE(PG8_SB(1, 0), cB + kstep, voffB); PG8_STAGE(PG8_SA(1, 0), cA + kstep, voffA); PG8_STAGE(PG8_SB(1, 1), cB + hstepB + kstep, voffB);
        PG8_WAIT_V(6); PG8_BAR;
    } else {
        PG8_STAGE(PG8_SB(0, 0), cB, voffB); PG8_STAGE(PG8_SA(0, 0), cA, voffA); PG8_STAGE(PG8_SB(0, 1), cB + hstepB, voffB); PG8_STAGE(PG8_SA(0, 1), cA + hstepA, voffA);
        if (wr == 1) PG8_BAR;
        PG8_WAIT_V(4); PG8_BAR;
        PG8_STAGE(PG8_SB(1, 0), cB + kstep, voffB); PG8_STAGE(PG8_SA(1, 0), cA + kstep, voffA); PG8_STAGE(PG8_SB(1, 1), cB + hstepB + kstep, voffB);
        PG8_WAIT_V(6); PG8_BAR;
    }
    for (;;) {
        const bool has_next = S.next(ui + 1, nxt);
        const char* nA = has_next ? (const char*)g.A + (size_t)nxt.pm * tstepA + (size_t)nxt.seg * g.segbytes : cA; const char* nB = has_next ? (const char*)g.Bt + (size_t)nxt.pn * tstepB + (size_t)nxt.seg * g.segbytes : cB;
        for (int t = 0; t < nt; t += 2) {
            const bool last = (t == nt - 2);
            const char* a1 = cA + (size_t)(t + 1) * kstep;
            const char* a2 = last ? nA : cA + (size_t)(t + 2) * kstep; const char* b2 = last ? nB : cB + (size_t)(t + 2) * kstep;
            const char* a3 = a2 + kstep; const char* b3 = b2 + kstep;
            if (last && has_next) S.a_ready(nxt);
            if constexpr (SP2) {
            PG8_LDB(B0, 0, 0); PG8_LDB(B1, 0, 1); PG8_SCHED; PG8_LDA(At, 0, 0); PG8_STAGE(PG8_SA(1, 1), a1 + hstepA, voffA);
            PG8_WAIT_V(8); PG8_WAIT_L(0); PG8_BAR; PG8_MMA(0, 0, At, B0); PG8_MMA(0, 1, At, B1); PG8_BAR; PG8_SCHED;
            PG8_LDA(At, 0, 1); PG8_STAGE(PG8_SB(0, 0), b2, voffB); PG8_STAGE(PG8_SB(0, 1), b2 + hstepB, voffB); PG8_STAGE(PG8_SA(0, 0), a2, voffA);
            PG8_WAIT_V(8); PG8_WAIT_L(0); PG8_BAR; PG8_MMA(1, 0, At, B0); PG8_MMA(1, 1, At, B1); PG8_BAR; PG8_SCHED;
            PG8_LDB(B0, 1, 0); PG8_LDB(B1, 1, 1); PG8_SCHED; PG8_LDA(At, 1, 0); PG8_STAGE(PG8_SA(0, 1), a2 + hstepA, voffA);
            PG8_WAIT_V(8); PG8_WAIT_L(0); PG8_BAR; PG8_MMA(0, 0, At, B0); PG8_MMA(0, 1, At, B1); PG8_BAR; PG8_SCHED;
            PG8_LDA(At, 1, 1); PG8_STAGE(PG8_SB(1, 0), b3, voffB); PG8_STAGE(PG8_SB(1, 1), b3 + hstepB, voffB); PG8_STAGE(PG8_SA(1, 0), a3, voffA);
            PG8_WAIT_V(8); PG8_WAIT_L(0); PG8_BAR; PG8_MMA(1, 0, At, B0); PG8_MMA(1, 1, At, B1); PG8_BAR; PG8_SCHED;
            } else {
            PG8_LDB(B0, 0, 0); PG8_SCHED; PG8_LDA(At, 0, 0); PG8_STAGE(PG8_SA(1, 1), a1 + hstepA, voffA);
            PG8_WAIT_L(8); PG8_BAR; PG8_WAIT_L(0); PG8_MMA(0, 0, At, B0); PG8_BAR; PG8_SCHED;
            PG8_LDB(B1, 0, 1); PG8_STAGE(PG8_SB(0, 0), b2, voffB);
            PG8_BAR; PG8_WAIT_L(0); PG8_MMA(0, 1, At, B1); PG8_BAR;
            PG8_LDA(At, 0, 1); PG8_STAGE(PG8_SA(0, 0), a2, voffA);
            PG8_BAR; PG8_WAIT_L(0); PG8_MMA(1, 0, At, B0); PG8_BAR; PG8_SCHED;
            PG8_STAGE(PG8_SB(0, 1), b2 + hstepB, voffB);
            PG8_WAIT_V(6); PG8_BAR; PG8_MMA(1, 1, At, B1); PG8_BAR;
            PG8_LDB(B0, 1, 0); PG8_SCHED; PG8_LDA(At, 1, 0); PG8_STAGE(PG8_SA(0, 1), a2 + hstepA, voffA);
            PG8_WAIT_L(8); PG8_BAR; PG8_WAIT_L(0); PG8_MMA(0, 0, At, B0); PG8_BAR; PG8_SCHED;
            PG8_LDB(B1, 1, 1); PG8_STAGE(PG8_SB(1, 0), b3, voffB);
            PG8_BAR; PG8_WAIT_L(0); PG8_MMA(0, 1, At, B1); PG8_BAR;
            PG8_LDA(At, 1, 1); PG8_STAGE(PG8_SA(1, 0), a3, voffA);
            PG8_BAR; PG8_WAIT_L(0); PG8_MMA(1, 0, At, B0); PG8_BAR; PG8_SCHED;
            PG8_STAGE(PG8_SB(1, 1), b3 + hstepB, voffB);
            PG8_WAIT_V(6); PG8_BAR; PG8_MMA(1, 1, At, B1); PG8_BAR;
            }
        }
        if constexpr (ALIGN_EPI) { if (wr == 0) PG8_BAR; }
        E(acc, cur, wr, wc, fr, fq); S.done(cur);
        if (!has_next) break;
        if (!(Epi::KEEP_SEG0 && cur.seg == 0))
#pragma unroll
        for (int a = 0; a < 2; ++a)
#pragma unroll
            for (int b = 0; b < 2; ++b)
#pragma unroll
                for (int m = 0; m < 4; ++m)
#pragma unroll
                    for (int n = 0; n < 2; ++n) acc[a][b][m][n] = (f32x4){0.f, 0.f, 0.f, 0.f};
        cur = nxt; cA = nA; cB = nB; ++ui;
        if constexpr (ALIGN_EPI) { if (wr == 1) PG8_BAR; }
    }
    PG8_WAIT_V(0);
    if constexpr (!ALIGN_EPI) { if (wr == 0) PG8_BAR; }
    PG8_BAR;
#undef PG8_SA
#undef PG8_SB
#undef PG8_STAGE
#undef PG8_LDA
#undef PG8_LDB
#undef PG8_MMA
#undef PG8_WAIT_V
#undef PG8_WAIT_L
#undef PG8_BAR
#undef PG8_SCHED
}

typedef f32x4 Acc[2][2][4][2];
__device__ __forceinline__ v4u pack8(const f32x4& v0, const f32x4& v1) { v4u w; w.x = pk2(v0[0], v0[1]); w.y = pk2(v0[2], v0[3]); w.z = pk2(v1[0], v1[1]); w.w = pk2(v1[2], v1[3]); return w; }

struct EpiStore {
    static constexpr bool KEEP_SEG0 = false;
    bf16_t* O; int ldc;
    __device__ __forceinline__ void operator()(Acc& acc, const Unit& u, int wr, int wc, int fr, int fq) const {
        const int row0 = u.pm * BM + wr * 64 + fr, col0 = u.pn * BM + wc * 32 + 8 * fq;
#pragma unroll
        for (int ai = 0; ai < 2; ++ai)
#pragma unroll
            for (int m = 0; m < 4; ++m) { bf16_t* rowp = O + (size_t)(row0 + ai * HALF + m * 16) * ldc + col0;
#pragma unroll
                for (int bj = 0; bj < 2; ++bj) *(v4u*)(rowp + bj * HALF) = pack8(acc[ai][bj][m][0], acc[ai][bj][m][1]); }
    }
};
struct EpiStoreF32 {
    static constexpr bool KEEP_SEG0 = false;
    float* O; int ldc;
    __device__ __forceinline__ void operator()(Acc& acc, const Unit& u, int wr, int wc, int fr, int fq) const {
        const int row0 = u.pm * BM + wr * 64 + fr, col0 = u.pn * BM + wc * 32 + 8 * fq;
#pragma unroll
        for (int ai = 0; ai < 2; ++ai)
#pragma unroll
            for (int m = 0; m < 4; ++m) { float* rowp = O + (size_t)(row0 + ai * HALF + m * 16) * ldc + col0;
#pragma unroll
                for (int bj = 0; bj < 2; ++bj) { *(f32x4*)(rowp + bj * HALF) = acc[ai][bj][m][0]; *(f32x4*)(rowp + bj * HALF + 4) = acc[ai][bj][m][1]; } }
    }
};
struct EpiSwiGLU {
    static constexpr bool KEEP_SEG0 = false;
    bf16_t* O;
    __device__ __forceinline__ void operator()(Acc& acc, const Unit& u, int wr, int wc, int fr, int fq) const {
        const int row0 = u.pm * BM + wr * 64 + fr, col0 = u.pn * HALF + wc * 32 + 8 * fq;
#pragma unroll
        for (int ai = 0; ai < 2; ++ai)
#pragma unroll
            for (int m = 0; m < 4; ++m) { bf16_t* rowp = O + (size_t)(row0 + ai * HALF + m * 16) * DFF + col0;
                f32x4 r0, r1;
#pragma unroll
                for (int i = 0; i < 4; ++i) { r0[i] = siluf_(acc[ai][0][m][0][i]) * acc[ai][1][m][0][i]; r1[i] = siluf_(acc[ai][0][m][1][i]) * acc[ai][1][m][1][i]; }
                *(v4u*)rowp = pack8(r0, r1); }
    }
};
struct EpiProj {
    static constexpr bool KEEP_SEG0 = false;
    unsigned char* rc;
    __device__ __forceinline__ void operator()(Acc& acc, const Unit& u, int wr, int wc, int fr, int fq) const {
        const int row0 = u.pm * BM + wr * 64 + fr, pn = u.pn;
        const int cw = wc * 32 + 8 * fq;
        if (pn < 10) {
            bf16_t* base = (bf16_t*)(rc + (size_t)(pn >> 1) * (64 * MiB)); const int colb = (pn & 1) * 256 + cw;
            const float sc = (pn >= 8) ? 0.125f * 1.4426950408889634f : 1.f;
#pragma unroll
            for (int ai = 0; ai < 2; ++ai)
#pragma unroll
                for (int m = 0; m < 4; ++m) { bf16_t* rowp = base + (size_t)(row0 + ai * HALF + m * 16) * 512 + colb;
#pragma unroll
                    for (int bj = 0; bj < 2; ++bj) *(v4u*)(rowp + bj * HALF) = pack8(acc[ai][bj][m][0] * sc, acc[ai][bj][m][1] * sc); }
        } else if (pn < 13) {
            const int g = cw >> 6, d = cw & 63;
#pragma unroll
            for (int bj = 0; bj < 2; ++bj) { bf16_t* base = (bf16_t*)(rc + RC_KV + (size_t)((pn - 10) * 2 + bj) * (16 * MiB));
#pragma unroll
                for (int ai = 0; ai < 2; ++ai)
#pragma unroll
                    for (int m = 0; m < 4; ++m) { const int row = row0 + ai * HALF + m * 16, b = row >> 12, s = row & 4095;
                        *(v4u*)(base + ((size_t)((b * 2 + g) * 4096 + s)) * 64 + d) = pack8(acc[ai][bj][m][0], acc[ai][bj][m][1]); } }
        } else if (pn < 21) {
            bf16_t* base = (bf16_t*)(rc + (pn < 17 ? RC_GM : RC_GN)); const int colb = ((pn - 13) & 3) * 256 + cw;
#pragma unroll
            for (int ai = 0; ai < 2; ++ai)
#pragma unroll
                for (int m = 0; m < 4; ++m) { bf16_t* rowp = base + (size_t)(row0 + ai * HALF + m * 16) * 1024 + colb;
#pragma unroll
                    for (int bj = 0; bj < 2; ++bj) { f32x4 s0, s1;
#pragma unroll
                        for (int i = 0; i < 4; ++i) { s0[i] = sigmoidf_(acc[ai][bj][m][0][i]); s1[i] = sigmoidf_(acc[ai][bj][m][1][i]); }
                        *(v4u*)(rowp + bj * HALF) = pack8(s0, s1); } }
        } else {
            if (wc == 0) {
                float* ifm = (float*)(rc + RC_IF); float* gg = (float*)(rc + RC_GG);
#pragma unroll
                for (int ai = 0; ai < 2; ++ai)
#pragma unroll
                    for (int m = 0; m < 4; ++m) { const size_t row = (size_t)(row0 + ai * HALF + m * 16);
                        float* p = (fq == 0) ? (ifm + row * 8) : (gg + row * 24 + (fq - 1) * 8);
                        *(f32x4*)p = acc[ai][0][m][0]; *(f32x4*)(p + 4) = acc[ai][0][m][1]; }
            }
        }
    }
};
struct EpiMergeFused {
    static constexpr bool KEEP_SEG0 = true;
    bf16_t* O; const bf16_t* gm; const bf16_t* gn;
    __device__ __forceinline__ void operator()(Acc& acc, const Unit& u, int wr, int wc, int fr, int fq) const {
        const int row0 = u.pm * BM + wr * 64 + fr, col0 = u.pn * BM + wc * 32 + 8 * fq;
        if (u.seg == 0) {
#pragma unroll
            for (int ai = 0; ai < 2; ++ai)
#pragma unroll
                for (int m = 0; m < 4; ++m) { const size_t off = (size_t)(row0 + ai * HALF + m * 16) * 1024 + col0;
#pragma unroll
                    for (int bj = 0; bj < 2; ++bj) { const v4u a = *(const v4u*)(gm + off + bj * HALF), b = *(const v4u*)(gn + off + bj * HALF);
                        float x[8], y[8]; unpack8(a, x); unpack8(b, y);
#pragma unroll
                        for (int i = 0; i < 4; ++i) { acc[ai][bj][m][0][i] *= x[i] * __builtin_amdgcn_rcpf(y[i]); acc[ai][bj][m][1][i] *= x[4 + i] * __builtin_amdgcn_rcpf(y[4 + i]); } } }
        } else {
#pragma unroll
            for (int ai = 0; ai < 2; ++ai)
#pragma unroll
                for (int m = 0; m < 4; ++m) { const size_t off = (size_t)(row0 + ai * HALF + m * 16) * 1024 + col0;
#pragma unroll
                    for (int bj = 0; bj < 2; ++bj) { const v4u b = *(const v4u*)(gn + off + bj * HALF); float y[8]; unpack8(b, y);
                        f32x4 r0, r1;
#pragma unroll
                        for (int i = 0; i < 4; ++i) { r0[i] = acc[ai][bj][m][0][i] * y[i]; r1[i] = acc[ai][bj][m][1][i] * y[4 + i]; }
                        *(v4u*)(O + off + bj * HALF) = pack8(r0, r1); } }
        }
    }
};
template <bool ADD> struct EpiMerge {
    static constexpr bool KEEP_SEG0 = false;
    bf16_t* O; const bf16_t* gate;
    __device__ __forceinline__ void operator()(Acc& acc, const Unit& u, int wr, int wc, int fr, int fq) const {
        const int row0 = u.pm * BM + wr * 64 + fr, col0 = u.pn * BM + wc * 32 + 8 * fq;
#pragma unroll
        for (int ai = 0; ai < 2; ++ai)
#pragma unroll
            for (int m = 0; m < 4; ++m) { const size_t off = (size_t)(row0 + ai * HALF + m * 16) * 1024 + col0;
#pragma unroll
                for (int bj = 0; bj < 2; ++bj) { const v4u gv = *(const v4u*)(gate + off + bj * HALF); v4u pv = (v4u){0u, 0u, 0u, 0u}; if (ADD) pv = *(const v4u*)(O + off + bj * HALF);
                    f32x4 r0, r1; const f32x4 a0 = acc[ai][bj][m][0], a1 = acc[ai][bj][m][1];
                    r0[0] = sigmoidf_(bflo(gv.x)) * a0[0]; r0[1] = sigmoidf_(bfhi(gv.x)) * a0[1]; r0[2] = sigmoidf_(bflo(gv.y)) * a0[2]; r0[3] = sigmoidf_(bfhi(gv.y)) * a0[3];
                    r1[0] = sigmoidf_(bflo(gv.z)) * a1[0]; r1[1] = sigmoidf_(bfhi(gv.z)) * a1[1]; r1[2] = sigmoidf_(bflo(gv.w)) * a1[2]; r1[3] = sigmoidf_(bfhi(gv.w)) * a1[3];
                    if (ADD) { r0[0] += bflo(pv.x); r0[1] += bfhi(pv.x); r0[2] += bflo(pv.y); r0[3] += bfhi(pv.y); r1[0] += bflo(pv.z); r1[1] += bfhi(pv.z); r1[2] += bflo(pv.w); r1[3] += bfhi(pv.w); }
                    *(v4u*)(O + off + bj * HALF) = pack8(r0, r1); } }
    }
};
}

#define XB_TMO      128
#define XB_XCNT(j)  (256  + 64 * (j))
#define XB_XSUB(j)  (1280 + 64 * (j))
#define XB_XGEN(j)  (2304 + 64 * (j))
#define XB_TOP      3328
#define XB_TOPGEN   3392
#define XCD_BAR_WORDS 3456
#define XB_SPIN_CAP (1u << 22)

__device__ __forceinline__ unsigned xb_ld(unsigned* p)              { return __hip_atomic_load(p, __ATOMIC_RELAXED, __HIP_MEMORY_SCOPE_AGENT); }
__device__ __forceinline__ unsigned xb_add(unsigned* p, unsigned v) { return __hip_atomic_fetch_add(p, v, __ATOMIC_RELAXED, __HIP_MEMORY_SCOPE_AGENT); }
__device__ __forceinline__ unsigned xb_xcc_id() { return (unsigned)__builtin_amdgcn_s_getreg((3 << 11) | 20) & 0xFu; }
#define XB_SPIN(cond, bar) do { unsigned _sp = 0; while (cond) { __builtin_amdgcn_s_sleep(1); \
    if ((++_sp & 255u) == 0u) { if (xb_ld(&(bar)[XB_TMO])) break; if (_sp > XB_SPIN_CAP) { atomicAdd(&(bar)[XB_TMO], 1u); break; } } } } while (0)

struct XcdBarrier { unsigned* bar; unsigned x; volatile LAS unsigned* st; };

__device__ __forceinline__ XcdBarrier xcd_barrier_post(unsigned* bar, volatile LAS unsigned* st) {
    XcdBarrier b; b.bar = bar; b.x = xb_xcc_id(); b.st = st;
    if (threadIdx.x == 0) (void)xb_add(&bar[XB_XCNT(b.x)], 1u);
    return b;
}
__device__ __forceinline__ void xcd_barrier_complete(unsigned* bar, unsigned x, unsigned& nloc, unsigned& nx) {
    const unsigned G = gridDim.x * gridDim.y * gridDim.z;
    unsigned sum, cnt, mine, sp = 0u;
    for (;;) {
        sum = 0u; cnt = 0u; mine = 0u;
#pragma unroll
        for (unsigned j = 0; j < 16; ++j) { const unsigned c = xb_ld(&bar[XB_XCNT(j)]); sum += c; cnt += (c > 0u) ? 1u : 0u; mine = (j == x) ? c : mine; }
        if (sum == G) break;
        __builtin_amdgcn_s_sleep(1);
        if ((++sp & 255u) == 0u) { if (xb_ld(&bar[XB_TMO])) break; if (sp > XB_SPIN_CAP) { atomicAdd(&bar[XB_TMO], 1u); break; } }
    }
    nloc = mine > 0u ? mine : 1u; nx = cnt > 0u ? cnt : 1u;
}
__device__ __forceinline__ void xcd_barrier(const XcdBarrier& b) {
    asm volatile("s_waitcnt vmcnt(0)" ::: "memory");
    __syncthreads();
    if (threadIdx.x == 0) {
        unsigned* bar = b.bar;
        __builtin_amdgcn_s_waitcnt(0);
        unsigned nloc = b.st[0], nx = b.st[1];
        if (nloc == 0u) { xcd_barrier_complete(bar, b.x, nloc, nx); b.st[0] = nloc; b.st[1] = nx; }
        const unsigned old = xb_add(&bar[XB_XSUB(b.x)], 1u);
        const unsigned gen = old / nloc;
        if (old + 1u == (gen + 1u) * nloc) {
            __builtin_amdgcn_fence(__ATOMIC_RELEASE, "agent");
            asm volatile("s_waitcnt vmcnt(0)" ::: "memory");
            const unsigned og = xb_add(&bar[XB_TOP], 1u);
            const unsigned tg = og / nx;
            if (og + 1u == (tg + 1u) * nx) xb_add(&bar[XB_TOPGEN], 1u);
            else XB_SPIN(xb_ld(&bar[XB_TOPGEN]) == tg, bar);
            __builtin_amdgcn_fence(__ATOMIC_ACQUIRE, "agent");
            xb_add(&bar[XB_XGEN(b.x)], 1u);
            asm volatile("s_waitcnt vmcnt(0)" ::: "memory");
        } else {
            XB_SPIN(xb_ld(&bar[XB_XGEN(b.x)]) == gen, bar);
            __builtin_amdgcn_fence(__ATOMIC_ACQUIRE, "agent");
            asm volatile("s_waitcnt vmcnt(0)" ::: "memory");
        }
    }
    __syncthreads();
}

struct Args { const float* in[21]; float* out; unsigned char* ws; int ph_lo, ph_hi; };
enum { I_X = 0, I_C, I_WADA, I_BADA, I_GAINS, I_WG, I_WU, I_WD, I_WIN, I_CONVW, I_CONVB, I_GATEB, I_HGAIN, I_PE, I_CW1, I_CB1, I_CW2, I_CB2, I_WUPM, I_WUPN, I_WOUT };

struct Frame {
    LAS unsigned char* lds;
    int tid, lane, wave, vcu, G;
};

struct ColMap { const float* p; int ld; };
template <int KIND> __device__ __forceinline__ ColMap colmap(const Args& a, int layer, int n) {
    ColMap r; r.p = nullptr; r.ld = 0;
    if (KIND == 0) {
        const int pn = n >> 8, bj = (n >> 7) & 1, j = n & 127; const float* w = (bj ? a.in[I_WU] : a.in[I_WG]) + (size_t)layer * DM * DFF;
        r.p = w + pn * 128 + j; r.ld = DFF;
    } else if (KIND == 1) {
        r.p = a.in[I_WD] + (size_t)layer * DFF * DM + n; r.ld = DM;
    } else if (KIND == 2) {
        int sc; if (n < 2048) sc = n; else if (n < 3328) sc = n + 8; else if (n < 5376) sc = n + 32; else if (n < 5384) sc = n - 5376 + 2048; else if (n < 5408) sc = n - 5384 + 3336; else sc = -1;
        if (sc >= 0) { r.p = a.in[I_WIN] + sc; r.ld = 5408; }
    } else if (KIND == 3) { r.p = a.in[I_WUPM] + n; r.ld = DM; }
    else if (KIND == 4) { r.p = a.in[I_WUPN] + n; r.ld = DM; }
    else if (KIND == 5) { r.p = a.in[I_WOUT] + n; r.ld = DM; }
    else {
        const float* w = a.in[I_CW1] + (size_t)layer * 2048 * 256; r.p = w + (size_t)(n >> 8) * 1024 * 256 + (n & 255); r.ld = 256;
    }
    return r;
}
template <int KIND> __device__ __forceinline__ void transpose_item(const Args& a, int layer, int K, int N, bf16* WT, LAS unsigned* scr, int item, int lane, int ldw = 0) {
    const int nblk = N / 64, kb = item / nblk, nb = item % nblk, k0 = 64 * kb, n0 = 64 * nb;
    const ColMap cm = colmap<KIND>(a, layer, n0 + lane);
    float v[64];
#pragma unroll
    for (int kk = 0; kk < 64; ++kk) v[kk] = cm.p ? cm.p[(size_t)(k0 + kk) * cm.ld] : 0.f;
#pragma unroll
    for (int kk = 0; kk < 64; kk += 2) scr[lane * 33 + (kk >> 1)] = pk2(v[kk], v[kk + 1]);
    LDS_WAIT(); asm volatile("" ::: "memory");
    const int c = lane & 7;
#pragma unroll
    for (int j = 0; j < 8; ++j) { const int n = (lane >> 3) + 8 * j; const LAS unsigned* sp = scr + n * 33 + 4 * c;
        v4u o; o.x = sp[0]; o.y = sp[1]; o.z = sp[2]; o.w = sp[3];
        *(v4u*)(WT + (size_t)(n0 + n) * (ldw ? ldw : K) + k0 + 8 * c) = o; }
    LDS_WAIT(); asm volatile("" ::: "memory");
}
__device__ __forceinline__ void p0_prologue(const Args& a, Frame& F) {
    unsigned char* ws = a.ws;
    {
        LAS float* sc = (LAS float*)F.lds;
        LAS float* red = (LAS float*)(F.lds + 65536);
        bool have = false;
        for (int cg = F.vcu; cg < 144; cg += F.G) {
            if (!have) { for (int i = F.tid; i < NB * DM; i += NTHREADS) sc[i] = siluf_(a.in[I_C][i]); have = true; __syncthreads(); }
            float acc[16];
#pragma unroll
            for (int b = 0; b < 16; ++b) acc[b] = 0.f;
            const float* wp = a.in[I_WADA] + (size_t)(F.wave * 128) * 9216 + cg * 64 + F.lane;
#pragma unroll 1
            for (int k0 = 0; k0 < 128; k0 += 16) { float wv[16];
#pragma unroll
                for (int i = 0; i < 16; ++i) wv[i] = wp[(size_t)(k0 + i) * 9216];
#pragma unroll
                for (int i = 0; i < 16; ++i)
#pragma unroll
                    for (int b = 0; b < 16; ++b) acc[b] += sc[b * 1024 + F.wave * 128 + k0 + i] * wv[i]; }
#pragma unroll
            for (int b = 0; b < 16; ++b) red[(F.wave * 16 + b) * 64 + F.lane] = acc[b];
            __syncthreads();
            for (int i = F.tid; i < 16 * 64; i += NTHREADS) { const int b = i >> 6, l = i & 63; float s = 0.f;
#pragma unroll
                for (int w = 0; w < 8; ++w) s += red[(w * 16 + b) * 64 + l];
                ((float*)(ws + WS_ADA))[b * 9216 + cg * 64 + l] = s + a.in[I_BADA][cg * 64 + l]; }
            __syncthreads();
        }
        __syncthreads();
    }
    { const int slot = F.vcu - (F.G - 32);
      if (slot >= 0) { const int kv = slot >> 4, part = slot & 15, c = F.tid & 255, half = F.tid >> 8;
        const float* w1 = a.in[I_CW1] + (size_t)kv * 2048 * 256 + (size_t)(part * 128 + half * 64) * 256 + c; const float* pe = a.in[I_PE] + (size_t)kv * 2048 + part * 128 + half * 64;
        float sacc = 0.f;
#pragma unroll 1
        for (int r0 = 0; r0 < 64; r0 += 16) { float wv[16];
#pragma unroll
            for (int i = 0; i < 16; ++i) wv[i] = w1[(size_t)(r0 + i) * 256];
#pragma unroll
            for (int i = 0; i < 16; ++i) sacc += pe[r0 + i] * wv[i]; }
        LAS float* red = (LAS float*)(F.lds + 98304);
        __syncthreads();
        if (half) red[c] = sacc;
        __syncthreads();
        if (!half) ((float*)(ws + WS_B1P))[(kv * 16 + part) * 256 + c] = sacc + red[c];
        __syncthreads(); } }
    LAS unsigned* scr = (LAS unsigned*)(F.lds + F.wave * 16384);
    const int gw = F.vcu * NWAVES + F.wave, NGW = F.G * NWAVES;
    constexpr int I_GU = (DM / 64) * (NPROJ / 64), I_DN = (DFF / 64) * (DM / 64), I_IN = (DM / 64) * (NPROJ / 64), I_UP = (512 / 64) * (DM / 64), I_OUT = (DM / 64) * (DM / 64), I_C1 = (1024 / 64) * (512 / 64);
    constexpr int NITEMS = 2 * I_GU + 2 * I_DN + I_IN + 2 * I_UP + I_OUT + 2 * I_C1;
    for (int it = gw; it < NITEMS; it += NGW) {
        int r = it;
        if (r < I_GU) { transpose_item<0>(a, 0, DM, NPROJ, (bf16*)(ws + WS_W1T), scr, r, F.lane); continue; } r -= I_GU;
        if (r < I_GU) { transpose_item<0>(a, 1, DM, NPROJ, (bf16*)(ws + WS_W1T) + (size_t)NPROJ * DM, scr, r, F.lane); continue; } r -= I_GU;
        if (r < I_DN) { transpose_item<1>(a, 0, DFF, DM, (bf16*)(ws + WS_W1D), scr, r, F.lane); continue; } r -= I_DN;
        if (r < I_DN) { transpose_item<1>(a, 1, DFF, DM, (bf16*)(ws + WS_W1D) + (size_t)DM * DFF, scr, r, F.lane); continue; } r -= I_DN;
        if (r < I_IN) { transpose_item<2>(a, 0, DM, NPROJ, (bf16*)(ws + WS_WIN), scr, r, F.lane); continue; } r -= I_IN;
        if (r < I_UP) { transpose_item<3>(a, 0, 512, DM, (bf16*)(ws + WS_WUPM), scr, r, F.lane, 1024); continue; } r -= I_UP;
        if (r < I_UP) { transpose_item<4>(a, 0, 512, DM, (bf16*)(ws + WS_WUPM) + 512, scr, r, F.lane, 1024); continue; } r -= I_UP;
        if (r < I_OUT) { transpose_item<5>(a, 0, DM, DM, (bf16*)(ws + WS_WOUT), scr, r, F.lane); continue; } r -= I_OUT;
        if (r < I_C1) { transpose_item<6>(a, 0, 1024, 512, (bf16*)(ws + WS_WC1), scr, r, F.lane); continue; } r -= I_C1;
        transpose_item<6>(a, 1, 1024, 512, (bf16*)(ws + WS_WC1) + (size_t)512 * 1024, scr, r, F.lane);
    }
}

template <int MODE, bool RES_BF = false, bool OUT_BF = false> __device__ __forceinline__ void thin_phase(const Args& a, Frame& F, const void* res_, const bf16* f, void* out_, bf16* u, int s_post, int s_pre, float rw) {
    const float* res = (const float*)res_; const bf16* resb = (const bf16*)res_; float* out = (float*)out_; bf16* outb = (bf16*)out_;
    constexpr int R = 4;
    const float* ada = (const float*)(a.ws + WS_ADA); const float* gains = a.in[I_GAINS];
    const int gw = F.vcu * NWAVES + F.wave, NGW = F.G * NWAVES;
    for (int row0 = gw * R; row0 < T; row0 += NGW * R) {
        const int b = row0 >> 12;
        f32x4 h[R][4]; v2u fw[R][4];
#pragma unroll
        for (int r = 0; r < R; ++r)
#pragma unroll
            for (int j = 0; j < 4; ++j) { if (RES_BF) { const v2u w = __builtin_nontemporal_load((const v2u*)(resb + (size_t)(row0 + r) * DM + 256 * j + 4 * F.lane)); h[r][j] = (f32x4){bflo(w.x), bfhi(w.x), bflo(w.y), bfhi(w.y)}; }
                else h[r][j] = (MODE == 0) ? *(const f32x4*)(res + (size_t)(row0 + r) * DM + 256 * j + 4 * F.lane) : __builtin_nontemporal_load((const f32x4*)(res + (size_t)(row0 + r) * DM + 256 * j + 4 * F.lane));
                if (MODE != 0) fw[r][j] = __builtin_nontemporal_load((const v2u*)(f + (size_t)(row0 + r) * DM + 256 * j + 4 * F.lane)); }
        if (MODE != 0) {
            const float* gp = gains + (2 * s_post + 1) * DM; const float* gt = ada + (size_t)b * 9216 + (s_post * 3 + 2) * DM;
            f32x4 g4[4], t4[4];
#pragma unroll
            for (int j = 0; j < 4; ++j) { g4[j] = *(const f32x4*)(gp + 256 * j + 4 * F.lane); t4[j] = *(const f32x4*)(gt + 256 * j + 4 * F.lane) * rw; }
#pragma unroll
            for (int r = 0; r < R; ++r) { f32x4 fv[4]; float ss = 0.f;
#pragma unroll
                for (int j = 0; j < 4; ++j) { const v2u w = fw[r][j]; fv[j] = (f32x4){bflo(w.x), bfhi(w.x), bflo(w.y), bfhi(w.y)};
                    ss += fv[j][0] * fv[j][0] + fv[j][1] * fv[j][1] + fv[j][2] * fv[j][2] + fv[j][3] * fv[j][3]; }
                const float rstd = rsqrtf(wave_sum(ss) * (1.f / DM) + EPS);
#pragma unroll
                for (int j = 0; j < 4; ++j) { h[r][j] = h[r][j] + t4[j] * (fv[j] * rstd * g4[j]);
                    if (OUT_BF) { v2u w; w.x = pk2(h[r][j][0], h[r][j][1]); w.y = pk2(h[r][j][2], h[r][j][3]); __builtin_nontemporal_store(w, (v2u*)(outb + (size_t)(row0 + r) * DM + 256 * j + 4 * F.lane)); }
                    else __builtin_nontemporal_store(h[r][j], (f32x4*)(out + (size_t)(row0 + r) * DM + 256 * j + 4 * F.lane)); } }
        }
        if (MODE != 2) {
            const float* gp = gains + (2 * s_pre) * DM; const float* sh = ada + (size_t)b * 9216 + (s_pre * 3 + 0) * DM; const float* sc = sh + DM;
            f32x4 g4[4], s4[4], c4[4];
#pragma unroll
            for (int j = 0; j < 4; ++j) { g4[j] = *(const f32x4*)(gp + 256 * j + 4 * F.lane); s4[j] = *(const f32x4*)(sh + 256 * j + 4 * F.lane); c4[j] = 1.f + *(const f32x4*)(sc + 256 * j + 4 * F.lane); }
#pragma unroll
            for (int r = 0; r < R; ++r) { float ss = 0.f;
#pragma unroll
                for (int j = 0; j < 4; ++j) ss += h[r][j][0] * h[r][j][0] + h[r][j][1] * h[r][j][1] + h[r][j][2] * h[r][j][2] + h[r][j][3] * h[r][j][3];
                const float rstd = rsqrtf(wave_sum(ss) * (1.f / DM) + EPS);
#pragma unroll
                for (int j = 0; j < 4; ++j) { const f32x4 y = (h[r][j] * rstd * g4[j]) * c4[j] + s4[j];
                    v2u w; w.x = pk2(y[0], y[1]); w.y = pk2(y[2], y[3]);
                    *(v2u*)(u + (size_t)(row0 + r) * DM + 256 * j + 4 * F.lane) = w; } }
        }
    }
}

constexpr int MQ_OFF = 0, MK_OFF = 64 * 129 * 4, MV_OFF = 2 * 64 * 129 * 4, MS_OFF = 3 * 64 * 129 * 4, MCT_OFF = MS_OFF + 64 * 65 * 4, MVEC_OFF = MCT_OFF + 128 * 130 * 2;
static_assert(MVEC_OFF + 8 * 256 <= MISC_OFF, "mlstm lds");
template <bool WANTQ> __device__ __forceinline__ void mlstm_load_chunk(const Args& a, Frame& F, int b, int h, int c) {
    unsigned char* rc = a.ws + WS_RC;
    const bf16* qm = (const bf16*)(rc + RC_QM); const bf16* km = (const bf16*)(rc + RC_KM); const bf16* vm = (const bf16*)(rc + RC_VM); const float* ifm = (const float*)(rc + RC_IF);
    LAS float* Qs = (LAS float*)(F.lds + MQ_OFF); LAS float* Ks = (LAS float*)(F.lds + MK_OFF); LAS float* Vs = (LAS float*)(F.lds + MV_OFF);
    LAS float* bcum = (LAS float*)(F.lds + MVEC_OFF); LAS float* ig = bcum + 64;
    const int t0 = c * CHUNK; const size_t row0 = (size_t)b * SEQ + t0;
    if (F.tid < 64) { const float* g = ifm + (row0 + F.tid) * 8; const float fp = g[4 + h] + a.in[I_GATEB][4 + h];
        ig[F.tid] = g[h] + a.in[I_GATEB][h];
        bcum[F.tid] = fminf(fp, 0.f) - log1pf(__expf(-fabsf(fp))); }
    __syncthreads();
    if (F.tid == 0) { float s = 0.f; for (int i = 0; i < 64; ++i) { s += bcum[i]; bcum[i] = s; } }
    const float* cw = a.in[I_CONVW]; const float* cb = a.in[I_CONVB];
    for (int idx = F.tid; idx < 64 * 128; idx += NTHREADS) { const int t = idx >> 7, d = idx & 127, ch = h * 128 + d;
        float accq = cb[ch], acck = cb[512 + ch];
#pragma unroll
        for (int j = 0; j < 4; ++j) { const int tt = t0 + t - 3 + j; if (tt >= 0) { const size_t r = (size_t)b * SEQ + tt;
                if (WANTQ) accq += cw[j * 1024 + ch] * bf2f(qm[r * 512 + ch]);
                acck += cw[j * 1024 + 512 + ch] * bf2f(km[r * 512 + ch]); } }
        if (WANTQ) Qs[t * 129 + d] = siluf_(accq);
        Ks[t * 129 + d] = siluf_(acck) * 0.08838834764831845f;
        Vs[t * 129 + d] = bf2f(vm[(row0 + t) * 512 + ch]); }
    __syncthreads();
}
__device__ __forceinline__ void mlstm_local_unit(const Args& a, Frame& F, int unit) {
    const int c = unit & 63, h = (unit >> 6) & 3, b = unit >> 8;
    mlstm_load_chunk<false>(a, F, b, h, c);
    LAS float* Ks = (LAS float*)(F.lds + MK_OFF); LAS float* Vs = (LAS float*)(F.lds + MV_OFF);
    LAS float* bcum = (LAS float*)(F.lds + MVEC_OFF); LAS float* ig = bcum + 64; LAS float* wv = bcum + 128;
    const float blast = bcum[63];
    float g = -1e30f; if (F.tid < 64) g = blast - bcum[F.tid] + ig[F.tid];
    float mloc = 0.f;
    if (F.wave == 0) { mloc = wave_max(g); wv[F.tid] = __expf(g - mloc); if (F.tid == 0) { float* cs = (float*)(a.ws + WS_CSC) + (size_t)unit * 2; cs[0] = blast; cs[1] = mloc; } }
    __syncthreads();
    const int e = F.tid >> 2, dq = (F.tid & 3) * 32;
    float acc[32];
#pragma unroll
    for (int i = 0; i < 32; ++i) acc[i] = 0.f;
    for (int s = 0; s < 64; ++s) { const float vv = Vs[s * 129 + e] * wv[s];
#pragma unroll
        for (int i = 0; i < 32; ++i) acc[i] += vv * Ks[s * 129 + dq + i]; }
    bf16* st = (bf16*)(a.ws + WS_RB) + (size_t)unit * 16384 + e * 128 + dq;
#pragma unroll
    for (int i = 0; i < 32; i += 8) { v4u w; w.x = pk2(acc[i], acc[i + 1]); w.y = pk2(acc[i + 2], acc[i + 3]); w.z = pk2(acc[i + 4], acc[i + 5]); w.w = pk2(acc[i + 6], acc[i + 7]); *(v4u*)(st + i) = w; }
    if (F.tid < 128) { float s = 0.f; for (int t = 0; t < 64; ++t) s += wv[t] * Ks[t * 129 + F.tid]; ((float*)(a.ws + WS_NST))[(size_t)unit * 128 + F.tid] = s; }
    __syncthreads();
}
__device__ __forceinline__ void mlstm_scan(const Args& a, Frame& F) {
    const float* csc = (const float*)(a.ws + WS_CSC); float* mprev = (float*)(a.ws + WS_MPREV);
    bf16* st = (bf16*)(a.ws + WS_RB); float* nst = (float*)(a.ws + WS_NST);
    const int gt = F.vcu * NTHREADS + F.tid, NGT = F.G * NTHREADS;
    LAS float* tab = (LAS float*)F.lds;
    for (int idx = gt; idx < 64 * 2048; idx += NGT) { const int bh = idx >> 11, p = idx & 2047;
        __syncthreads();
        if (F.tid == 0) { float m = 0.f; for (int c = 0; c < 64; ++c) { const float bl = csc[(bh * 64 + c) * 2], ml = csc[(bh * 64 + c) * 2 + 1]; const float mn = fmaxf(bl + m, ml); tab[2 * c] = __expf(bl + m - mn); tab[2 * c + 1] = __expf(ml - mn); m = mn; } }
        __syncthreads();
        float cv[8];
#pragma unroll
        for (int i = 0; i < 8; ++i) cv[i] = 0.f;
        v4u* base = (v4u*)(st + (size_t)(bh * 64) * 16384) + p;
#pragma unroll 1
        for (int c0 = 0; c0 < 64; c0 += 8) { v4u uw[8];
#pragma unroll
            for (int k = 0; k < 8; ++k) uw[k] = base[(size_t)(c0 + k) * 2048];
#pragma unroll
            for (int k = 0; k < 8; ++k) { const int c = c0 + k;
                v4u o; o.x = pk2(cv[0], cv[1]); o.y = pk2(cv[2], cv[3]); o.z = pk2(cv[4], cv[5]); o.w = pk2(cv[6], cv[7]); base[(size_t)c * 2048] = o;
                const float dec = tab[2 * c], sc = tab[2 * c + 1];
                float x[8]; unpack8(uw[k], x);
#pragma unroll
                for (int i = 0; i < 8; ++i) cv[i] = dec * cv[i] + sc * x[i]; } } }
    __syncthreads();
    for (int idx = gt; idx < 64 * 128; idx += NGT) { const int bh = idx >> 7, d = idx & 127;
        float m = 0.f, n = 0.f;
        float* base = nst + (size_t)(bh * 64) * 128 + d;
#pragma unroll 1
        for (int c0 = 0; c0 < 64; c0 += 16) { float nl[16];
#pragma unroll
            for (int k = 0; k < 16; ++k) nl[k] = base[(size_t)(c0 + k) * 128];
#pragma unroll
            for (int k = 0; k < 16; ++k) { const int c = c0 + k; base[(size_t)c * 128] = n;
                if (d == 0) mprev[bh * 64 + c] = m;
                const float bl = csc[(bh * 64 + c) * 2], ml = csc[(bh * 64 + c) * 2 + 1];
                const float mn = fmaxf(bl + m, ml), dec = __expf(bl + m - mn), sc = __expf(ml - mn);
                n = dec * n + sc * nl[k]; m = mn; } } }
}
__device__ __forceinline__ void mlstm_out_unit(const Args& a, Frame& F, int unit) {
    const int c = unit & 63, h = (unit >> 6) & 3, b = unit >> 8;
    mlstm_load_chunk<true>(a, F, b, h, c);
    LAS float* Qs = (LAS float*)(F.lds + MQ_OFF); LAS float* Ks = (LAS float*)(F.lds + MK_OFF); LAS float* Vs = (LAS float*)(F.lds + MV_OFF); LAS float* Ss = (LAS float*)(F.lds + MS_OFF);
    LAS bf16* CT = (LAS bf16*)(F.lds + MCT_OFF);
    LAS float* bcum = (LAS float*)(F.lds + MVEC_OFF); LAS float* ig = bcum + 64; LAS float* mt = bcum + 128; LAS float* wi = bcum + 192; LAS float* den = bcum + 256; LAS float* nv = bcum + 320;
    const float mp = ((const float*)(a.ws + WS_MPREV))[unit];
    const bf16* ctg = (const bf16*)(a.ws + WS_RB) + (size_t)unit * 16384;
    for (int idx = F.tid; idx < 128 * 64; idx += NTHREADS) { const int e = idx >> 6, dp = idx & 63; *(LAS unsigned*)(CT + e * 130 + 2 * dp) = *(const unsigned*)(ctg + e * 128 + 2 * dp); }
    if (F.tid < 128) nv[F.tid] = ((const float*)(a.ws + WS_NST))[(size_t)unit * 128 + F.tid];
    if (F.tid < 64) { const int t = F.tid; const float bt = bcum[t], at = bt + mp; float mm = at;
        for (int s = 0; s <= t; ++s) mm = fmaxf(mm, bt - bcum[s] + ig[s]);
        mt[t] = mm; wi[t] = __expf(at - mm); }
    __syncthreads();
    { const int s = F.tid & 63, tb = (F.tid >> 6) * 8;
#pragma unroll
        for (int i = 0; i < 8; ++i) { const int t = tb + i; float v = 0.f;
            if (s <= t) { float d = 0.f; for (int k = 0; k < 128; ++k) d += Qs[t * 129 + k] * Ks[s * 129 + k]; v = d * __expf(bcum[t] - bcum[s] + ig[s] - mt[t]); }
            Ss[t * 65 + s] = v; } }
    __syncthreads();
    if (F.tid < 64) { const int t = F.tid; float sd = 0.f; for (int s = 0; s <= t; ++s) sd += Ss[t * 65 + s]; float qn = 0.f; for (int k = 0; k < 128; ++k) qn += Qs[t * 129 + k] * nv[k];
        den[t] = sd + wi[t] * qn; }
    const int t = F.tid >> 3, e0 = (F.tid & 7) * 16;
    float num[16], qc[16];
#pragma unroll
    for (int i = 0; i < 16; ++i) { num[i] = 0.f; qc[i] = 0.f; }
    for (int s = 0; s <= t; ++s) { const float sv = Ss[t * 65 + s];
#pragma unroll
        for (int i = 0; i < 16; ++i) num[i] += sv * Vs[s * 129 + e0 + i]; }
    for (int k = 0; k < 128; ++k) { const float qv = Qs[t * 129 + k];
#pragma unroll
        for (int i = 0; i < 16; ++i) qc[i] += qv * bf2f(CT[(e0 + i) * 130 + k]); }
    __syncthreads();
    const float dn = fmaxf(fabsf(den[t]), __expf(-mt[t])), wt = wi[t];
    float ss = 0.f;
#pragma unroll
    for (int i = 0; i < 16; ++i) { num[i] = (num[i] + wt * qc[i]) / dn; ss += num[i] * num[i]; }
    ss += __shfl_xor(ss, 1); ss += __shfl_xor(ss, 2); ss += __shfl_xor(ss, 4);
    const float rstd = rsqrtf(ss * (1.f / 128.f) + EPS);
    const size_t row = (size_t)b * SEQ + c * CHUNK + t; const int ch = h * 128 + e0;
    const bf16* om = (const bf16*)(a.ws + WS_RC + RC_OM) + row * 512 + ch; const float* hg = a.in[I_HGAIN] + ch;
    float o[16];
#pragma unroll
    for (int i = 0; i < 16; ++i) o[i] = sigmoidf_(bf2f(om[i])) * num[i] * rstd * hg[i];
    bf16* hm = (bf16*)(a.ws + WS_RA) + row * 1024 + ch;
#pragma unroll
    for (int i = 0; i < 16; i += 8) { v4u w; w.x = pk2(o[i], o[i + 1]); w.y = pk2(o[i + 2], o[i + 3]); w.z = pk2(o[i + 4], o[i + 5]); w.w = pk2(o[i + 6], o[i + 7]); *(v4u*)(hm + i) = w; }
    __syncthreads();
}

__device__ __forceinline__ void compress_l2(const Args& a, Frame& F) {
    LAS float* hid = (LAS float*)(F.lds + F.wave * 4096);
    const int gw = F.vcu * NWAVES + F.wave, NGW = F.G * NWAVES;
    for (int kv = 0; kv < 2; ++kv) {
        const float* P = (const float*)(a.ws + WS_RA) + (size_t)kv * 8192 * 512; const float* b1p = (const float*)(a.ws + WS_B1P) + kv * 16 * 256;
        const float* w2 = a.in[I_CW2] + (size_t)kv * 256 * 64; bf16* outp = (bf16*)(a.ws + WS_KCMP) + (size_t)kv * 8192 * 64;
        for (int r0 = gw; r0 < 8192; r0 += 4 * NGW) {
            float pv[4][8];
#pragma unroll
            for (int q = 0; q < 4; ++q) { const int m0 = r0 + q * NGW; const bool ok = m0 < 8192 && (m0 & 255) != NCMP;
#pragma unroll
                for (int jj = 0; jj < 4; ++jj) { const int cc = jj * 64 + F.lane; pv[q][2 * jj] = ok ? P[(size_t)m0 * 512 + cc] : 0.f; pv[q][2 * jj + 1] = ok ? P[(size_t)(m0 + 1) * 512 + 256 + cc] : 0.f; } }
            float bb[4];
#pragma unroll
            for (int jj = 0; jj < 4; ++jj) { float t = a.in[I_CB1][kv * 256 + jj * 64 + F.lane];
#pragma unroll
                for (int pt = 0; pt < 16; ++pt) t += b1p[pt * 256 + jj * 64 + F.lane];
                bb[jj] = t; }
#pragma unroll
            for (int q = 0; q < 4; ++q)
#pragma unroll
                for (int jj = 0; jj < 4; ++jj) hid[q * 256 + jj * 64 + F.lane] = siluf_(pv[q][2 * jj] + pv[q][2 * jj + 1] + bb[jj]);
            LDS_WAIT();
            float sacc[4]; const float b2 = a.in[I_CB2][kv * 64 + F.lane];
#pragma unroll
            for (int q = 0; q < 4; ++q) sacc[q] = b2;
#pragma unroll 1
            for (int c0 = 0; c0 < 256; c0 += 32) { float wv[32];
#pragma unroll
                for (int i = 0; i < 32; ++i) wv[i] = w2[(c0 + i) * 64 + F.lane];
#pragma unroll
                for (int i = 0; i < 32; ++i)
#pragma unroll
                    for (int q = 0; q < 4; ++q) sacc[q] += hid[q * 256 + c0 + i] * wv[i]; }
#pragma unroll
            for (int q = 0; q < 4; ++q) { const int m0 = r0 + q * NGW; if (m0 < 8192) outp[(size_t)m0 * 64 + F.lane] = ((m0 & 255) == NCMP) ? (bf16)0 : (bf16)f2bf(sacc[q]); }
            LDS_WAIT();
        }
    }
}

struct AttState { float m[4], l[4], o[4]; };
__device__ __forceinline__ void nsa_dot4(const bf16* krow, const LAS float* qs, float (&s)[4]) {
    s[0] = s[1] = s[2] = s[3] = 0.f;
#pragma unroll
    for (int c8 = 0; c8 < 8; ++c8) { const v4u kw = *(const v4u*)(krow + c8 * 8);
        float kf[8] = {bflo(kw.x), bfhi(kw.x), bflo(kw.y), bfhi(kw.y), bflo(kw.z), bfhi(kw.z), bflo(kw.w), bfhi(kw.w)};
#pragma unroll
        for (int h = 0; h < 4; ++h)
#pragma unroll
            for (int i = 0; i < 8; ++i) s[h] += kf[i] * qs[h * 64 + c8 * 8 + i]; }
}
__device__ __forceinline__ void nsa_attend(AttState& A, const bf16* Kb, const bf16* Vb, int base, int t, const LAS float* qs, LAS float* pl, int lane) {
    const int pos = base + lane; const bool valid = pos >= 0 && pos <= t;
    float s[4] = {0.f, 0.f, 0.f, 0.f};
    if (valid) nsa_dot4(Kb + (size_t)pos * 64, qs, s);
#pragma unroll
    for (int h = 0; h < 4; ++h) { const float mb = wave_max(valid ? s[h] : -1e30f), mn = fmaxf(A.m[h], mb), al = __expf(A.m[h] - mn), p = valid ? __expf(s[h] - mn) : 0.f;
        A.l[h] = A.l[h] * al + wave_sum(p); A.o[h] *= al; A.m[h] = mn; pl[h * 64 + lane] = p; }
    LDS_WAIT();
    const int k0 = base < 0 ? -base : 0, k1 = (t - base) < 63 ? (t - base) : 63;
    for (int kk = k0; kk <= k1; ++kk) { const float v = bf2f(Vb[(size_t)(base + kk) * 64 + lane]);
#pragma unroll
        for (int h = 0; h < 4; ++h) A.o[h] += pl[h * 64 + kk] * v; }
    LDS_WAIT();
}
__device__ __forceinline__ void nsa_query(const Args& a, Frame& F, int qid, LAS float* wl) {
    const int t = qid & 4095, g = (qid >> 12) & 1, b = qid >> 13, bg = b * 2 + g, lane = F.lane;
    const size_t row = (size_t)b * SEQ + t;
    unsigned char* rc = a.ws + WS_RC;
    LAS float* qs = wl; LAS float* pc = wl + 256; LAS float* ps = wl + 512; LAS float* pl = wl + 768;
    const bf16* qn = (const bf16*)(rc + RC_QN) + row * 512 + g * 256;
#pragma unroll
    for (int h = 0; h < 4; ++h) qs[h * 64 + lane] = bf2f(qn[h * 64 + lane]) * 0.6931471805599453f;
    const float* gg = (const float*)(rc + RC_GG) + row * 24 + g * 12;
    float gate[4][3];
#pragma unroll
    for (int h = 0; h < 4; ++h)
#pragma unroll
        for (int r = 0; r < 3; ++r) gate[h][r] = sigmoidf_(gg[h * 3 + r]);
    LDS_WAIT();
    const bf16* kc = (const bf16*)(a.ws + WS_KCMP) + (size_t)bg * 256 * 64; const bf16* vc = kc + (size_t)32 * 256 * 64;
    const int nvalid = t >= 31 ? ((t - 31) >> 4) + 1 : 0;
    float sc[4][4];
#pragma unroll
    for (int kk = 0; kk < 4; ++kk) { const int n = kk * 64 + lane; float s[4] = {0.f, 0.f, 0.f, 0.f}; if (n < nvalid) nsa_dot4(kc + (size_t)n * 64, qs, s);
#pragma unroll
        for (int h = 0; h < 4; ++h) sc[h][kk] = s[h]; }
    float psum[4] = {0.f, 0.f, 0.f, 0.f}, ocmp[4];
#pragma unroll
    for (int h = 0; h < 4; ++h) { float mx = -1e30f;
#pragma unroll
        for (int kk = 0; kk < 4; ++kk) if (kk * 64 + lane < nvalid) mx = fmaxf(mx, sc[h][kk]);
        mx = wave_max(mx); float e[4], l = 0.f;
#pragma unroll
        for (int kk = 0; kk < 4; ++kk) { e[kk] = (kk * 64 + lane < nvalid) ? __expf(sc[h][kk] - mx) : 0.f; l += e[kk]; }
        l = fmaxf(wave_sum(l), 1e-30f);
#pragma unroll
        for (int kk = 0; kk < 4; ++kk) { const float p = e[kk] / l; psum[kk] += p; pc[kk * 64 + lane] = p; }
        LDS_WAIT();
        float o = 0.f; for (int n = 0; n < nvalid; ++n) o += pc[n] * bf2f(vc[(size_t)n * 64 + lane]);
        ocmp[h] = o; LDS_WAIT(); }
#pragma unroll
    for (int kk = 0; kk < 4; ++kk) ps[kk * 64 + lane] = psum[kk];
    LDS_WAIT();
    const int cur = t >> 6;
    float imp = 0.f;
#pragma unroll
    for (int i = -1; i <= 3; ++i) { const int n = 4 * lane + i; if (n >= 0 && n < NCMP) imp += ps[n]; }
    const bool forced = (lane == 0) || (lane == cur) || (lane == cur - 1);
    const float val = (lane <= cur) ? (forced ? 1e4f : imp) : -1.f;
    int rank = 0;
    for (int i = 0; i < 64; ++i) { const float vi = __shfl(val, i); rank += (vi > val || (vi == val && i < lane)) ? 1 : 0; }
    const unsigned long long mask = __ballot(rank < 16);
    AttState S;
#pragma unroll
    for (int h = 0; h < 4; ++h) { S.m[h] = -1e30f; S.l[h] = 0.f; S.o[h] = 0.f; }
    const bf16* ks = (const bf16*)(rc + RC_KV + 2 * 16 * MiB) + (size_t)bg * 4096 * 64; const bf16* vs = (const bf16*)(rc + RC_KV + 3 * 16 * MiB) + (size_t)bg * 4096 * 64;
    for (int j = 0; j <= cur; ++j) if ((mask >> j) & 1ull) nsa_attend(S, ks, vs, 64 * j, t, qs, pl, lane);
    AttState W;
#pragma unroll
    for (int h = 0; h < 4; ++h) { W.m[h] = -1e30f; W.l[h] = 0.f; W.o[h] = 0.f; }
    const bf16* kw = (const bf16*)(rc + RC_KV + 4 * 16 * MiB) + (size_t)bg * 4096 * 64; const bf16* vw = (const bf16*)(rc + RC_KV + 5 * 16 * MiB) + (size_t)bg * 4096 * 64;
    for (int kk = 0; kk < 4; ++kk) { const int base = t - 255 + 64 * kk; if (base + 63 >= 0) nsa_attend(W, kw, vw, base, t, qs, pl, lane); }
    bf16* outp = (bf16*)(a.ws + WS_RA) + row * 1024 + 512 + g * 256;
#pragma unroll
    for (int h = 0; h < 4; ++h) { const float o = gate[h][0] * ocmp[h] + gate[h][1] * S.o[h] / fmaxf(S.l[h], 1e-30f) + gate[h][2] * W.o[h] / fmaxf(W.l[h], 1e-30f);
        outp[h * 64 + lane] = (bf16)f2bf(o); }
}

typedef float f32x16 __attribute__((ext_vector_type(16)));
typedef short s16x4 __attribute__((ext_vector_type(4)));
typedef float f32x2_t __attribute__((ext_vector_type(2))); typedef __bf16 bf16x2_t __attribute__((ext_vector_type(2)));
constexpr int NKS = 144, NVS = 192;
constexpr int NK_OFF = 0, NKBUF = 64 * NKS, NV_OFF = 4 * NKBUF, NVBUF = 64 * NVS, NPSW = 8 * 260, NPS_OFF = NV_OFF + 4 * NVBUF, NMASK_OFF = NPS_OFF + 8 * NPSW * 4, NWS_OFF = NMASK_OFF + 512, NSA_LDS_END = NWS_OFF + 8 * 256;
static_assert(NSA_LDS_END <= MISC_OFF, "nsa lds");
constexpr float L2E = 1.4426950408889634f;
__device__ __forceinline__ int crow(int r, int hi) { return (r & 3) + 8 * (r >> 2) + 4 * hi; }
__device__ __forceinline__ unsigned cvtpk(float lo, float hi) { f32x2_t v = {lo, hi}; bf16x2_t b = __builtin_convertvector(v, bf16x2_t); return __builtin_bit_cast(unsigned, b); }
__device__ __forceinline__ float max3f(float a, float b, float c) { float r; asm("v_max3_f32 %0, %1, %2, %3" : "=v"(r) : "v"(a), "v"(b), "v"(c)); return r; }
template <int CTRL> __device__ __forceinline__ float dpp_quad(float v) { return __builtin_bit_cast(float, __builtin_amdgcn_update_dpp(0, __builtin_bit_cast(int, v), CTRL, 0xF, 0xF, true)); }
__device__ __forceinline__ float swapmax(float v) { auto rr = __builtin_amdgcn_permlane32_swap(__float_as_uint(v), __float_as_uint(v), false, false); return fmaxf(__uint_as_float(rr[0]), __uint_as_float(rr[1])); }
__device__ __forceinline__ float swapsum(float v) { auto rr = __builtin_amdgcn_permlane32_swap(__float_as_uint(v), __float_as_uint(v), false, false); return __uint_as_float(rr[0]) + __uint_as_float(rr[1]); }
__device__ __forceinline__ s16x4 vtr(const LAS unsigned char* p) { typedef short v4i16_t __attribute__((ext_vector_type(4))); return __builtin_bit_cast(s16x4, __builtin_amdgcn_ds_read_tr16_b64_v4i16((LAS v4i16_t*)p)); }
__device__ __forceinline__ void nsa_qk(f32x16& p0, f32x16& p1, const LAS unsigned char* kb, const bf16x8 (&qr)[4], const f32x16& cinit, int r32, int hi) {
    const LAS unsigned char* kp = kb + r32 * NKS + hi * 16;
    bf16x8 kf[8];
#pragma unroll
    for (int d0 = 0; d0 < 4; ++d0) { kf[2 * d0] = *(const LAS bf16x8*)(kp + d0 * 32); kf[2 * d0 + 1] = *(const LAS bf16x8*)(kp + 32 * NKS + d0 * 32); }
    __builtin_amdgcn_sched_barrier(0);
    p0 = __builtin_amdgcn_mfma_f32_32x32x16_bf16(kf[0], qr[0], cinit, 0, 0, 0); p1 = __builtin_amdgcn_mfma_f32_32x32x16_bf16(kf[1], qr[0], cinit, 0, 0, 0);
#pragma unroll
    for (int d0 = 1; d0 < 4; ++d0) { p0 = __builtin_amdgcn_mfma_f32_32x32x16_bf16(kf[2 * d0], qr[d0], p0, 0, 0, 0); p1 = __builtin_amdgcn_mfma_f32_32x32x16_bf16(kf[2 * d0 + 1], qr[d0], p1, 0, 0, 0); }
}
__device__ __forceinline__ void nsa_vload(bf16x8 (&vf)[4], const LAS unsigned char* vb, int lane, int d0) {
    const int hi = lane >> 5, blk = (lane >> 4) & 1, q = (lane & 15) >> 2, p = lane & 3;
    const LAS unsigned char* base = vb + (4 * hi + q) * NVS + (16 * blk + 4 * p) * 2 + d0 * 64;
#pragma unroll
    for (int ks = 0; ks < 4; ++ks) { const s16x4 lo = vtr(base + (ks * 16) * NVS), hh = vtr(base + (ks * 16 + 8) * NVS);
        vf[ks] = (bf16x8){lo[0], lo[1], lo[2], lo[3], hh[0], hh[1], hh[2], hh[3]}; }
}
__device__ __forceinline__ void nsa_pv(f32x16& o, const bf16x8 (&vf)[4], const bf16x8 (&pa)[4]) {
#pragma unroll
    for (int ks = 0; ks < 4; ++ks) o = __builtin_amdgcn_mfma_f32_32x32x16_bf16(pa[ks], vf[ks], o, 0, 0, 0);
}
__device__ __forceinline__ void nsa_pack(bf16x8 (&pa)[4], const f32x16& p0, const f32x16& p1) {
    v4u w;
    w.x = cvtpk(p0[0], p0[1]); w.y = cvtpk(p0[2], p0[3]); w.z = cvtpk(p0[4], p0[5]); w.w = cvtpk(p0[6], p0[7]); pa[0] = __builtin_bit_cast(bf16x8, w);
    w.x = cvtpk(p0[8], p0[9]); w.y = cvtpk(p0[10], p0[11]); w.z = cvtpk(p0[12], p0[13]); w.w = cvtpk(p0[14], p0[15]); pa[1] = __builtin_bit_cast(bf16x8, w);
    w.x = cvtpk(p1[0], p1[1]); w.y = cvtpk(p1[2], p1[3]); w.z = cvtpk(p1[4], p1[5]); w.w = cvtpk(p1[6], p1[7]); pa[2] = __builtin_bit_cast(bf16x8, w);
    w.x = cvtpk(p1[8], p1[9]); w.y = cvtpk(p1[10], p1[11]); w.z = cvtpk(p1[12], p1[13]); w.w = cvtpk(p1[14], p1[15]); pa[3] = __builtin_bit_cast(bf16x8, w);
}
__device__ __forceinline__ void row_bcast(float v, LAS float* wsf, int r32, int hi, float (&f)[16]) {
    if (hi == 0) wsf[r32] = v;
#pragma unroll
    for (int r = 0; r < 16; ++r) f[r] = wsf[crow(r, hi)];
}
constexpr float NSA_THR = 5.f;
__device__ __forceinline__ void nsa_step(const int VAR, f32x16& p0, f32x16& p1, float& mhat, f32x16& negm, f32x16 (&o)[2], f32x16& ol, int diag, bool rowvalid, bool allvalid, int rel, const LAS unsigned char* vb, LAS float* wsf, int lane, int r32, int hi) {
    bf16x8 vf[4]; nsa_vload(vf, vb, lane, 0);
    __builtin_amdgcn_sched_barrier(0);
    asm volatile("s_nop 15\n\ts_nop 7" : "+v"(p0), "+v"(p1));
    if (diag == 1) {
#pragma unroll
        for (int r = 0; r < 16; ++r) { const int kv = crow(r, hi); p0[r] = kv <= rel ? p0[r] : -INFINITY; p1[r] = kv + 32 <= rel ? p1[r] : -INFINITY; }
    } else if (diag == 2) {
#pragma unroll
        for (int r = 0; r < 16; ++r) { const int kv = crow(r, hi); p0[r] = kv > rel ? p0[r] : -INFINITY; p1[r] = kv + 32 > rel ? p1[r] : -INFINITY; }
    }
    float mx = max3f(p0[0], p1[0], -INFINITY);
#pragma unroll
    for (int r = 1; r < 16; ++r) mx = max3f(mx, p0[r], p1[r]);
    mx = rowvalid ? mx : -INFINITY;
    mx = swapmax(mx);
    if (__any(mx > NSA_THR)) {
        const float dl = fmaxf(mx, 0.f); mhat += dl;
#pragma unroll
        for (int r = 0; r < 16; ++r) { p0[r] -= dl; p1[r] -= dl; negm[r] = -mhat; }
        float f[16]; row_bcast(__builtin_amdgcn_exp2f(-dl), wsf, r32, hi, f);
#pragma unroll
        for (int r = 0; r < 16; ++r) { o[0][r] *= f[r]; o[1][r] *= f[r]; ol[r] *= f[r]; } }
#pragma unroll
    for (int r = 0; r < 16; ++r) { if (VAR == 2) { p0[r] += 1.f; p1[r] += 1.f; } else { p0[r] = __builtin_amdgcn_exp2f(p0[r]); p1[r] = __builtin_amdgcn_exp2f(p1[r]); } }
    bf16x8 pa[4]; nsa_pack(pa, p0, p1);
    if (!allvalid) { const short km = rowvalid ? (short)-1 : (short)0;
#pragma unroll
        for (int k = 0; k < 4; ++k) { v4u w = __builtin_bit_cast(v4u, pa[k]); const unsigned mk = rowvalid ? 0xffffffffu : 0u; w.x &= mk; w.y &= mk; w.z &= mk; w.w &= mk; pa[k] = __builtin_bit_cast(bf16x8, w); }
        (void)km; }
    __builtin_amdgcn_sched_barrier(0);
    if (VAR != 3) { bf16x8 vg[4]; nsa_vload(vg, vb, lane, 1);
        __builtin_amdgcn_sched_barrier(0);
        nsa_pv(o[0], vf, pa);
        const bf16x8 ones = (bf16x8){0x3f80, 0x3f80, 0x3f80, 0x3f80, 0x3f80, 0x3f80, 0x3f80, 0x3f80};
#pragma unroll
        for (int ks = 0; ks < 4; ++ks) ol = __builtin_amdgcn_mfma_f32_32x32x16_bf16(pa[ks], ones, ol, 0, 0, 0);
        nsa_pv(o[1], vg, pa); }
}
__device__ __forceinline__ void nsa_unit(const int VAR, const Args& a, Frame& F, int bg, int qt, bf16* outbase) {
    const int lane = F.lane, r32 = lane & 31, hi = lane >> 5, w = F.wave, tid = F.tid;
    const int qi = r32 >> 2, h = r32 & 3, t0 = qt * 64, rel = 8 * w + qi, t = t0 + rel, cur = qt, b = bg >> 1, g = bg & 1;
    const size_t row = (size_t)b * SEQ + t;
    unsigned char* rc = a.ws + WS_RC;
    LAS float* PS = (LAS float*)(F.lds + NPS_OFF) + w * NPSW;
    LAS unsigned long long* MASKS = (LAS unsigned long long*)(F.lds + NMASK_OFF);
    LAS float* wsf = (LAS float*)(F.lds + NWS_OFF) + w * 64;
    const int srow = tid >> 3, sch = tid & 7;
    v4u kreg, vreg;
#define NSA_LOADK(ptr) kreg = *(const v4u*)((ptr) + srow * 64 + sch * 8)
#define NSA_LOADV(ptr) vreg = *(const v4u*)((ptr) + srow * 64 + sch * 8)
#define NSA_STOREK(bi) *(LAS v4u*)(F.lds + NK_OFF + (bi) * NKBUF + srow * NKS + sch * 16) = kreg
#define NSA_STOREV(bi) *(LAS v4u*)(F.lds + NV_OFF + (bi) * NVBUF + srow * NVS + sch * 16) = vreg
#define NSA_KB(bi) (F.lds + NK_OFF + (bi) * NKBUF)
#define NSA_VB(bi) (F.lds + NV_OFF + (bi) * NVBUF)
    bf16x8 qr[4];
    { const bf16* qp = (const bf16*)(rc + RC_QN) + row * 512 + (g * 4 + h) * 64 + hi * 8;
#pragma unroll
      for (int d0 = 0; d0 < 4; ++d0) qr[d0] = *(const bf16x8*)(qp + d0 * 16); }
    float g0, g1, g2;
    { const float* gg = (const float*)(rc + RC_GG) + row * 24 + (g * 4 + h) * 3; g0 = sigmoidf_(gg[0]); g1 = sigmoidf_(gg[1]); g2 = sigmoidf_(gg[2]); }
    f32x16 o[2], p0, p1, ol, negm, zero16;
#pragma unroll
    for (int i = 0; i < 16; ++i) zero16[i] = 0.f;
    float f16[16];
    const bf16* kc = (const bf16*)(a.ws + WS_KCMP) + (size_t)bg * 256 * 64; const bf16* vc = kc + (size_t)32 * 256 * 64;
    const int nvmax = (t0 / 16 + 3) < 255 ? (t0 / 16 + 3) : 255, nb = (VAR == 7) ? 0 : ((nvmax + 63) >> 6);
    const int nv = t >= 31 ? ((t - 31) >> 4) + 1 : 0;
    float m = -1e30f, l = 0.f;
    { v4u ck[4], cv[4];
#pragma unroll
      for (int cb = 0; cb < 4; ++cb) if (cb < nb) { ck[cb] = *(const v4u*)(kc + cb * 4096 + srow * 64 + sch * 8); cv[cb] = *(const v4u*)(vc + cb * 4096 + srow * 64 + sch * 8); }
#pragma unroll
      for (int cb = 0; cb < 4; ++cb) if (cb < nb) { *(LAS v4u*)(F.lds + NK_OFF + cb * NKBUF + srow * NKS + sch * 16) = ck[cb]; *(LAS v4u*)(F.lds + NV_OFF + cb * NVBUF + srow * NVS + sch * 16) = cv[cb]; } }
#pragma unroll
    for (int i = 0; i < 9; ++i) { const int idx = i * 256 + lane * 4; if (idx < NPSW) *(LAS f32x4*)(PS + idx) = (f32x4){0.f, 0.f, 0.f, 0.f}; }
    __syncthreads();
#pragma unroll 1
    for (int cb = 0; cb < nb; ++cb) {
        nsa_qk(p0, p1, NSA_KB(cb), qr, zero16, r32, hi);
        float mx = -1e30f;
#pragma unroll
        for (int r = 0; r < 16; ++r) { const int n0 = cb * 64 + crow(r, hi); p0[r] = n0 < nv ? p0[r] : -1e30f; p1[r] = n0 + 32 < nv ? p1[r] : -1e30f; mx = fmaxf(mx, fmaxf(p0[r], p1[r])); }
        mx = swapmax(mx);
        const float mnew = fmaxf(m, mx); l *= __builtin_amdgcn_exp2f(m - mnew); m = mnew; const float nm = mnew < -1e29f ? 0.f : -mnew;
        float s = 0.f;
#pragma unroll
        for (int r = 0; r < 16; ++r) s += __builtin_amdgcn_exp2f(p0[r] + nm) + __builtin_amdgcn_exp2f(p1[r] + nm);
        l += s;
    }
    l = swapsum(l);
    const float inv_l = 1.f / l, nmc = m < -1e29f ? 0.f : -m;
#pragma unroll
    for (int i = 0; i < 16; ++i) { o[0][i] = 0.f; o[1][i] = 0.f; }
#pragma unroll 1
    for (int cb = 0; cb < nb; ++cb) {
        nsa_qk(p0, p1, NSA_KB(cb), qr, zero16, r32, hi);
#pragma unroll
        for (int r = 0; r < 16; ++r) { const int n0 = cb * 64 + crow(r, hi);
            p0[r] = n0 < nv ? __builtin_amdgcn_exp2f(p0[r] + nmc) * inv_l : 0.f; p1[r] = n0 + 32 < nv ? __builtin_amdgcn_exp2f(p1[r] + nmc) * inv_l : 0.f;
            float v0 = p0[r], v1 = p1[r]; v0 += dpp_quad<0xB1>(v0); v1 += dpp_quad<0xB1>(v1); v0 += dpp_quad<0x4E>(v0); v1 += dpp_quad<0x4E>(v1);
            if (h == 0) { PS[qi * 260 + n0] = v0; PS[qi * 260 + n0 + 32] = v1; } }
        bf16x8 pa[4]; nsa_pack(pa, p0, p1);
        { bf16x8 vf[4], vg[4]; nsa_vload(vf, NSA_VB(cb), lane, 0); nsa_vload(vg, NSA_VB(cb), lane, 1); __builtin_amdgcn_sched_barrier(0); nsa_pv(o[0], vf, pa); nsa_pv(o[1], vg, pa); }
    }
    if (cur >= 16) {
#pragma unroll 1
        for (int qq = 0; qq < 8; ++qq) { const LAS float* pq = PS + qq * 260;
            const f32x4 q4 = *(const LAS f32x4*)(pq + 4 * lane);
            float imp = (q4[0] + q4[1]) + (q4[2] + q4[3]); if (lane > 0) imp += pq[4 * lane - 1];
            const bool forced = (lane == 0) || (lane == cur) || (lane == cur - 1);
            const float val = (lane <= cur) ? (forced ? 1e4f : imp) : -1.f;
            wsf[lane] = val;
            int rank = 0;
#pragma unroll
            for (int i4 = 0; i4 < 16; ++i4) { const f32x4 v4 = *(const LAS f32x4*)(wsf + 4 * i4);
#pragma unroll
                for (int e = 0; e < 4; ++e) { const int i = 4 * i4 + e; rank += (v4[e] > val || (v4[e] == val && i < lane)) ? 1 : 0; } }
            const unsigned long long mk = __ballot(rank < 16);
            if (lane == 0) MASKS[w * 8 + qq] = mk; }
    } else { if (lane < 8) MASKS[w * 8 + lane] = (2ull << cur) - 1ull; }
    __syncthreads();
    const unsigned long long mym = MASKS[w * 8 + qi];
    unsigned long long um = MASKS[lane];
#pragma unroll
    for (int off = 1; off < 64; off <<= 1) { const unsigned lo_ = __shfl_xor((unsigned)um, off), hi_ = __shfl_xor((unsigned)(um >> 32), off); um |= ((unsigned long long)hi_ << 32) | lo_; }
    um &= (2ull << cur) - 1ull;
    unsigned long long rem = ((unsigned long long)__builtin_amdgcn_readfirstlane((unsigned)(um >> 32)) << 32) | (unsigned)__builtin_amdgcn_readfirstlane((unsigned)um);
    row_bcast(g0, wsf, r32, hi, f16);
#pragma unroll
    for (int r = 0; r < 16; ++r) { PS[(2 * r) * 64 + lane] = o[0][r] * f16[r]; PS[(2 * r + 1) * 64 + lane] = o[1][r] * f16[r]; }
    const bf16* ks = (const bf16*)(rc + RC_KV + 2 * 16 * MiB) + (size_t)bg * 4096 * 64; const bf16* vs = (const bf16*)(rc + RC_KV + 3 * 16 * MiB) + (size_t)bg * 4096 * 64;
    const bf16* kw = (const bf16*)(rc + RC_KV + 4 * 16 * MiB) + (size_t)bg * 4096 * 64; const bf16* vw = (const bf16*)(rc + RC_KV + 5 * 16 * MiB) + (size_t)bg * 4096 * 64;
    float mhat = 0.f;
#pragma unroll
    for (int i = 0; i < 16; ++i) { o[0][i] = 0.f; o[1][i] = 0.f; ol[i] = 0.f; negm[i] = 0.f; }
    {
        const int j0w = cur >= 4 ? cur - 4 : 0;
        if (VAR == 6) rem = 0ull;
        int jc = __builtin_ctzll(rem | (1ull << 63)), wc = (VAR == 6) ? 1 : 0, buf = 0; rem &= rem - 1ull; if (VAR == 6) jc = cur;
        NSA_LOADK(ks + (size_t)jc * 4096); NSA_LOADV(vs + (size_t)jc * 4096); NSA_STOREK(0); NSA_STOREV(0); __syncthreads();
#pragma unroll 1
        for (;;) {
            bool has_next = true; int jn, wn;
            if (wc == 0) { if (rem != 0ull) { jn = __builtin_ctzll(rem); rem &= rem - 1ull; wn = 0; } else { jn = j0w; wn = 1; } }
            else { jn = jc + 1; wn = 1; has_next = jc < cur; }
            if (has_next && VAR != 1) { const bf16* kp = wn ? kw : ks; const bf16* vp = wn ? vw : vs; NSA_LOADK(kp + (size_t)jn * 4096); NSA_LOADV(vp + (size_t)jn * 4096); }
            const bool rv = wc ? true : (((mym >> jc) & 1ull) != 0ull);
            const int diag = (jc == cur) ? 1 : ((wc && jc == cur - 4) ? 2 : 0);
            if (__any(rv)) {
                nsa_qk(p0, p1, NSA_KB(buf), qr, negm, r32, hi);
                nsa_step(VAR, p0, p1, mhat, negm, o, ol, diag, rv, __all(rv), rel, NSA_VB(buf), wsf, lane, r32, hi); }
            if (has_next && VAR != 1) { NSA_STOREK(buf ^ 1); NSA_STOREV(buf ^ 1); }
            if (VAR != 4) __syncthreads();
            if (has_next && wn != wc) {
                row_bcast(g1, wsf, r32, hi, f16);
#pragma unroll
                for (int r = 0; r < 16; ++r) { const float fc = f16[r] * __builtin_amdgcn_rcpf(ol[r]); PS[(2 * r) * 64 + lane] += o[0][r] * fc; PS[(2 * r + 1) * 64 + lane] += o[1][r] * fc; o[0][r] = 0.f; o[1][r] = 0.f; ol[r] = 0.f; negm[r] = 0.f; }
                mhat = 0.f;
            }
            if (!has_next) break;
            jc = jn; wc = wn; buf ^= 1;
        }
    }
    row_bcast(g2, wsf, r32, hi, f16);
#pragma unroll
    for (int r = 0; r < 16; ++r) f16[r] *= __builtin_amdgcn_rcpf(ol[r]);
    bf16* outb = outbase + ((size_t)b * SEQ + t0 + 8 * w) * 1024 + 512 + g * 256 + r32;
    if (VAR == 0 || mhat == 12345.678f)
#pragma unroll
    for (int r = 0; r < 16; ++r) { const int rr = crow(r, hi), qo = rr >> 2, ho = rr & 3;
        outb[(size_t)qo * 1024 + ho * 64] = (bf16)f2bf(PS[(2 * r) * 64 + lane] + o[0][r] * f16[r]); outb[(size_t)qo * 1024 + ho * 64 + 32] = (bf16)f2bf(PS[(2 * r + 1) * 64 + lane] + o[1][r] * f16[r]); }
#undef NSA_LOADK
#undef NSA_LOADV
#undef NSA_STOREK
#undef NSA_STOREV
#undef NSA_KB
#undef NSA_VB
}

constexpr int ML_QS = 272, ML_VS = 320;
constexpr int ML_Q_OFF = 0, ML_K_OFF = 64 * ML_QS, ML_V_OFF = 2 * 64 * ML_QS, ML_CT_OFF = ML_V_OFF + 64 * ML_VS, ML_HS_OFF = ML_CT_OFF + 128 * ML_QS, ML_VEC_OFF = ML_HS_OFF + 128 * 65 * 4, ML_END = ML_VEC_OFF + 4096;
static_assert(ML_END <= MISC_OFF && 2 * 67 * 256 <= 128 * ML_QS, "mlstm mfma lds");
__device__ __forceinline__ void conv8(const LAS bf16* raw, int s, int c8, const float* cw, const float* cb, float (&out)[8]) {
    const f32x4 b0 = *(const f32x4*)(cb + c8 * 8), b1 = *(const f32x4*)(cb + c8 * 8 + 4);
    float acc[8] = {b0[0], b0[1], b0[2], b0[3], b1[0], b1[1], b1[2], b1[3]};
#pragma unroll
    for (int j = 0; j < 4; ++j) { float x[8]; unpack8(*(const LAS v4u*)(raw + (s + j) * 128 + c8 * 8), x);
        const f32x4 w0 = *(const f32x4*)(cw + j * 1024 + c8 * 8), w1 = *(const f32x4*)(cw + j * 1024 + c8 * 8 + 4);
        acc[0] += w0[0] * x[0]; acc[1] += w0[1] * x[1]; acc[2] += w0[2] * x[2]; acc[3] += w0[3] * x[3]; acc[4] += w1[0] * x[4]; acc[5] += w1[1] * x[5]; acc[6] += w1[2] * x[6]; acc[7] += w1[3] * x[7]; }
#pragma unroll
    for (int i = 0; i < 8; ++i) out[i] = siluf_(acc[i]);
}
__device__ __forceinline__ void mlstm_gates(const Args& a, Frame& F, int h, size_t row0, LAS float* bcum, LAS float* ig) {
    if (F.wave == 0) { const float* g = (const float*)(a.ws + WS_RC + RC_IF) + (row0 + F.lane) * 8; const float fp = g[4 + h] + a.in[I_GATEB][4 + h];
        ig[F.lane] = g[h] + a.in[I_GATEB][h];
        float v = fminf(fp, 0.f) - log1pf(__expf(-fabsf(fp)));
#pragma unroll
        for (int off = 1; off < 64; off <<= 1) { const float u = __shfl_up(v, off); if (F.lane >= off) v += u; }
        bcum[F.lane] = v; }
}
__device__ __forceinline__ void mlstm_stage_raw(Frame& F, const bf16* src, int b, int h, int t0, LAS bf16* raw) {
    for (int idx = F.tid; idx < 67 * 16; idx += NTHREADS) { const int rr = idx >> 4, c8 = idx & 15, tt = t0 - 3 + rr;
        v4u v = (v4u){0u, 0u, 0u, 0u}; if (tt >= 0) v = *(const v4u*)(src + ((size_t)b * SEQ + tt) * 512 + h * 128 + c8 * 8);
        *(LAS v4u*)(raw + rr * 128 + c8 * 8) = v; }
}
__device__ __forceinline__ void conv8r(const v4u (&tap)[4], int c8, const float* cw, const float* cb, float (&out)[8]) {
    const f32x4 b0 = *(const f32x4*)(cb + c8 * 8), b1 = *(const f32x4*)(cb + c8 * 8 + 4);
    float acc[8] = {b0[0], b0[1], b0[2], b0[3], b1[0], b1[1], b1[2], b1[3]};
#pragma unroll
    for (int j = 0; j < 4; ++j) { float x[8]; unpack8(tap[j], x);
        const f32x4 w0 = *(const f32x4*)(cw + j * 1024 + c8 * 8), w1 = *(const f32x4*)(cw + j * 1024 + c8 * 8 + 4);
        acc[0] += w0[0] * x[0]; acc[1] += w0[1] * x[1]; acc[2] += w0[2] * x[2]; acc[3] += w0[3] * x[3]; acc[4] += w1[0] * x[4]; acc[5] += w1[1] * x[5]; acc[6] += w1[2] * x[6]; acc[7] += w1[3] * x[7]; }
#pragma unroll
    for (int i = 0; i < 8; ++i) out[i] = siluf_(acc[i]);
}
__device__ __forceinline__ void load_taps(v4u (&tap)[4], const bf16* src, int b, int h, int t0, int s, int c8) {
#pragma unroll
    for (int j = 0; j < 4; ++j) { const int tt = t0 + s - 3 + j; tap[j] = (v4u){0u, 0u, 0u, 0u}; if (tt >= 0) tap[j] = *(const v4u*)(src + ((size_t)b * SEQ + tt) * 512 + h * 128 + c8 * 8); }
}
__device__ __forceinline__ void mlstm_gates_lane(const Args& a, int h, size_t row0, int lane, float& igv, float& bc) {
    const float* g = (const float*)(a.ws + WS_RC + RC_IF) + (row0 + lane) * 8; const float fp = g[4 + h] + a.in[I_GATEB][4 + h];
    igv = g[h] + a.in[I_GATEB][h];
    float v = fminf(fp, 0.f) - log1pf(__expf(-fabsf(fp)));
#pragma unroll
    for (int off = 1; off < 64; off <<= 1) { const float u = __shfl_up(v, off); if (lane >= off) v += u; }
    bc = v;
}
__device__ __forceinline__ void mlstm_local_mfma(const Args& a, Frame& F, int unit) {
    const int c = unit & 63, h = (unit >> 6) & 3, b = unit >> 8, t0 = c * CHUNK, lane = F.lane, w = F.wave, hi = lane >> 5, r32 = lane & 31;
    const size_t row0 = (size_t)b * SEQ + t0;
    unsigned char* rc = a.ws + WS_RC;
    LAS unsigned char* LK = F.lds; LAS unsigned char* LV = F.lds + 64 * ML_VS;
    v4u tk[2][4], vv[2];
#pragma unroll
    for (int u = 0; u < 2; ++u) { const int it = F.tid + u * NTHREADS, s = it >> 4, c8 = it & 15;
        load_taps(tk[u], (const bf16*)(rc + RC_KM), b, h, t0, s, c8);
        vv[u] = *(const v4u*)((const bf16*)(rc + RC_VM) + (row0 + s) * 512 + h * 128 + c8 * 8); }
    float igv, bc; mlstm_gates_lane(a, h, row0, lane, igv, bc);
    const float blast = __shfl(bc, 63), gv = blast - bc + igv, mloc = wave_max(gv), wvv = __expf(gv - mloc);
    if (F.tid == 0) { float* cs = (float*)(a.ws + WS_CSC) + (size_t)unit * 2; cs[0] = blast; cs[1] = mloc; }
    __syncthreads();
    { const float* cw = a.in[I_CONVW] + 512 + h * 128; const float* cb = a.in[I_CONVB] + 512 + h * 128;
#pragma unroll
      for (int u = 0; u < 2; ++u) { const int it = F.tid + u * NTHREADS, s = it >> 4, c8 = it & 15; float k8[8]; conv8r(tk[u], c8, cw, cb, k8);
          const float sc = 0.08838834764831845f * __shfl(wvv, s & 63);
          v4u o; o.x = pk2(k8[0] * sc, k8[1] * sc); o.y = pk2(k8[2] * sc, k8[3] * sc); o.z = pk2(k8[4] * sc, k8[5] * sc); o.w = pk2(k8[6] * sc, k8[7] * sc);
          *(LAS v4u*)(LK + s * ML_VS + c8 * 16) = o; *(LAS v4u*)(LV + s * ML_VS + c8 * 16) = vv[u]; } }
    __syncthreads();
    if (F.tid < 128) { float sacc = 0.f; for (int s = 0; s < 64; ++s) sacc += bf2f(*(const LAS bf16*)(LK + s * ML_VS + F.tid * 2)); ((float*)(a.ws + WS_NST))[(size_t)unit * 128 + F.tid] = sacc; }
    const int et = w >> 1, dt0 = (w & 1) * 2, blk = (lane >> 4) & 1, q = (lane & 15) >> 2, p = lane & 3;
    f32x16 acc[2];
#pragma unroll
    for (int i = 0; i < 16; ++i) { acc[0][i] = 0.f; acc[1][i] = 0.f; }
    const LAS unsigned char* abase = LV + (8 * hi + q) * ML_VS + (et * 32 + 16 * blk + 4 * p) * 2;
    const LAS unsigned char* bbase = LK + (8 * hi + q) * ML_VS + (dt0 * 32 + 16 * blk + 4 * p) * 2;
#pragma unroll
    for (int ks = 0; ks < 4; ++ks) { const s16x4 a0 = vtr(abase + ks * 16 * ML_VS), a1 = vtr(abase + (ks * 16 + 4) * ML_VS);
        const bf16x8 af = (bf16x8){a0[0], a0[1], a0[2], a0[3], a1[0], a1[1], a1[2], a1[3]};
#pragma unroll
        for (int n = 0; n < 2; ++n) { const s16x4 b0 = vtr(bbase + ks * 16 * ML_VS + n * 64), b1 = vtr(bbase + (ks * 16 + 4) * ML_VS + n * 64);
            const bf16x8 bfr = (bf16x8){b0[0], b0[1], b0[2], b0[3], b1[0], b1[1], b1[2], b1[3]};
            acc[n] = __builtin_amdgcn_mfma_f32_32x32x16_bf16(af, bfr, acc[n], 0, 0, 0); } }
    bf16* st = (bf16*)(a.ws + WS_RB) + (size_t)unit * 16384;
#pragma unroll
    for (int n = 0; n < 2; ++n)
#pragma unroll
        for (int r = 0; r < 16; ++r) st[(et * 32 + crow(r, hi)) * 128 + (dt0 + n) * 32 + r32] = (bf16)f2bf(acc[n][r]);
}
__device__ __forceinline__ void mlstm_out_mfma(const Args& a, Frame& F, int unit) {
    const int c = unit & 63, h = (unit >> 6) & 3, b = unit >> 8, t0 = c * CHUNK, lane = F.lane, w = F.wave, hi = lane >> 5, r32 = lane & 31;
    const size_t row0 = (size_t)b * SEQ + t0;
    unsigned char* rc = a.ws + WS_RC;
    LAS unsigned char* QB = F.lds + ML_Q_OFF; LAS unsigned char* KB = F.lds + ML_K_OFF; LAS unsigned char* VB = F.lds + ML_V_OFF;
    LAS float* HS = (LAS float*)(F.lds + ML_HS_OFF);
    LAS float* bcum = (LAS float*)(F.lds + ML_VEC_OFF); LAS float* ig = bcum + 64; LAS float* nv = bcum + 192; LAS float* ssq = bcum + 320;
    v4u tq[2][4], tk[2][4], vv[2];
#pragma unroll
    for (int u = 0; u < 2; ++u) { const int it = F.tid + u * NTHREADS, s = it >> 4, c8 = it & 15;
        load_taps(tq[u], (const bf16*)(rc + RC_QM), b, h, t0, s, c8); load_taps(tk[u], (const bf16*)(rc + RC_KM), b, h, t0, s, c8);
        vv[u] = *(const v4u*)((const bf16*)(rc + RC_VM) + (row0 + s) * 512 + h * 128 + c8 * 8); }
    const bf16* ctg = (const bf16*)(a.ws + WS_RB) + (size_t)unit * 16384;
    const int te = F.tid >> 3, e0 = (F.tid & 7) * 16;
    float nvr = 0.f; if (F.tid < 128) nvr = ((const float*)(a.ws + WS_NST))[(size_t)unit * 128 + F.tid];
    const float mp = ((const float*)(a.ws + WS_MPREV))[unit];
    float igv = 0.f, bc = 0.f; if (w == 0) mlstm_gates_lane(a, h, row0, lane, igv, bc);
    __syncthreads();
    if (w == 0) { ig[lane] = igv - bc; bcum[lane] = bc; }
    if (F.tid < 128) nv[F.tid] = nvr;
    { const float* cwq = a.in[I_CONVW] + h * 128; const float* cbq = a.in[I_CONVB] + h * 128;
#pragma unroll
      for (int u = 0; u < 2; ++u) { const int it = F.tid + u * NTHREADS, s = it >> 4, c8 = it & 15; float x8[8];
          conv8r(tq[u], c8, cwq, cbq, x8);
          v4u o; o.x = pk2(x8[0], x8[1]); o.y = pk2(x8[2], x8[3]); o.z = pk2(x8[4], x8[5]); o.w = pk2(x8[6], x8[7]);
          *(LAS v4u*)(QB + s * ML_QS + c8 * 16) = o;
          conv8r(tk[u], c8, cwq + 512, cbq + 512, x8); const float sc = 0.08838834764831845f;
          o.x = pk2(x8[0] * sc, x8[1] * sc); o.y = pk2(x8[2] * sc, x8[3] * sc); o.z = pk2(x8[4] * sc, x8[5] * sc); o.w = pk2(x8[6] * sc, x8[7] * sc);
          *(LAS v4u*)(KB + s * ML_QS + c8 * 16) = o;
          *(LAS v4u*)(VB + s * ML_VS + c8 * 16) = vv[u]; } }
    __syncthreads();
    const int et = w & 3, tt = w >> 2, t = tt * 32 + r32, blk = (lane >> 4) & 1, q = (lane & 15) >> 2, p = lane & 3;
    bf16x8 cf[8];
#pragma unroll
    for (int d0 = 0; d0 < 8; ++d0) cf[d0] = *(const bf16x8*)(ctg + (et * 32 + r32) * 128 + d0 * 16 + hi * 8);
    v4u omr[2]; { const bf16* om = (const bf16*)(rc + RC_OM) + (row0 + te) * 512 + h * 128 + e0; omr[0] = *(const v4u*)om; omr[1] = *(const v4u*)(om + 8); }
    bf16x8 qf[8];
#pragma unroll
    for (int d0 = 0; d0 < 8; ++d0) qf[d0] = *(const LAS bf16x8*)(QB + t * ML_QS + d0 * 32 + hi * 16);
    float qn = 0.f;
#pragma unroll
    for (int d0 = 0; d0 < 8; ++d0) { float x[8]; unpack8(__builtin_bit_cast(v4u, qf[d0]), x); const f32x4 n0 = *(const LAS f32x4*)(nv + d0 * 16 + hi * 8), n1 = *(const LAS f32x4*)(nv + d0 * 16 + hi * 8 + 4);
        qn += x[0] * n0[0] + x[1] * n0[1] + x[2] * n0[2] + x[3] * n0[3] + x[4] * n1[0] + x[5] * n1[1] + x[6] * n1[2] + x[7] * n1[3]; }
    qn = swapsum(qn);
    f32x16 p0, p1;
#pragma unroll
    for (int i = 0; i < 16; ++i) { p0[i] = 0.f; p1[i] = 0.f; }
#pragma unroll
    for (int hf = 0; hf < 2; ++hf) { bf16x8 kf[8];
#pragma unroll
        for (int dd = 0; dd < 4; ++dd) { const int d0 = hf * 4 + dd; kf[2 * dd] = *(const LAS bf16x8*)(KB + r32 * ML_QS + d0 * 32 + hi * 16); kf[2 * dd + 1] = *(const LAS bf16x8*)(KB + (32 + r32) * ML_QS + d0 * 32 + hi * 16); }
        __builtin_amdgcn_sched_barrier(0);
#pragma unroll
        for (int dd = 0; dd < 4; ++dd) { const int d0 = hf * 4 + dd; p0 = __builtin_amdgcn_mfma_f32_32x32x16_bf16(kf[2 * dd], qf[d0], p0, 0, 0, 0); p1 = __builtin_amdgcn_mfma_f32_32x32x16_bf16(kf[2 * dd + 1], qf[d0], p1, 0, 0, 0); } }
    const float bt = bcum[t], at = bt + mp;
    float mt = at;
#pragma unroll
    for (int r = 0; r < 16; ++r) { const int s0 = crow(r, hi), s1 = s0 + 32; const float a0 = ig[s0], a1 = ig[s1];
        if (s0 <= t) mt = fmaxf(mt, bt + a0); if (s1 <= t) mt = fmaxf(mt, bt + a1); }
    mt = swapmax(mt);
    float sden = 0.f;
#pragma unroll
    for (int r = 0; r < 16; ++r) { const int s0 = crow(r, hi), s1 = s0 + 32; const float a0 = ig[s0], a1 = ig[s1];
        p0[r] = s0 <= t ? p0[r] * __expf(bt + a0 - mt) : 0.f; p1[r] = s1 <= t ? p1[r] * __expf(bt + a1 - mt) : 0.f; sden += p0[r] + p1[r]; }
    sden = swapsum(sden);
    const float wi = __expf(at - mt), den = sden + wi * qn, dn = fmaxf(fabsf(den), __expf(-mt));
    bf16x8 pa[4]; nsa_pack(pa, p0, p1);
    f32x16 acc, acc2;
#pragma unroll
    for (int i = 0; i < 16; ++i) { acc[i] = 0.f; acc2[i] = 0.f; }
    { const LAS unsigned char* vbase = VB + (4 * hi + q) * ML_VS + (et * 32 + 16 * blk + 4 * p) * 2;
#pragma unroll
      for (int ks = 0; ks < 4; ++ks) { const s16x4 a0 = vtr(vbase + ks * 16 * ML_VS), a1 = vtr(vbase + (ks * 16 + 8) * ML_VS);
          const bf16x8 af = (bf16x8){a0[0], a0[1], a0[2], a0[3], a1[0], a1[1], a1[2], a1[3]};
          acc = __builtin_amdgcn_mfma_f32_32x32x16_bf16(af, pa[ks], acc, 0, 0, 0); } }
#pragma unroll
    for (int d0 = 0; d0 < 8; ++d0) acc2 = __builtin_amdgcn_mfma_f32_32x32x16_bf16(cf[d0], qf[d0], acc2, 0, 0, 0);
    float ss = 0.f; const float rdn = 1.f / dn;
#pragma unroll
    for (int r = 0; r < 16; ++r) { const float hv = (acc[r] + wi * acc2[r]) * rdn; ss += hv * hv; HS[(et * 32 + crow(r, hi)) * 65 + t] = hv; }
    ss = swapsum(ss);
    if (hi == 0) ssq[et * 64 + t] = ss;
    __syncthreads();
    { const float rstd = rsqrtf((ssq[te] + ssq[64 + te] + ssq[128 + te] + ssq[192 + te]) * (1.f / 128.f) + EPS);
      const size_t row = row0 + te; const int ch = h * 128 + e0;
      const float* hg = a.in[I_HGAIN] + ch;
      float o[16], og[16]; unpack8(omr[0], *(float(*)[8])&og[0]); unpack8(omr[1], *(float(*)[8])&og[8]);
#pragma unroll
      for (int i = 0; i < 16; ++i) o[i] = sigmoidf_(og[i]) * HS[(e0 + i) * 65 + te] * rstd * hg[i];
      bf16* hm = (bf16*)(a.ws + WS_RA) + row * 1024 + ch;
#pragma unroll
      for (int i = 0; i < 16; i += 8) { v4u wv4; wv4.x = pk2(o[i], o[i + 1]); wv4.y = pk2(o[i + 2], o[i + 3]); wv4.z = pk2(o[i + 4], o[i + 5]); wv4.w = pk2(o[i + 6], o[i + 7]); *(v4u*)(hm + i) = wv4; } }
}

__global__ void __launch_bounds__(NTHREADS, 2) mk_fwd(Args args) {
    extern __shared__ __attribute__((aligned(16))) unsigned char lds[];
    Frame F;
    F.lds = (LAS unsigned char*)lds;
    F.tid = threadIdx.x; F.lane = F.tid & 63; F.wave = __builtin_amdgcn_readfirstlane(F.tid >> 6);
    F.G = gridDim.x; { const int bx = blockIdx.x; F.vcu = (F.G % 8 == 0) ? (bx % 8) * (F.G / 8) + bx / 8 : bx; }
    volatile LAS unsigned* MISC = (volatile LAS unsigned*)(F.lds + MISC_OFF);
    if (F.tid < 64) MISC[F.tid] = 0u;
    __syncthreads();
    unsigned char* ws = args.ws;
    gu32* ctl = (gu32*)(ws + WS_CTL);
    XcdBarrier bar; bar.bar = (unsigned*)ctl + CW_BAR; bar.x = 0; bar.st = nullptr;
    if (MK_N_LAUNCHES == 1) bar = xcd_barrier_post((unsigned*)ctl + CW_BAR, MISC + 8);
    const int lo = args.ph_lo, hi = args.ph_hi;
#define IN(k) (lo <= (k) && (k) < hi)
#define SEAM(k) do { if (IN(k) && IN((k) + 1)) xcd_barrier(bar); } while (0)
    bf16* U = (bf16*)(ws + WS_RA); bf16* Fb = (bf16*)(ws + WS_RB); bf16* HID = (bf16*)(ws + WS_RC);
    PG8_LAS unsigned char* ring = (PG8_LAS unsigned char*)lds;

    if (IN(0)) { p0_prologue(args, F); } SEAM(0);
    if (IN(1)) { thin_phase<0>(args, F, args.in[I_X], nullptr, nullptr, U, 0, 0, 0.f); } SEAM(1);
    if (IN(2)) { pg8::Gemm g{U, (const bf16*)(ws + WS_W1T), T, NPROJ, DM, DM, DM, 0}; pg8::StaticOrder S; S.init(T, NPROJ, F.G, (int)blockIdx.x);
        pg8::EpiSwiGLU E{HID}; pg8::gemm_phase<pg8::EpiSwiGLU, pg8::StaticOrder, true, true>(ring, g, S, E); } SEAM(2);
    if (IN(3)) { pg8::Gemm g{HID, (const bf16*)(ws + WS_W1D), T, DM, DFF, DFF, DFF, 0}; pg8::StaticOrder S; S.init(T, DM, F.G, (int)blockIdx.x);
        pg8::EpiStore E{Fb, DM}; pg8::gemm_phase<pg8::EpiStore, pg8::StaticOrder, true, true>(ring, g, S, E); } SEAM(3);
    if (IN(4)) { thin_phase<1, false, true>(args, F, args.in[I_X], Fb, args.out, U, 0, 1, 0.5f); } SEAM(4);
    if (IN(5)) { pg8::Gemm g{U, (const bf16*)(ws + WS_WIN), T, NPROJ, DM, DM, DM, 0}; pg8::StaticOrder S; S.init(T, NPROJ, F.G, (int)blockIdx.x);
        pg8::EpiProj E{ws + WS_RC}; pg8::gemm_phase<pg8::EpiProj, pg8::StaticOrder, true, true>(ring, g, S, E); } SEAM(5);
    if (IN(6)) {
        const int bx = (int)blockIdx.x;
        if (bx < 128) { const int kv = bx >> 6; pg8::Gemm g{(const bf16*)(ws + WS_RC + RC_KV + (size_t)kv * 16 * MiB), (const bf16*)(ws + WS_WC1) + (size_t)kv * 512 * 1024, 8192, 512, 1024, 1024, 1024, 0};
            pg8::StaticOrder S; S.init(8192, 512, 64, bx & 63);
            pg8::EpiStoreF32 E{(float*)(ws + WS_RA) + (size_t)kv * 8192 * 512, 512}; pg8::gemm_phase<pg8::EpiStoreF32, pg8::StaticOrder, false, true>(ring, g, S, E); }
        __syncthreads();
#ifdef MLSTM_REF
        for (;;) { if (F.tid == 0) MISC[16] = atomicAdd((unsigned*)ctl + CW_QUEUE, 1u); __syncthreads(); const unsigned unit = MISC[16]; __syncthreads(); if (unit >= 4096u) break; mlstm_local_unit(args, F, (int)unit); }
#else
        { unsigned ticket = 0u; if (F.tid == 0) ticket = atomicAdd((unsigned*)ctl + CW_QUEUE, 1u);
          for (;;) { unsigned nxt = 0u;
              if (F.tid == 0) { MISC[16] = ticket; nxt = atomicAdd((unsigned*)ctl + CW_QUEUE, 1u); }
              __syncthreads(); const unsigned unit = MISC[16]; __syncthreads(); if (unit >= 4096u) break;
              mlstm_local_mfma(args, F, (int)unit); ticket = nxt; } }
#endif
    } SEAM(6);
    if (IN(7)) {
#ifdef PROBE_P7_PART
        if (!(hi - lo == 1 && PROBE_P7_PART == 2)) mlstm_scan(args, F);
        if (!(hi - lo == 1 && PROBE_P7_PART == 1)) compress_l2(args, F);
#else
        mlstm_scan(args, F); compress_l2(args, F);
#endif
    } SEAM(7);
    if (IN(8)) {
#ifdef MLSTM_REF
        for (int unit = F.vcu; unit < 4096; unit += F.G) mlstm_out_unit(args, F, unit);
#else
#ifdef PROBE_P8_PART
        if (!(hi - lo == 1 && PROBE_P8_PART == 2))
#endif
        for (int unit = F.vcu; unit < 4096; unit += F.G) mlstm_out_mfma(args, F, unit);
#endif
        __syncthreads();
#ifdef NSA_DEBUG
        xcd_barrier(bar);
        for (int pidx = F.vcu; pidx < 1024; pidx += F.G) { const int bg = pidx >> 5, i = pidx & 31; nsa_unit(0, args, F, bg, 63 - i, (bf16*)(ws + WS_RC + RC_QM)); nsa_unit(0, args, F, bg, i, (bf16*)(ws + WS_RC + RC_QM)); }
        __syncthreads();
        { LAS float* wl = (LAS float*)(F.lds + F.wave * 4096); const int gw = F.vcu * NWAVES + F.wave, NGW = F.G * NWAVES;
          for (int q = gw; q < NB * NG * SEQ; q += NGW) nsa_query(args, F, q, wl); }
        xcd_barrier(bar);
        { const bf16* A = (const bf16*)(ws + WS_RA + 64 * MiB); const bf16* B = (const bf16*)(ws + WS_RC + RC_QM); float sd = 0.f, sa = 0.f;
          for (size_t i = (size_t)F.vcu * NTHREADS + F.tid; i < (size_t)T * 512; i += (size_t)F.G * NTHREADS) { const float x = bf2f(A[i]), y = bf2f(B[i]); sd += (x - y) * (x - y); sa += x * x; }
          sd = wave_sum(sd); sa = wave_sum(sa);
          if (F.lane == 0) { atomicAdd((float*)ctl + 80, sd); atomicAdd((float*)ctl + 81, sa); } }
#else
#ifdef PROBE_P8_PART
        if (!(hi - lo == 1 && PROBE_P8_PART == 1))
#endif
#ifdef PROBE_NSA_VAR
        { const int var = (hi - lo == 1) ? PROBE_NSA_VAR : 0;
        for (int pidx = F.vcu; pidx < 1024; pidx += F.G) { const int bg = pidx >> 5, i = pidx & 31; nsa_unit(var, args, F, bg, 63 - i, (bf16*)(ws + WS_RA)); nsa_unit(var, args, F, bg, i, (bf16*)(ws + WS_RA)); } }
#else
        for (int pidx = F.vcu; pidx < 1024; pidx += F.G) { const int bg = pidx >> 5, i = pidx & 31; nsa_unit(0, args, F, bg, 63 - i, (bf16*)(ws + WS_RA)); nsa_unit(0, args, F, bg, i, (bf16*)(ws + WS_RA)); }
#endif
#endif
    } SEAM(8);
    if (IN(9)) { pg8::Gemm g{(const bf16*)(ws + WS_RA), (const bf16*)(ws + WS_WUPM), T, DM, 512, 1024, 1024, 1024}; pg8::SegOrder S; S.init(T, DM, F.G, (int)blockIdx.x);
        pg8::EpiMergeFused E{(bf16*)(ws + WS_RC + RC_MERGED), (const bf16*)(ws + WS_RC + RC_GM), (const bf16*)(ws + WS_RC + RC_GN)};
        pg8::gemm_phase<pg8::EpiMergeFused, pg8::SegOrder, true, true>(ring, g, S, E); } SEAM(9);
    if (IN(10)) { pg8::Gemm g{(const bf16*)(ws + WS_RC + RC_MERGED), (const bf16*)(ws + WS_WOUT), T, DM, DM, DM, DM, 0}; pg8::StaticOrder S; S.init(T, DM, F.G, (int)blockIdx.x);
        pg8::EpiStore E{Fb, DM}; pg8::gemm_phase<pg8::EpiStore, pg8::StaticOrder, true, true>(ring, g, S, E); } SEAM(10);
    if (IN(11)) { thin_phase<1, true, true>(args, F, args.out, Fb, ws + WS_RC + 512 * MiB, U, 1, 2, 1.0f); } SEAM(11);
    if (IN(12)) { pg8::Gemm g{U, (const bf16*)(ws + WS_W1T) + (size_t)NPROJ * DM, T, NPROJ, DM, DM, DM, 0}; pg8::StaticOrder S; S.init(T, NPROJ, F.G, (int)blockIdx.x);
        pg8::EpiSwiGLU E{HID}; pg8::gemm_phase<pg8::EpiSwiGLU, pg8::StaticOrder, true, true>(ring, g, S, E); } SEAM(12);
    if (IN(13)) { pg8::Gemm g{HID, (const bf16*)(ws + WS_W1D) + (size_t)DM * DFF, T, DM, DFF, DFF, DFF, 0}; pg8::StaticOrder S; S.init(T, DM, F.G, (int)blockIdx.x);
        pg8::EpiStore E{Fb, DM}; pg8::gemm_phase<pg8::EpiStore, pg8::StaticOrder, true, true>(ring, g, S, E); } SEAM(13);
    if (IN(14)) { thin_phase<2, true, false>(args, F, ws + WS_RC + 512 * MiB, Fb, args.out, nullptr, 2, 0, 0.5f);
#ifdef NSA_DEBUG
        __syncthreads();
        { const float sd = __hip_atomic_load((float*)ctl + 80, RLX_AGENT), sa = __hip_atomic_load((float*)ctl + 81, RLX_AGENT); float rel = sqrtf(sd / fmaxf(sa, 1e-30f)); rel = (rel == rel) ? fminf(rel, 4.f) : 8.f;
          const int gw = F.vcu * NWAVES + F.wave, NGW = F.G * NWAVES;
          for (int row = gw; row < T; row += NGW) for (int j = 0; j < 4; ++j) { f32x4* p = (f32x4*)(args.out + (size_t)row * DM + 256 * j + 4 * F.lane); *p = *p * (1.f + rel); } }
#endif
    }
#undef IN
#undef SEAM
}

extern "C" void kernel_launch(void* const* d_in, const int* in_sizes, int n_in, void* d_out, int out_size, void* d_ws, size_t ws_size, hipStream_t stream) {
    static int grid = 0;
    if (grid == 0) {
        if (n_in != 21 || in_sizes[0] != T * DM || out_size != T * DM || ws_size < WS_END) { fprintf(stderr, "kernel_launch: unexpected shapes (n_in %d, in0 %d, out %d, ws %zu, need %zu)\n", n_in, n_in > 0 ? in_sizes[0] : -1, out_size, ws_size, (size_t)WS_END); grid = -1; return; }
        int dev = 0, cus = 0;
        if (hipGetDevice(&dev) != hipSuccess || hipDeviceGetAttribute(&cus, hipDeviceAttributeMultiprocessorCount, dev) != hipSuccess) { grid = -1; return; }
        if (hipFuncSetAttribute((const void*)mk_fwd, hipFuncAttributeMaxDynamicSharedMemorySize, LDS_BYTES) != hipSuccess) { fprintf(stderr, "kernel_launch: hipFuncSetAttribute failed\n"); grid = -1; return; }
        int per_cu = 0;
        if (hipOccupancyMaxActiveBlocksPerMultiprocessor(&per_cu, (const void*)mk_fwd, NTHREADS, LDS_BYTES) != hipSuccess || per_cu < 1) fprintf(stderr, "kernel_launch: occupancy query reports %d\n", per_cu);
        (void)hipGetLastError();
        grid = cus;
    }
    if (grid < 0) return;
    if (hipMemsetAsync((char*)d_ws + WS_CTL, 0, CTL_ZERO_BYTES, stream) != hipSuccess) return;
    Args a{};
    for (int i = 0; i < 21; ++i) a.in[i] = (const float*)d_in[i];
    a.out = (float*)d_out; a.ws = (unsigned char*)d_ws;
    if (MK_N_LAUNCHES == 1) { a.ph_lo = 0; a.ph_hi = NPHASE; hipLaunchKernelGGL(mk_fwd, dim3(grid), dim3(NTHREADS), LDS_BYTES, stream, a);
#ifdef PROBE_PHASE
        for (int r = 0; r < PROBE_REPS; ++r) { if (PROBE_PHASE == 6) hipMemsetAsync((char*)d_ws + WS_CTL + CW_QUEUE * 4, 0, 4, stream);
            a.ph_lo = PROBE_PHASE; a.ph_hi = PROBE_PHASE + 1; hipLaunchKernelGGL(mk_fwd, dim3(grid), dim3(NTHREADS), LDS_BYTES, stream, a); }
#endif
    }
    else for (int li = 0; li < NPHASE; ++li) { a.ph_lo = li; a.ph_hi = li + 1; hipLaunchKernelGGL(mk_fwd, dim3(grid), dim3(NTHREADS), LDS_BYTES, stream, a); }
}
```

```cpp
#include <hip/hip_runtime.h>
#include <cstdio>
#include <cstdint>

#define GAS __attribute__((address_space(1)))
#define LAS __attribute__((address_space(3)))
typedef unsigned short bf16;
typedef unsigned v4u __attribute__((ext_vector_type(4)));
typedef unsigned v2u __attribute__((ext_vector_type(2)));
typedef float f32x4 __attribute__((ext_vector_type(4)));
typedef short bf16x8 __attribute__((ext_vector_type(8)));
typedef GAS unsigned gu32;

#ifndef MK_N_LAUNCHES
#define MK_N_LAUNCHES 1
#endif

constexpr int DM = 1024, NB = 16, SEQ = 4096, T = NB * SEQ, DFF = 2816;
constexpr int MH = 4, MDH = 128, MW = 512, CHUNK = 64, NCHUNK = SEQ / CHUNK;
constexpr int NSW = 512, NG = 2, NHG = 4, NDH = 64;
constexpr int NCMP = 255, NSEL = 64;
constexpr int NPROJ = 5632;
constexpr float EPS = 1e-6f;
constexpr int NPHASE = 15;

constexpr size_t MiB = 1u << 20;
constexpr size_t WS_CTL = 0, CTL_ZERO_BYTES = 1 * MiB;
constexpr size_t WS_W1T = 1 * MiB;
constexpr size_t WS_W1D = WS_W1T + 2 * (size_t)NPROJ * DM * 2;
constexpr size_t WS_WIN = WS_W1D + 2 * (size_t)DM * DFF * 2;
constexpr size_t WS_WUPM = WS_WIN + (size_t)NPROJ * DM * 2;
constexpr size_t WS_WUPN = WS_WUPM + (size_t)DM * MW * 2;
constexpr size_t WS_WOUT = WS_WUPN + (size_t)DM * NSW * 2;
constexpr size_t WS_WC1 = WS_WOUT + (size_t)DM * DM * 2;
constexpr size_t WS_ADA = WS_WC1 + 2 * (size_t)512 * 1024 * 2;
constexpr size_t WS_B1P = WS_ADA + (size_t)NB * 9 * DM * 4;
constexpr size_t WS_KCMP = WS_B1P + 32768;
constexpr size_t WS_CSC = WS_KCMP + 2 * (size_t)32 * 256 * 64 * 2;
constexpr size_t WS_MPREV = WS_CSC + 4096 * 8;
constexpr size_t WS_NST = WS_MPREV + 4096 * 4;
constexpr size_t WS_SMALL_END = WS_NST + (size_t)4096 * 128 * 4;
constexpr size_t WS_RA = 64 * MiB;
constexpr size_t WS_RB = WS_RA + 128 * MiB;
constexpr size_t WS_RC = WS_RB + 128 * MiB;
static_assert(WS_SMALL_END <= WS_RA, "small buffers");
constexpr size_t RC_QM = 0, RC_KM = 64 * MiB, RC_VM = 128 * MiB, RC_OM = 192 * MiB, RC_QN = 256 * MiB;
constexpr size_t RC_KV = 320 * MiB;
constexpr size_t RC_GM = 416 * MiB, RC_GN = 544 * MiB, RC_IF = 672 * MiB, RC_GG = 674 * MiB, RC_END = 680 * MiB;
constexpr size_t RC_MERGED = RC_VM;
constexpr size_t WS_END = WS_RC + RC_END;
static_assert(WS_END <= 1024 * MiB, "workspace");
static_assert((size_t)T * DFF * 2 <= 512 * MiB && 512 * MiB + (size_t)T * DM * 2 <= RC_END, "hid and the bf16 residual copy fit");

constexpr int CW_TMO = 0, CW_CODE = 1, CW_QUEUE = 64;
constexpr int CW_BAR = 4096;

constexpr int LDS_BYTES = 159744;
constexpr int MISC_OFF = LDS_BYTES - 256;
constexpr int NWAVES = 8, NTHREADS = 512;

#define RLX_AGENT __ATOMIC_RELAXED, __HIP_MEMORY_SCOPE_AGENT
#define LDS_WAIT() asm volatile("s_waitcnt lgkmcnt(0)" ::: "memory")
#define VM_WAIT() asm volatile("s_waitcnt vmcnt(0)" ::: "memory")
__device__ __forceinline__ unsigned f2bf(float f) { unsigned u = __builtin_bit_cast(unsigned, f); return (u + 0x7fffu + ((u >> 16) & 1u)) >> 16; }
__device__ __forceinline__ unsigned pk2(float lo, float hi) { return f2bf(lo) | (f2bf(hi) << 16); }
__device__ __forceinline__ float bf2f(unsigned short b) { return __builtin_bit_cast(float, (unsigned)b << 16); }
__device__ __forceinline__ float bflo(unsigned w) { return __builtin_bit_cast(float, w << 16); }
__device__ __forceinline__ float bfhi(unsigned w) { return __builtin_bit_cast(float, w & 0xffff0000u); }
__device__ __forceinline__ float sigmoidf_(float x) { return __builtin_amdgcn_rcpf(1.f + __builtin_amdgcn_exp2f(-1.4426950408889634f * x)); }
__device__ __forceinline__ float siluf_(float x) { return x * __builtin_amdgcn_rcpf(1.f + __builtin_amdgcn_exp2f(-1.4426950408889634f * x)); }
__device__ __forceinline__ void unpack8(const v4u w, float (&x)[8]) { x[0] = bflo(w.x); x[1] = bfhi(w.x); x[2] = bflo(w.y); x[3] = bfhi(w.y); x[4] = bflo(w.z); x[5] = bfhi(w.z); x[6] = bflo(w.w); x[7] = bfhi(w.w); }
__device__ __forceinline__ float wave_sum(float v) {
#pragma unroll
    for (int o = 1; o < 64; o <<= 1) v += __shfl_xor(v, o);
    return v;
}
__device__ __forceinline__ float wave_max(float v) {
#pragma unroll
    for (int o = 1; o < 64; o <<= 1) v = fmaxf(v, __shfl_xor(v, o));
    return v;
}

namespace pg8 {
#define PG8_LAS __attribute__((address_space(3)))
typedef unsigned short bf16_t;
typedef unsigned u32x4 __attribute__((ext_vector_type(4)));
constexpr int BM = 256, BK = 64, HALF = 128, HTB = HALF * BK * 2, STAGE_BYTES = 8 * HTB, NXCD = 8, WGM = 4;

__host__ __device__ __forceinline__ int lds_byte(int r, int c) { const int st = (r >> 4) * 2 + (c >> 5), rr = r & 15, cc = c & 31, ob = rr * 64 + cc * 2; return st * 1024 + (ob ^ (((ob >> 9) & 1) << 5)); }
__host__ __device__ __forceinline__ void stage_rc(int b, int& R, int& C) { const int st = b / 1024, sb = b % 1024, swz = sb ^ (((sb >> 9) & 1) << 5); R = (st >> 1) * 16 + swz / 64; C = (st & 1) * 32 + (swz % 64) / 2; }
__host__ __device__ __forceinline__ int perm32(int rho) { const int n = rho >> 4, i = rho & 15; return 8 * (i >> 2) + 4 * n + (i & 3); }

struct Unit { int pm, pn, seg; };
struct Gemm { const bf16_t* A; const bf16_t* Bt; int M, N, K; int lda, ldb, segbytes; };

struct StaticOrder {
    int nM, nN, nwg, G, c;
    __host__ __device__ void init(int M, int N, int G_, int c_) { nM = M / BM; nN = N / BM; nwg = nM * nN; G = G_; c = c_; }
    __host__ __device__ bool next(int i, Unit& u) const {
        const long L = (long)i * G + c; if (L >= nwg) return false;
        int wgid = (int)L; { const int q = nwg / NXCD, r = nwg % NXCD, xcd = wgid % NXCD, off = wgid / NXCD; wgid = (xcd < r ? xcd * (q + 1) : r * (q + 1) + (xcd - r) * q) + off; }
        const int nig = WGM * nN, gid = wgid / nig, fm = gid * WGM, gsz = (nM - fm) < WGM ? (nM - fm) : WGM;
        u.pm = fm + ((wgid % nig) % gsz); u.pn = (wgid % nig) / gsz; u.seg = 0; return true;
    }
    __device__ __forceinline__ void a_ready(const Unit&) const {}
    __device__ __forceinline__ void done(const Unit&) const {}
};
struct SegOrder : StaticOrder {
    __host__ __device__ bool next(int i, Unit& u) const { if (!StaticOrder::next(i >> 1, u)) return false; u.seg = i & 1; return true; }
};

template <class Epi, class Sched, bool ALIGN_EPI = false, bool SP2 = false, bool F8 = false, int SCALE_B = 0x7f7f7f7f, int SCALE_A = 0x7f7f7f7f>
__device__ __forceinline__ void gemm_phase(PG8_LAS unsigned char* lds, const Gemm g, const Sched& S, const Epi& E) {
    const int tid = threadIdx.x, wid = __builtin_amdgcn_readfirstlane(tid >> 6), lane = tid & 63, wr = wid >> 2, wc = wid & 3, fr = lane & 15, fq = lane >> 4;
    const int K = g.K, nt = K / BK;
    unsigned voffA[2], voffB[2];
#pragma unroll
    for (int i = 0; i < 2; ++i) { int R, C; stage_rc(tid * 16 + i * 8192, R, C); const int Rb = ((R & ~31) + perm32(R & 31));
        voffA[i] = (unsigned)(R * g.lda + C) * 2u; voffB[i] = (unsigned)(Rb * g.ldb + C) * 2u; }
    const size_t kstep = (size_t)(BK * 2);
    const size_t hstepA = (size_t)HALF * g.lda * 2, hstepB = (size_t)HALF * g.ldb * 2;
    const size_t tstepA = 2 * hstepA, tstepB = 2 * hstepB;
    const unsigned ldsw = (unsigned)wid * 1024u;
    const int aoff = lds_byte(wr * 64 + fr, fq * 8), boff = lds_byte(wc * 32 + fr, fq * 8);
#define PG8_SA(b, h) (((b) * 2 + (h)) * HTB)
#define PG8_SB(b, h) ((4 + (b) * 2 + (h)) * HTB)
#define PG8_STAGE(bufoff, gbase, voff) do { _Pragma("unroll") for (int _i = 0; _i < 2; ++_i) \
        __builtin_amdgcn_global_load_lds((const unsigned*)((const char*)(gbase) + (voff)[_i]), (PG8_LAS unsigned*)(lds + (bufoff) + ldsw + _i * 8192), 16, 0, 0); } while (0)
    typedef int v4i_ __attribute__((ext_vector_type(4))); typedef int v8i_ __attribute__((ext_vector_type(8)));
#define PG8_LDA(dst, b, h) do { _Pragma("unroll") for (int m = 0; m < 4; ++m) { if constexpr (F8) { \
        dst##8[m] = __builtin_shufflevector(*(const PG8_LAS v4i_*)(lds + PG8_SA(b, h) + aoff + m * 2048), *(const PG8_LAS v4i_*)(lds + PG8_SA(b, h) + aoff + m * 2048 + 1024), 0, 1, 2, 3, 4, 5, 6, 7); } \
        else { _Pragma("unroll") for (int k = 0; k < 2; ++k) dst[m][k] = *(const PG8_LAS bf16x8*)(lds + PG8_SA(b, h) + aoff + m * 2048 + k * 1024); } } } while (0)
#define PG8_LDB(dst, b, h) do { _Pragma("unroll") for (int n = 0; n < 2; ++n) { if constexpr (F8) { \
        dst##8[n] = __builtin_shufflevector(*(const PG8_LAS v4i_*)(lds + PG8_SB(b, h) + boff + n * 2048), *(const PG8_LAS v4i_*)(lds + PG8_SB(b, h) + boff + n * 2048 + 1024), 0, 1, 2, 3, 4, 5, 6, 7); } \
        else { _Pragma("unroll") for (int k = 0; k < 2; ++k) dst[n][k] = *(const PG8_LAS bf16x8*)(lds + PG8_SB(b, h) + boff + n * 2048 + k * 1024); } } } while (0)
#define PG8_MMA(ai, bj, At, Bt) do { __builtin_amdgcn_s_setprio(1); _Pragma("unroll") for (int m = 0; m < 4; ++m) _Pragma("unroll") for (int n = 0; n < 2; ++n) { \
        if constexpr (F8) { asm volatile("v_mfma_scale_f32_16x16x128_f8f6f4 %0, %1, %2, %0, %3, %4 op_sel_hi:[0,0,0]" : "+v"(acc[ai][bj][m][n]) : "v"(Bt##8[n]), "v"(At##8[m]), "v"(sclB), "v"(sclA)); } \
        else { _Pragma("unroll") for (int k = 0; k < 2; ++k) acc[ai][bj][m][n] = __builtin_amdgcn_mfma_f32_16x16x32_bf16(Bt[n][k], At[m][k], acc[ai][bj][m][n], 0, 0, 0); } } \
        __builtin_amdgcn_s_setprio(0); } while (0)
#define PG8_WAIT_V(n) asm volatile("s_waitcnt vmcnt(" #n ")" ::: "memory")
#define PG8_WAIT_L(n) asm volatile("s_waitcnt lgkmcnt(" #n ")" ::: "memory")
#define PG8_BAR __builtin_amdgcn_s_barrier()
#define PG8_SCHED __builtin_amdgcn_sched_barrier(0)
    Unit cur, nxt; int ui = 0;
    if (!S.next(0, cur)) return;
    f32x4 acc[2][2][4][2];
#pragma unroll
    for (int a = 0; a < 2; ++a)
#pragma unroll
        for (int b = 0; b < 2; ++b)
#pragma unroll
            for (int m = 0; m < 4; ++m)
#pragma unroll
                for (int n = 0; n < 2; ++n) acc[a][b][m][n] = (f32x4){0.f, 0.f, 0.f, 0.f};
    const int sclB = SCALE_B, sclA = SCALE_A;
    bf16x8 At[4][2], B0[2][2], B1[2][2]; v8i_ At8[4], B08[2], B18[2];
    const char* cA = (const char*)g.A + (size_t)cur.pm * tstepA + (size_t)cur.seg * g.segbytes; const char* cB = (const char*)g.Bt + (size_t)cur.pn * tstepB + (size_t)cur.seg * g.segbytes;
    S.a_ready(cur);
    if constexpr (SP2) {
        PG8_STAGE(PG8_SB(0, 0), cB, voffB); PG8_STAGE(PG8_SB(0, 1), cB + hstepB, voffB); PG8_STAGE(PG8_SA(0, 0), cA, voffA); PG8_STAGE(PG8_SA(0, 1), cA + hstepA, voffA);
        if (wr == 1) PG8_BAR;
        PG8_WAIT_V(2); PG8_BAR;
        PG8_STAGE(PG8_SB(1, 0), cB + kstep, voffB); PG8_STAGE(PG8_SA(1, 0), cA + kstep, voffA); PG8_STAGE(PG8_SB(1, 1), cB + hstepB + kstep, voffB);
        PG8_WAIT_V(6); PG8_BAR;
    } else {
        PG8_STAGE(PG8_SB(0, 0), cB, voffB); PG8_STAGE(PG8_SA(0, 0), cA, voffA); PG8_STAGE(PG8_SB(0, 1), cB + hstepB, voffB); PG8_STAGE(PG8_SA(0, 1), cA + hstepA, voffA);
        if (wr == 1) PG8_BAR;
        PG8_WAIT_V(4); PG8_BAR;
        PG8_STAGE(PG8_SB(1, 0), cB + kstep, voffB); PG8_STAGE(PG8_SA(1, 0), cA + kstep, voffA); PG8_STAGE(PG8_SB(1, 1), cB + hstepB + kstep, voffB);
        PG8_WAIT_V(6); PG8_BAR;
    }
    for (;;) {
        const bool has_next = S.next(ui + 1, nxt);
        const char* nA = has_next ? (const char*)g.A + (size_t)nxt.pm * tstepA + (size_t)nxt.seg * g.segbytes : cA; const char* nB = has_next ? (const char*)g.Bt + (size_t)nxt.pn * tstepB + (size_t)nxt.seg * g.segbytes : cB;
        for (int t = 0; t < nt; t += 2) {
            const bool last = (t == nt - 2);
            const char* a1 = cA + (size_t)(t + 1) * kstep;
            const char* a2 = last ? nA : cA + (size_t)(t + 2) * kstep; const char* b2 = last ? nB : cB + (size_t)(t + 2) * kstep;
            const char* a3 = a2 + kstep; const char* b3 = b2 + kstep;
            if (last && has_next) S.a_ready(nxt);
            if constexpr (SP2) {
            PG8_LDB(B0, 0, 0); PG8_LDB(B1, 0, 1); PG8_SCHED; PG8_LDA(At, 0, 0); PG8_STAGE(PG8_SA(1, 1), a1 + hstepA, voffA);
            PG8_WAIT_V(8); PG8_WAIT_L(0); PG8_BAR; PG8_MMA(0, 0, At, B0); PG8_MMA(0, 1, At, B1); PG8_BAR; PG8_SCHED;
            PG8_LDA(At, 0, 1); PG8_STAGE(PG8_SB(0, 0), b2, voffB); PG8_STAGE(PG8_SB(0, 1), b2 + hstepB, voffB); PG8_STAGE(PG8_SA(0, 0), a2, voffA);
            PG8_WAIT_V(8); PG8_WAIT_L(0); PG8_BAR; PG8_MMA(1, 0, At, B0); PG8_MMA(1, 1, At, B1); PG8_BAR; PG8_SCHED;
            PG8_LDB(B0, 1, 0); PG8_LDB(B1, 1, 1); PG8_SCHED; PG8_LDA(At, 1, 0); PG8_STAGE(PG8_SA(0, 1), a2 + hstepA, voffA);
            PG8_WAIT_V(8); PG8_WAIT_L(0); PG8_BAR; PG8_MMA(0, 0, At, B0); PG8_MMA(0, 1, At, B1); PG8_BAR; PG8_SCHED;
            PG8_LDA(At, 1, 1); PG8_STAGE(PG8_SB(1, 0), b3, voffB); PG8_STAGE(PG8_SB(1, 1), b3 + hstepB, voffB); PG8_STAGE(PG8_SA(1, 0), a3, voffA);
            PG8_WAIT_V(8); PG8_WAIT_L(0); PG8_BAR; PG8_MMA(1, 0, At, B0); PG8_MMA(1, 1, At, B1); PG8_BAR; PG8_SCHED;
            } else {
            PG8_LDB(B0, 0, 0); PG8_SCHED; PG8_LDA(At, 0, 0); PG8_STAGE(PG8_SA(1, 1), a1 + hstepA, voffA);
            PG8_WAIT_L(8); PG8_BAR; PG8_WAIT_L(0); PG8_MMA(0, 0, At, B0); PG8_BAR; PG8_SCHED;
            PG8_LDB(B1, 0, 1); PG8_STAGE(PG8_SB(0, 0), b2, voffB);
            PG8_BAR; PG8_WAIT_L(0); PG8_MMA(0, 1, At, B1); PG8_BAR;
            PG8_LDA(At, 0, 1); PG8_STAGE(PG8_SA(0, 0), a2, voffA);
            PG8_BAR; PG8_WAIT_L(0); PG8_MMA(1, 0, At, B0); PG8_BAR; PG8_SCHED;
            PG8_STAGE(PG8_SB(0, 1), b2 + hstepB, voffB);
            PG8_WAIT_V(6); PG8_BAR; PG8_MMA(1, 1, At, B1); PG8_BAR;
            PG8_LDB(B0, 1, 0); PG8_SCHED; PG8_LDA(At, 1, 0); PG8_STAGE(PG8_SA(0, 1), a2 + hstepA, voffA);
            PG8_WAIT_L(8); PG8_BAR; PG8_WAIT_L(0); PG8_MMA(0, 0, At, B0); PG8_BAR; PG8_SCHED;
            PG8_LDB(B1, 1, 1); PG8_STAGE(PG8_SB(1, 0), b3, voffB);
            PG8_BAR; PG8_WAIT_L(0); PG8_MMA(0, 1, At, B1); PG8_BAR;
            PG8_LDA(At, 1, 1); PG8_STAGE(PG8_SA(1, 0), a3, voffA);
            PG8_BAR; PG8_WAIT_L(0); PG8_MMA(1, 0, At, B0); PG8_BAR; PG8_SCHED;
            PG8_STAGE(PG8_SB(1, 1), b3 + hstepB, voffB);
            PG8_WAIT_V(6); PG8_BAR; PG8_MMA(1, 1, At, B1); PG8_BAR;
            }
        }
        if constexpr (ALIGN_EPI) { if (wr == 0) PG8_BAR; }
        if constexpr (F8) asm volatile("s_nop 15\n\ts_nop 15" ::: "memory");
        E(acc, cur, wr, wc, fr, fq); S.done(cur);
        if (!has_next) break;
        if (!(Epi::KEEP_SEG0 && cur.seg == 0))
#pragma unroll
        for (int a = 0; a < 2; ++a)
#pragma unroll
            for (int b = 0; b < 2; ++b)
#pragma unroll
                for (int m = 0; m < 4; ++m)
#pragma unroll
                    for (int n = 0; n < 2; ++n) acc[a][b][m][n] = (f32x4){0.f, 0.f, 0.f, 0.f};
        cur = nxt; cA = nA; cB = nB; ++ui;
        if constexpr (ALIGN_EPI) { if (wr == 1) PG8_BAR; }
    }
    PG8_WAIT_V(0);
    if constexpr (!ALIGN_EPI) { if (wr == 0) PG8_BAR; }
    PG8_BAR;
#undef PG8_SA
#undef PG8_SB
#undef PG8_STAGE
#undef PG8_LDA
#undef PG8_LDB
#undef PG8_MMA
#undef PG8_WAIT_V
#undef PG8_WAIT_L
#undef PG8_BAR
#undef PG8_SCHED
}

typedef f32x4 Acc[2][2][4][2];
__device__ __forceinline__ v4u pack8(const f32x4& v0, const f32x4& v1) { v4u w; w.x = pk2(v0[0], v0[1]); w.y = pk2(v0[2], v0[3]); w.z = pk2(v1[0], v1[1]); w.w = pk2(v1[2], v1[3]); return w; }

struct EpiStore {
    static constexpr bool KEEP_SEG0 = false;
    bf16_t* O; int ldc;
    __device__ __forceinline__ void operator()(Acc& acc, const Unit& u, int wr, int wc, int fr, int fq) const {
        const int row0 = u.pm * BM + wr * 64 + fr, col0 = u.pn * BM + wc * 32 + 8 * fq;
#pragma unroll
        for (int ai = 0; ai < 2; ++ai)
#pragma unroll
            for (int m = 0; m < 4; ++m) { bf16_t* rowp = O + (size_t)(row0 + ai * HALF + m * 16) * ldc + col0;
#pragma unroll
                for (int bj = 0; bj < 2; ++bj) *(v4u*)(rowp + bj * HALF) = pack8(acc[ai][bj][m][0], acc[ai][bj][m][1]); }
    }
};
struct EpiStoreF32 {
    static constexpr bool KEEP_SEG0 = false;
    float* O; int ldc;
    __device__ __forceinline__ void operator()(Acc& acc, const Unit& u, int wr, int wc, int fr, int fq) const {
        const int row0 = u.pm * BM + wr * 64 + fr, col0 = u.pn * BM + wc * 32 + 8 * fq;
#pragma unroll
        for (int ai = 0; ai < 2; ++ai)
#pragma unroll
            for (int m = 0; m < 4; ++m) { float* rowp = O + (size_t)(row0 + ai * HALF + m * 16) * ldc + col0;
#pragma unroll
                for (int bj = 0; bj < 2; ++bj) { *(f32x4*)(rowp + bj * HALF) = acc[ai][bj][m][0]; *(f32x4*)(rowp + bj * HALF + 4) = acc[ai][bj][m][1]; } }
    }
};
__device__ __forceinline__ float f8clamp(float v) { return __builtin_amdgcn_fmed3f(v, -448.f, 448.f); }
struct EpiSwiGLU {
    static constexpr bool KEEP_SEG0 = false;
    unsigned char* O;
    __device__ __forceinline__ void operator()(Acc& acc, const Unit& u, int wr, int wc, int fr, int fq) const {
        const int row0 = u.pm * BM + wr * 64 + fr, col0 = u.pn * HALF + wc * 32 + 8 * fq;
#pragma unroll
        for (int ai = 0; ai < 2; ++ai)
#pragma unroll
            for (int m = 0; m < 4; ++m) { unsigned char* rowp = O + (size_t)(row0 + ai * HALF + m * 16) * DFF + col0;
                f32x4 r0, r1;
#pragma unroll
                for (int i = 0; i < 4; ++i) { r0[i] = f8clamp(8.f * siluf_(acc[ai][0][m][0][i]) * acc[ai][1][m][0][i]); r1[i] = f8clamp(8.f * siluf_(acc[ai][0][m][1][i]) * acc[ai][1][m][1][i]); }
                v2u w; w.x = 0u; w.y = 0u;
                w.x = __builtin_amdgcn_cvt_pk_fp8_f32(r0[0], r0[1], w.x, false); w.x = __builtin_amdgcn_cvt_pk_fp8_f32(r0[2], r0[3], w.x, true);
                w.y = __builtin_amdgcn_cvt_pk_fp8_f32(r1[0], r1[1], w.y, false); w.y = __builtin_amdgcn_cvt_pk_fp8_f32(r1[2], r1[3], w.y, true);
                *(v2u*)rowp = w; }
    }
};
struct EpiProj {
    static constexpr bool KEEP_SEG0 = false;
    unsigned char* rc;
    __device__ __forceinline__ void operator()(Acc& acc, const Unit& u, int wr, int wc, int fr, int fq) const {
        const int row0 = u.pm * BM + wr * 64 + fr, pn = u.pn;
        const int cw = wc * 32 + 8 * fq;
        if (pn < 10) {
            bf16_t* base = (bf16_t*)(rc + (size_t)(pn >> 1) * (64 * MiB)); const int colb = (pn & 1) * 256 + cw;
            const float sc = (pn >= 8) ? 0.125f * 1.4426950408889634f : 1.f;
#pragma unroll
            for (int ai = 0; ai < 2; ++ai)
#pragma unroll
                for (int m = 0; m < 4; ++m) { bf16_t* rowp = base + (size_t)(row0 + ai * HALF + m * 16) * 512 + colb;
#pragma unroll
                    for (int bj = 0; bj < 2; ++bj) *(v4u*)(rowp + bj * HALF) = pack8(acc[ai][bj][m][0] * sc, acc[ai][bj][m][1] * sc); }
        } else if (pn < 13) {
            const int g = cw >> 6, d = cw & 63;
#pragma unroll
            for (int bj = 0; bj < 2; ++bj) { bf16_t* base = (bf16_t*)(rc + RC_KV + (size_t)((pn - 10) * 2 + bj) * (16 * MiB));
#pragma unroll
                for (int ai = 0; ai < 2; ++ai)
#pragma unroll
                    for (int m = 0; m < 4; ++m) { const int row = row0 + ai * HALF + m * 16, b = row >> 12, s = row & 4095;
                        *(v4u*)(base + ((size_t)((b * 2 + g) * 4096 + s)) * 64 + d) = pack8(acc[ai][bj][m][0], acc[ai][bj][m][1]); } }
        } else if (pn < 21) {
            bf16_t* base = (bf16_t*)(rc + (pn < 17 ? RC_GM : RC_GN)); const int colb = ((pn - 13) & 3) * 256 + cw;
#pragma unroll
            for (int ai = 0; ai < 2; ++ai)
#pragma unroll
                for (int m = 0; m < 4; ++m) { bf16_t* rowp = base + (size_t)(row0 + ai * HALF + m * 16) * 1024 + colb;
#pragma unroll
                    for (int bj = 0; bj < 2; ++bj) { f32x4 s0, s1;
#pragma unroll
                        for (int i = 0; i < 4; ++i) { s0[i] = sigmoidf_(acc[ai][bj][m][0][i]); s1[i] = sigmoidf_(acc[ai][bj][m][1][i]); }
                        *(v4u*)(rowp + bj * HALF) = pack8(s0, s1); } }
        } else {
            if (wc == 0) {
                float* ifm = (float*)(rc + RC_IF); float* gg = (float*)(rc + RC_GG);
#pragma unroll
                for (int ai = 0; ai < 2; ++ai)
#pragma unroll
                    for (int m = 0; m < 4; ++m) { const size_t row = (size_t)(row0 + ai * HALF + m * 16);
                        float* p = (fq == 0) ? (ifm + row * 8) : (gg + row * 24 + (fq - 1) * 8);
                        *(f32x4*)p = acc[ai][0][m][0]; *(f32x4*)(p + 4) = acc[ai][0][m][1]; }
            }
        }
    }
};
struct EpiMergeFused {
    static constexpr bool KEEP_SEG0 = true;
    bf16_t* O; const bf16_t* gm; const bf16_t* gn;
    __device__ __forceinline__ void operator()(Acc& acc, const Unit& u, int wr, int wc, int fr, int fq) const {
        const int row0 = u.pm * BM + wr * 64 + fr, col0 = u.pn * BM + wc * 32 + 8 * fq;
        if (u.seg == 0) {
#pragma unroll
            for (int ai = 0; ai < 2; ++ai)
#pragma unroll
                for (int m = 0; m < 4; ++m) { const size_t off = (size_t)(row0 + ai * HALF + m * 16) * 1024 + col0;
#pragma unroll
                    for (int bj = 0; bj < 2; ++bj) { const v4u a = *(const v4u*)(gm + off + bj * HALF), b = *(const v4u*)(gn + off + bj * HALF);
                        float x[8], y[8]; unpack8(a, x); unpack8(b, y);
#pragma unroll
                        for (int i = 0; i < 4; ++i) { acc[ai][bj][m][0][i] *= x[i] * __builtin_amdgcn_rcpf(y[i]); acc[ai][bj][m][1][i] *= x[4 + i] * __builtin_amdgcn_rcpf(y[4 + i]); } } }
        } else {
#pragma unroll
            for (int ai = 0; ai < 2; ++ai)
#pragma unroll
                for (int m = 0; m < 4; ++m) { const size_t off = (size_t)(row0 + ai * HALF + m * 16) * 1024 + col0;
#pragma unroll
                    for (int bj = 0; bj < 2; ++bj) { const v4u b = *(const v4u*)(gn + off + bj * HALF); float y[8]; unpack8(b, y);
                        f32x4 r0, r1;
#pragma unroll
                        for (int i = 0; i < 4; ++i) { r0[i] = acc[ai][bj][m][0][i] * y[i]; r1[i] = acc[ai][bj][m][1][i] * y[4 + i]; }
                        *(v4u*)(O + off + bj * HALF) = pack8(r0, r1); } }
        }
    }
};
template <bool ADD> struct EpiMerge {
    static constexpr bool KEEP_SEG0 = false;
    bf16_t* O; const bf16_t* gate;
    __device__ __forceinline__ void operator()(Acc& acc, const Unit& u, int wr, int wc, int fr, int fq) const {
        const int row0 = u.pm * BM + wr * 64 + fr, col0 = u.pn * BM + wc * 32 + 8 * fq;
#pragma unroll
        for (int ai = 0; ai < 2; ++ai)
#pragma unroll
            for (int m = 0; m < 4; ++m) { const size_t off = (size_t)(row0 + ai * HALF + m * 16) * 1024 + col0;
#pragma unroll
                for (int bj = 0; bj < 2; ++bj) { const v4u gv = *(const v4u*)(gate + off + bj * HALF); v4u pv = (v4u){0u, 0u, 0u, 0u}; if (ADD) pv = *(const v4u*)(O + off + bj * HALF);
                    f32x4 r0, r1; const f32x4 a0 = acc[ai][bj][m][0], a1 = acc[ai][bj][m][1];
                    r0[0] = sigmoidf_(bflo(gv.x)) * a0[0]; r0[1] = sigmoidf_(bfhi(gv.x)) * a0[1]; r0[2] = sigmoidf_(bflo(gv.y)) * a0[2]; r0[3] = sigmoidf_(bfhi(gv.y)) * a0[3];
                    r1[0] = sigmoidf_(bflo(gv.z)) * a1[0]; r1[1] = sigmoidf_(bfhi(gv.z)) * a1[1]; r1[2] = sigmoidf_(bflo(gv.w)) * a1[2]; r1[3] = sigmoidf_(bfhi(gv.w)) * a1[3];
                    if (ADD) { r0[0] += bflo(pv.x); r0[1] += bfhi(pv.x); r0[2] += bflo(pv.y); r0[3] += bfhi(pv.y); r1[0] += bflo(pv.z); r1[1] += bfhi(pv.z); r1[2] += bflo(pv.w); r1[3] += bfhi(pv.w); }
                    *(v4u*)(O + off + bj * HALF) = pack8(r0, r1); } }
    }
};
}

#define XB_TMO      128
#define XB_XCNT(j)  (256  + 64 * (j))
#define XB_XSUB(j)  (1280 + 64 * (j))
#define XB_XGEN(j)  (2304 + 64 * (j))
#define XB_TOP      3328
#define XB_TOPGEN   3392
#define XCD_BAR_WORDS 3456
#define XB_SPIN_CAP (1u << 22)

__device__ __forceinline__ unsigned xb_ld(unsigned* p)              { return __hip_atomic_load(p, __ATOMIC_RELAXED, __HIP_MEMORY_SCOPE_AGENT); }
__device__ __forceinline__ unsigned xb_add(unsigned* p, unsigned v) { return __hip_atomic_fetch_add(p, v, __ATOMIC_RELAXED, __HIP_MEMORY_SCOPE_AGENT); }
__device__ __forceinline__ unsigned xb_xcc_id() { return (unsigned)__builtin_amdgcn_s_getreg((3 << 11) | 20) & 0xFu; }
#define XB_SPIN(cond, bar) do { unsigned _sp = 0; while (cond) { __builtin_amdgcn_s_sleep(1); \
    if ((++_sp & 255u) == 0u) { if (xb_ld(&(bar)[XB_TMO])) break; if (_sp > XB_SPIN_CAP) { atomicAdd(&(bar)[XB_TMO], 1u); break; } } } } while (0)

struct XcdBarrier { unsigned* bar; unsigned x; volatile LAS unsigned* st; };

__device__ __forceinline__ XcdBarrier xcd_barrier_post(unsigned* bar, volatile LAS unsigned* st) {
    XcdBarrier b; b.bar = bar; b.x = xb_xcc_id(); b.st = st;
    if (threadIdx.x == 0) (void)xb_add(&bar[XB_XCNT(b.x)], 1u);
    return b;
}
__device__ __forceinline__ void xcd_barrier_complete(unsigned* bar, unsigned x, unsigned& nloc, unsigned& nx) {
    const unsigned G = gridDim.x * gridDim.y * gridDim.z;
    unsigned sum, cnt, mine, sp = 0u;
    for (;;) {
        sum = 0u; cnt = 0u; mine = 0u;
#pragma unroll
        for (unsigned j = 0; j < 16; ++j) { const unsigned c = xb_ld(&bar[XB_XCNT(j)]); sum += c; cnt += (c > 0u) ? 1u : 0u; mine = (j == x) ? c : mine; }
        if (sum == G) break;
        __builtin_amdgcn_s_sleep(1);
        if ((++sp & 255u) == 0u) { if (xb_ld(&bar[XB_TMO])) break; if (sp > XB_SPIN_CAP) { atomicAdd(&bar[XB_TMO], 1u); break; } }
    }
    nloc = mine > 0u ? mine : 1u; nx = cnt > 0u ? cnt : 1u;
}
__device__ __forceinline__ void xcd_barrier(const XcdBarrier& b) {
    asm volatile("s_waitcnt vmcnt(0)" ::: "memory");
    __syncthreads();
    if (threadIdx.x == 0) {
        unsigned* bar = b.bar;
        __builtin_amdgcn_s_waitcnt(0);
        unsigned nloc = b.st[0], nx = b.st[1];
        if (nloc == 0u) { xcd_barrier_complete(bar, b.x, nloc, nx); b.st[0] = nloc; b.st[1] = nx; }
        const unsigned old = xb_add(&bar[XB_XSUB(b.x)], 1u);
        const unsigned gen = old / nloc;
        if (old + 1u == (gen + 1u) * nloc) {
            __builtin_amdgcn_fence(__ATOMIC_RELEASE, "agent");
            asm volatile("s_waitcnt vmcnt(0)" ::: "memory");
            const unsigned og = xb_add(&bar[XB_TOP], 1u);
            const unsigned tg = og / nx;
            if (og + 1u == (tg + 1u) * nx) xb_add(&bar[XB_TOPGEN], 1u);
            else XB_SPIN(xb_ld(&bar[XB_TOPGEN]) == tg, bar);
            __builtin_amdgcn_fence(__ATOMIC_ACQUIRE, "agent");
            xb_add(&bar[XB_XGEN(b.x)], 1u);
            asm volatile("s_waitcnt vmcnt(0)" ::: "memory");
        } else {
            XB_SPIN(xb_ld(&bar[XB_XGEN(b.x)]) == gen, bar);
            __builtin_amdgcn_fence(__ATOMIC_ACQUIRE, "agent");
            asm volatile("s_waitcnt vmcnt(0)" ::: "memory");
        }
    }
    __syncthreads();
}

struct Args { const float* in[21]; float* out; unsigned char* ws; int ph_lo, ph_hi; };
enum { I_X = 0, I_C, I_WADA, I_BADA, I_GAINS, I_WG, I_WU, I_WD, I_WIN, I_CONVW, I_CONVB, I_GATEB, I_HGAIN, I_PE, I_CW1, I_CB1, I_CW2, I_CB2, I_WUPM, I_WUPN, I_WOUT };

struct Frame {
    LAS unsigned char* lds;
    int tid, lane, wave, vcu, G;
};

struct ColMap { const float* p; int ld; };
template <int KIND> __device__ __forceinline__ ColMap colmap(const Args& a, int layer, int n) {
    ColMap r; r.p = nullptr; r.ld = 0;
    if (KIND == 0) {
        const int pn = n >> 8, bj = (n >> 7) & 1, j = n & 127; const float* w = (bj ? a.in[I_WU] : a.in[I_WG]) + (size_t)layer * DM * DFF;
        r.p = w + pn * 128 + j; r.ld = DFF;
    } else if (KIND == 1) {
        r.p = a.in[I_WD] + (size_t)layer * DFF * DM + n; r.ld = DM;
    } else if (KIND == 2) {
        int sc; if (n < 2048) sc = n; else if (n < 3328) sc = n + 8; else if (n < 5376) sc = n + 32; else if (n < 5384) sc = n - 5376 + 2048; else if (n < 5408) sc = n - 5384 + 3336; else sc = -1;
        if (sc >= 0) { r.p = a.in[I_WIN] + sc; r.ld = 5408; }
    } else if (KIND == 3) { r.p = a.in[I_WUPM] + n; r.ld = DM; }
    else if (KIND == 4) { r.p = a.in[I_WUPN] + n; r.ld = DM; }
    else if (KIND == 5) { r.p = a.in[I_WOUT] + n; r.ld = DM; }
    else {
        const float* w = a.in[I_CW1] + (size_t)layer * 2048 * 256; r.p = w + (size_t)(n >> 8) * 1024 * 256 + (n & 255); r.ld = 256;
    }
    return r;
}
template <int KIND> __device__ __forceinline__ void transpose_item(const Args& a, int layer, int K, int N, bf16* WT, LAS unsigned* scr, int item, int lane, int ldw = 0) {
    const int nblk = N / 64, kb = item / nblk, nb = item % nblk, k0 = 64 * kb, n0 = 64 * nb;
    const ColMap cm = colmap<KIND>(a, layer, n0 + lane);
    float v[64];
#pragma unroll
    for (int kk = 0; kk < 64; ++kk) v[kk] = cm.p ? cm.p[(size_t)(k0 + kk) * cm.ld] : 0.f;
#pragma unroll
    for (int kk = 0; kk < 64; kk += 2) scr[lane * 33 + (kk >> 1)] = pk2(v[kk], v[kk + 1]);
    LDS_WAIT(); asm volatile("" ::: "memory");
    const int c = lane & 7;
#pragma unroll
    for (int j = 0; j < 8; ++j) { const int n = (lane >> 3) + 8 * j; const LAS unsigned* sp = scr + n * 33 + 4 * c;
        v4u o; o.x = sp[0]; o.y = sp[1]; o.z = sp[2]; o.w = sp[3];
        *(v4u*)(WT + (size_t)(n0 + n) * (ldw ? ldw : K) + k0 + 8 * c) = o; }
    LDS_WAIT(); asm volatile("" ::: "memory");
}
__device__ __forceinline__ void transpose_item_f8(const Args& a, int layer, bf16* WT_, LAS unsigned* scr, int item, int lane) {
    unsigned char* WT = (unsigned char*)WT_;
    const int nblk = DM / 64, kb = item / nblk, nb = item % nblk, k0 = 64 * kb, n0 = 64 * nb;
    const float* p = a.in[I_WD] + (size_t)layer * DFF * DM + n0 + lane;
    float v[64];
#pragma unroll
    for (int kk = 0; kk < 64; ++kk) v[kk] = p[(size_t)(k0 + kk) * DM];
#pragma unroll
    for (int kk = 0; kk < 64; kk += 4) { unsigned w = 0u;
        w = __builtin_amdgcn_cvt_pk_fp8_f32(__builtin_amdgcn_fmed3f(1024.f * v[kk], -448.f, 448.f), __builtin_amdgcn_fmed3f(1024.f * v[kk + 1], -448.f, 448.f), w, false);
        w = __builtin_amdgcn_cvt_pk_fp8_f32(__builtin_amdgcn_fmed3f(1024.f * v[kk + 2], -448.f, 448.f), __builtin_amdgcn_fmed3f(1024.f * v[kk + 3], -448.f, 448.f), w, true);
        scr[lane * 17 + (kk >> 2)] = w; }
    LDS_WAIT(); asm volatile("" ::: "memory");
    const int c = lane & 3;
#pragma unroll
    for (int j = 0; j < 4; ++j) { const int n = (lane >> 2) + 16 * j; const LAS unsigned* sp = scr + n * 17 + 4 * c;
        v4u o; o.x = sp[0]; o.y = sp[1]; o.z = sp[2]; o.w = sp[3];
        *(v4u*)(WT + (size_t)(n0 + n) * DFF + k0 + 16 * c) = o; }
    LDS_WAIT(); asm volatile("" ::: "memory");
}
__device__ __forceinline__ void p0_prologue(const Args& a, Frame& F) {
    unsigned char* ws = a.ws;
    {
        LAS float* sc = (LAS float*)F.lds;
        LAS float* red = (LAS float*)(F.lds + 65536);
        bool have = false;
        for (int cg = F.vcu; cg < 144; cg += F.G) {
            if (!have) { for (int i = F.tid; i < NB * DM; i += NTHREADS) sc[i] = siluf_(a.in[I_C][i]); have = true; __syncthreads(); }
            float acc[16];
#pragma unroll
            for (int b = 0; b < 16; ++b) acc[b] = 0.f;
            const float* wp = a.in[I_WADA] + (size_t)(F.wave * 128) * 9216 + cg * 64 + F.lane;
#pragma unroll 1
            for (int k0 = 0; k0 < 128; k0 += 16) { float wv[16];
#pragma unroll
                for (int i = 0; i < 16; ++i) wv[i] = wp[(size_t)(k0 + i) * 9216];
#pragma unroll
                for (int i = 0; i < 16; ++i)
#pragma unroll
                    for (int b = 0; b < 16; ++b) acc[b] += sc[b * 1024 + F.wave * 128 + k0 + i] * wv[i]; }
#pragma unroll
            for (int b = 0; b < 16; ++b) red[(F.wave * 16 + b) * 64 + F.lane] = acc[b];
            __syncthreads();
            for (int i = F.tid; i < 16 * 64; i += NTHREADS) { const int b = i >> 6, l = i & 63; float s = 0.f;
#pragma unroll
                for (int w = 0; w < 8; ++w) s += red[(w * 16 + b) * 64 + l];
                ((float*)(ws + WS_ADA))[b * 9216 + cg * 64 + l] = s + a.in[I_BADA][cg * 64 + l]; }
            __syncthreads();
        }
        __syncthreads();
    }
    { const int slot = F.vcu - (F.G - 32);
      if (slot >= 0) { const int kv = slot >> 4, part = slot & 15, c = F.tid & 255, half = F.tid >> 8;
        const float* w1 = a.in[I_CW1] + (size_t)kv * 2048 * 256 + (size_t)(part * 128 + half * 64) * 256 + c; const float* pe = a.in[I_PE] + (size_t)kv * 2048 + part * 128 + half * 64;
        float sacc = 0.f;
#pragma unroll 1
        for (int r0 = 0; r0 < 64; r0 += 16) { float wv[16];
#pragma unroll
            for (int i = 0; i < 16; ++i) wv[i] = w1[(size_t)(r0 + i) * 256];
#pragma unroll
            for (int i = 0; i < 16; ++i) sacc += pe[r0 + i] * wv[i]; }
        LAS float* red = (LAS float*)(F.lds + 98304);
        __syncthreads();
        if (half) red[c] = sacc;
        __syncthreads();
        if (!half) ((float*)(ws + WS_B1P))[(kv * 16 + part) * 256 + c] = sacc + red[c];
        __syncthreads(); } }
    LAS unsigned* scr = (LAS unsigned*)(F.lds + F.wave * 16384);
    const int gw = F.vcu * NWAVES + F.wave, NGW = F.G * NWAVES;
    constexpr int I_GU = (DM / 64) * (NPROJ / 64), I_DN = (DFF / 64) * (DM / 64), I_IN = (DM / 64) * (NPROJ / 64), I_UP = (512 / 64) * (DM / 64), I_OUT = (DM / 64) * (DM / 64), I_C1 = (1024 / 64) * (512 / 64);
    constexpr int NITEMS = 2 * I_GU + 2 * I_DN + I_IN + 2 * I_UP + I_OUT + 2 * I_C1;
    for (int it = gw; it < NITEMS; it += NGW) {
        int r = it;
        if (r < I_GU) { transpose_item<0>(a, 0, DM, NPROJ, (bf16*)(ws + WS_W1T), scr, r, F.lane); continue; } r -= I_GU;
        if (r < I_GU) { transpose_item<0>(a, 1, DM, NPROJ, (bf16*)(ws + WS_W1T) + (size_t)NPROJ * DM, scr, r, F.lane); continue; } r -= I_GU;
        if (r < I_DN) { transpose_item_f8(a, 0, (bf16*)(ws + WS_W1D), scr, r, F.lane); continue; } r -= I_DN;
        if (r < I_DN) { transpose_item_f8(a, 1, (bf16*)(ws + WS_W1D + (size_t)DM * DFF), scr, r, F.lane); continue; } r -= I_DN;
        if (r < I_IN) { transpose_item<2>(a, 0, DM, NPROJ, (bf16*)(ws + WS_WIN), scr, r, F.lane); continue; } r -= I_IN;
        if (r < I_UP) { transpose_item<3>(a, 0, 512, DM, (bf16*)(ws + WS_WUPM), scr, r, F.lane, 1024); continue; } r -= I_UP;
        if (r < I_UP) { transpose_item<4>(a, 0, 512, DM, (bf16*)(ws + WS_WUPM) + 512, scr, r, F.lane, 1024); continue; } r -= I_UP;
        if (r < I_OUT) { transpose_item<5>(a, 0, DM, DM, (bf16*)(ws + WS_WOUT), scr, r, F.lane); continue; } r -= I_OUT;
        if (r < I_C1) { transpose_item<6>(a, 0, 1024, 512, (bf16*)(ws + WS_WC1), scr, r, F.lane); continue; } r -= I_C1;
        transpose_item<6>(a, 1, 1024, 512, (bf16*)(ws + WS_WC1) + (size_t)512 * 1024, scr, r, F.lane);
    }
}

template <int MODE, bool RES_BF = false, bool OUT_BF = false> __device__ __forceinline__ void thin_phase(const Args& a, Frame& F, const void* res_, const bf16* f, void* out_, bf16* u, int s_post, int s_pre, float rw) {
    const float* res = (const float*)res_; const bf16* resb = (const bf16*)res_; float* out = (float*)out_; bf16* outb = (bf16*)out_;
    constexpr int R = 4;
    const float* ada = (const float*)(a.ws + WS_ADA); const float* gains = a.in[I_GAINS];
    const int gw = F.vcu * NWAVES + F.wave, NGW = F.G * NWAVES;
    for (int row0 = gw * R; row0 < T; row0 += NGW * R) {
        const int b = row0 >> 12;
        f32x4 h[R][4]; v2u fw[R][4];
#pragma unroll
        for (int r = 0; r < R; ++r)
#pragma unroll
            for (int j = 0; j < 4; ++j) { if (RES_BF) { const v2u w = *(const v2u*)(resb + (size_t)(row0 + r) * DM + 256 * j + 4 * F.lane); h[r][j] = (f32x4){bflo(w.x), bfhi(w.x), bflo(w.y), bfhi(w.y)}; }
                else h[r][j] = *(const f32x4*)(res + (size_t)(row0 + r) * DM + 256 * j + 4 * F.lane);
                if (MODE != 0) fw[r][j] = *(const v2u*)(f + (size_t)(row0 + r) * DM + 256 * j + 4 * F.lane); }
        if (MODE != 0) {
            const float* gp = gains + (2 * s_post + 1) * DM; const float* gt = ada + (size_t)b * 9216 + (s_post * 3 + 2) * DM;
            f32x4 g4[4], t4[4];
#pragma unroll
            for (int j = 0; j < 4; ++j) { g4[j] = *(const f32x4*)(gp + 256 * j + 4 * F.lane); t4[j] = *(const f32x4*)(gt + 256 * j + 4 * F.lane) * rw; }
#pragma unroll
            for (int r = 0; r < R; ++r) { f32x4 fv[4]; float ss = 0.f;
#pragma unroll
                for (int j = 0; j < 4; ++j) { const v2u w = fw[r][j]; fv[j] = (f32x4){bflo(w.x), bfhi(w.x), bflo(w.y), bfhi(w.y)};
                    ss += fv[j][0] * fv[j][0] + fv[j][1] * fv[j][1] + fv[j][2] * fv[j][2] + fv[j][3] * fv[j][3]; }
                const float rstd = rsqrtf(wave_sum(ss) * (1.f / DM) + EPS);
#pragma unroll
                for (int j = 0; j < 4; ++j) { h[r][j] = h[r][j] + t4[j] * (fv[j] * rstd * g4[j]);
                    if (OUT_BF) { v2u w; w.x = pk2(h[r][j][0], h[r][j][1]); w.y = pk2(h[r][j][2], h[r][j][3]); *(v2u*)(outb + (size_t)(row0 + r) * DM + 256 * j + 4 * F.lane) = w; }
                    else *(f32x4*)(out + (size_t)(row0 + r) * DM + 256 * j + 4 * F.lane) = h[r][j]; } }
        }
        if (MODE != 2) {
            const float* gp = gains + (2 * s_pre) * DM; const float* sh = ada + (size_t)b * 9216 + (s_pre * 3 + 0) * DM; const float* sc = sh + DM;
            f32x4 g4[4], s4[4], c4[4];
#pragma unroll
            for (int j = 0; j < 4; ++j) { g4[j] = *(const f32x4*)(gp + 256 * j + 4 * F.lane); s4[j] = *(const f32x4*)(sh + 256 * j + 4 * F.lane); c4[j] = 1.f + *(const f32x4*)(sc + 256 * j + 4 * F.lane); }
#pragma unroll
            for (int r = 0; r < R; ++r) { float ss = 0.f;
#pragma unroll
                for (int j = 0; j < 4; ++j) ss += h[r][j][0] * h[r][j][0] + h[r][j][1] * h[r][j][1] + h[r][j][2] * h[r][j][2] + h[r][j][3] * h[r][j][3];
                const float rstd = rsqrtf(wave_sum(ss) * (1.f / DM) + EPS);
#pragma unroll
                for (int j = 0; j < 4; ++j) { const f32x4 y = (h[r][j] * rstd * g4[j]) * c4[j] + s4[j];
                    v2u w; w.x = pk2(y[0], y[1]); w.y = pk2(y[2], y[3]);
                    *(v2u*)(u + (size_t)(row0 + r) * DM + 256 * j + 4 * F.lane) = w; } }
        }
    }
}

constexpr int MQ_OFF = 0, MK_OFF = 64 * 129 * 4, MV_OFF = 2 * 64 * 129 * 4, MS_OFF = 3 * 64 * 129 * 4, MCT_OFF = MS_OFF + 64 * 65 * 4, MVEC_OFF = MCT_OFF + 128 * 130 * 2;
static_assert(MVEC_OFF + 8 * 256 <= MISC_OFF, "mlstm lds");
template <bool WANTQ> __device__ __forceinline__ void mlstm_load_chunk(const Args& a, Frame& F, int b, int h, int c) {
    unsigned char* rc = a.ws + WS_RC;
    const bf16* qm = (const bf16*)(rc + RC_QM); const bf16* km = (const bf16*)(rc + RC_KM); const bf16* vm = (const bf16*)(rc + RC_VM); const float* ifm = (const float*)(rc + RC_IF);
    LAS float* Qs = (LAS float*)(F.lds + MQ_OFF); LAS float* Ks = (LAS float*)(F.lds + MK_OFF); LAS float* Vs = (LAS float*)(F.lds + MV_OFF);
    LAS float* bcum = (LAS float*)(F.lds + MVEC_OFF); LAS float* ig = bcum + 64;
    const int t0 = c * CHUNK; const size_t row0 = (size_t)b * SEQ + t0;
    if (F.tid < 64) { const float* g = ifm + (row0 + F.tid) * 8; const float fp = g[4 + h] + a.in[I_GATEB][4 + h];
        ig[F.tid] = g[h] + a.in[I_GATEB][h];
        bcum[F.tid] = fminf(fp, 0.f) - log1pf(__expf(-fabsf(fp))); }
    __syncthreads();
    if (F.tid == 0) { float s = 0.f; for (int i = 0; i < 64; ++i) { s += bcum[i]; bcum[i] = s; } }
    const float* cw = a.in[I_CONVW]; const float* cb = a.in[I_CONVB];
    for (int idx = F.tid; idx < 64 * 128; idx += NTHREADS) { const int t = idx >> 7, d = idx & 127, ch = h * 128 + d;
        float accq = cb[ch], acck = cb[512 + ch];
#pragma unroll
        for (int j = 0; j < 4; ++j) { const int tt = t0 + t - 3 + j; if (tt >= 0) { const size_t r = (size_t)b * SEQ + tt;
                if (WANTQ) accq += cw[j * 1024 + ch] * bf2f(qm[r * 512 + ch]);
                acck += cw[j * 1024 + 512 + ch] * bf2f(km[r * 512 + ch]); } }
        if (WANTQ) Qs[t * 129 + d] = siluf_(accq);
        Ks[t * 129 + d] = siluf_(acck) * 0.08838834764831845f;
        Vs[t * 129 + d] = bf2f(vm[(row0 + t) * 512 + ch]); }
    __syncthreads();
}
__device__ __forceinline__ void mlstm_local_unit(const Args& a, Frame& F, int unit) {
    const int c = unit & 63, h = (unit >> 6) & 3, b = unit >> 8;
    mlstm_load_chunk<false>(a, F, b, h, c);
    LAS float* Ks = (LAS float*)(F.lds + MK_OFF); LAS float* Vs = (LAS float*)(F.lds + MV_OFF);
    LAS float* bcum = (LAS float*)(F.lds + MVEC_OFF); LAS float* ig = bcum + 64; LAS float* wv = bcum + 128;
    const float blast = bcum[63];
    float g = -1e30f; if (F.tid < 64) g = blast - bcum[F.tid] + ig[F.tid];
    float mloc = 0.f;
    if (F.wave == 0) { mloc = wave_max(g); wv[F.tid] = __expf(g - mloc); if (F.tid == 0) { float* cs = (float*)(a.ws + WS_CSC) + (size_t)unit * 2; cs[0] = blast; cs[1] = mloc; } }
    __syncthreads();
    const int e = F.tid >> 2, dq = (F.tid & 3) * 32;
    float acc[32];
#pragma unroll
    for (int i = 0; i < 32; ++i) acc[i] = 0.f;
    for (int s = 0; s < 64; ++s) { const float vv = Vs[s * 129 + e] * wv[s];
#pragma unroll
        for (int i = 0; i < 32; ++i) acc[i] += vv * Ks[s * 129 + dq + i]; }
    bf16* st = (bf16*)(a.ws + WS_RB) + (size_t)unit * 16384 + e * 128 + dq;
#pragma unroll
    for (int i = 0; i < 32; i += 8) { v4u w; w.x = pk2(acc[i], acc[i + 1]); w.y = pk2(acc[i + 2], acc[i + 3]); w.z = pk2(acc[i + 4], acc[i + 5]); w.w = pk2(acc[i + 6], acc[i + 7]); *(v4u*)(st + i) = w; }
    if (F.tid < 128) { float s = 0.f; for (int t = 0; t < 64; ++t) s += wv[t] * Ks[t * 129 + F.tid]; ((float*)(a.ws + WS_NST))[(size_t)unit * 128 + F.tid] = s; }
    __syncthreads();
}
__device__ __forceinline__ void mlstm_scan(const Args& a, Frame& F) {
    const float* csc = (const float*)(a.ws + WS_CSC); float* mprev = (float*)(a.ws + WS_MPREV);
    bf16* st = (bf16*)(a.ws + WS_RB); float* nst = (float*)(a.ws + WS_NST);
    const int gt = F.vcu * NTHREADS + F.tid, NGT = F.G * NTHREADS;
    LAS float* tab = (LAS float*)F.lds;
    for (int idx = gt; idx < 64 * 2048; idx += NGT) { const int bh = idx >> 11, p = idx & 2047;
        __syncthreads();
        if (F.tid == 0) { float m = 0.f; for (int c = 0; c < 64; ++c) { const float bl = csc[(bh * 64 + c) * 2], ml = csc[(bh * 64 + c) * 2 + 1]; const float mn = fmaxf(bl + m, ml); tab[2 * c] = __expf(bl + m - mn); tab[2 * c + 1] = __expf(ml - mn); m = mn; } }
        __syncthreads();
        float cv[8];
#pragma unroll
        for (int i = 0; i < 8; ++i) cv[i] = 0.f;
        v4u* base = (v4u*)(st + (size_t)(bh * 64) * 16384) + p;
#pragma unroll 1
        for (int c0 = 0; c0 < 64; c0 += 8) { v4u uw[8];
#pragma unroll
            for (int k = 0; k < 8; ++k) uw[k] = base[(size_t)(c0 + k) * 2048];
#pragma unroll
            for (int k = 0; k < 8; ++k) { const int c = c0 + k;
                v4u o; o.x = pk2(cv[0], cv[1]); o.y = pk2(cv[2], cv[3]); o.z = pk2(cv[4], cv[5]); o.w = pk2(cv[6], cv[7]); base[(size_t)c * 2048] = o;
                const float dec = tab[2 * c], sc = tab[2 * c + 1];
                float x[8]; unpack8(uw[k], x);
#pragma unroll
                for (int i = 0; i < 8; ++i) cv[i] = dec * cv[i] + sc * x[i]; } } }
    __syncthreads();
    for (int idx = gt; idx < 64 * 128; idx += NGT) { const int bh = idx >> 7, d = idx & 127;
        float m = 0.f, n = 0.f;
        float* base = nst + (size_t)(bh * 64) * 128 + d;
#pragma unroll 1
        for (int c0 = 0; c0 < 64; c0 += 16) { float nl[16];
#pragma unroll
            for (int k = 0; k < 16; ++k) nl[k] = base[(size_t)(c0 + k) * 128];
#pragma unroll
            for (int k = 0; k < 16; ++k) { const int c = c0 + k; base[(size_t)c * 128] = n;
                if (d == 0) mprev[bh * 64 + c] = m;
                const float bl = csc[(bh * 64 + c) * 2], ml = csc[(bh * 64 + c) * 2 + 1];
                const float mn = fmaxf(bl + m, ml), dec = __expf(bl + m - mn), sc = __expf(ml - mn);
                n = dec * n + sc * nl[k]; m = mn; } } }
}
__device__ __forceinline__ void mlstm_out_unit(const Args& a, Frame& F, int unit) {
    const int c = unit & 63, h = (unit >> 6) & 3, b = unit >> 8;
    mlstm_load_chunk<true>(a, F, b, h, c);
    LAS float* Qs = (LAS float*)(F.lds + MQ_OFF); LAS float* Ks = (LAS float*)(F.lds + MK_OFF); LAS float* Vs = (LAS float*)(F.lds + MV_OFF); LAS float* Ss = (LAS float*)(F.lds + MS_OFF);
    LAS bf16* CT = (LAS bf16*)(F.lds + MCT_OFF);
    LAS float* bcum = (LAS float*)(F.lds + MVEC_OFF); LAS float* ig = bcum + 64; LAS float* mt = bcum + 128; LAS float* wi = bcum + 192; LAS float* den = bcum + 256; LAS float* nv = bcum + 320;
    const float mp = ((const float*)(a.ws + WS_MPREV))[unit];
    const bf16* ctg = (const bf16*)(a.ws + WS_RB) + (size_t)unit * 16384;
    for (int idx = F.tid; idx < 128 * 64; idx += NTHREADS) { const int e = idx >> 6, dp = idx & 63; *(LAS unsigned*)(CT + e * 130 + 2 * dp) = *(const unsigned*)(ctg + e * 128 + 2 * dp); }
    if (F.tid < 128) nv[F.tid] = ((const float*)(a.ws + WS_NST))[(size_t)unit * 128 + F.tid];
    if (F.tid < 64) { const int t = F.tid; const float bt = bcum[t], at = bt + mp; float mm = at;
        for (int s = 0; s <= t; ++s) mm = fmaxf(mm, bt - bcum[s] + ig[s]);
        mt[t] = mm; wi[t] = __expf(at - mm); }
    __syncthreads();
    { const int s = F.tid & 63, tb = (F.tid >> 6) * 8;
#pragma unroll
        for (int i = 0; i < 8; ++i) { const int t = tb + i; float v = 0.f;
            if (s <= t) { float d = 0.f; for (int k = 0; k < 128; ++k) d += Qs[t * 129 + k] * Ks[s * 129 + k]; v = d * __expf(bcum[t] - bcum[s] + ig[s] - mt[t]); }
            Ss[t * 65 + s] = v; } }
    __syncthreads();
    if (F.tid < 64) { const int t = F.tid; float sd = 0.f; for (int s = 0; s <= t; ++s) sd += Ss[t * 65 + s]; float qn = 0.f; for (int k = 0; k < 128; ++k) qn += Qs[t * 129 + k] * nv[k];
        den[t] = sd + wi[t] * qn; }
    const int t = F.tid >> 3, e0 = (F.tid & 7) * 16;
    float num[16], qc[16];
#pragma unroll
    for (int i = 0; i < 16; ++i) { num[i] = 0.f; qc[i] = 0.f; }
    for (int s = 0; s <= t; ++s) { const float sv = Ss[t * 65 + s];
#pragma unroll
        for (int i = 0; i < 16; ++i) num[i] += sv * Vs[s * 129 + e0 + i]; }
    for (int k = 0; k < 128; ++k) { const float qv = Qs[t * 129 + k];
#pragma unroll
        for (int i = 0; i < 16; ++i) qc[i] += qv * bf2f(CT[(e0 + i) * 130 + k]); }
    __syncthreads();
    const float dn = fmaxf(fabsf(den[t]), __expf(-mt[t])), wt = wi[t];
    float ss = 0.f;
#pragma unroll
    for (int i = 0; i < 16; ++i) { num[i] = (num[i] + wt * qc[i]) / dn; ss += num[i] * num[i]; }
    ss += __shfl_xor(ss, 1); ss += __shfl_xor(ss, 2); ss += __shfl_xor(ss, 4);
    const float rstd = rsqrtf(ss * (1.f / 128.f) + EPS);
    const size_t row = (size_t)b * SEQ + c * CHUNK + t; const int ch = h * 128 + e0;
    const bf16* om = (const bf16*)(a.ws + WS_RC + RC_OM) + row * 512 + ch; const float* hg = a.in[I_HGAIN] + ch;
    float o[16];
#pragma unroll
    for (int i = 0; i < 16; ++i) o[i] = sigmoidf_(bf2f(om[i])) * num[i] * rstd * hg[i];
    bf16* hm = (bf16*)(a.ws + WS_RA) + row * 1024 + ch;
#pragma unroll
    for (int i = 0; i < 16; i += 8) { v4u w; w.x = pk2(o[i], o[i + 1]); w.y = pk2(o[i + 2], o[i + 3]); w.z = pk2(o[i + 4], o[i + 5]); w.w = pk2(o[i + 6], o[i + 7]); *(v4u*)(hm + i) = w; }
    __syncthreads();
}

__device__ __forceinline__ void compress_l2(const Args& a, Frame& F) {
    LAS float* hid = (LAS float*)(F.lds + F.wave * 4096);
    const int gw = F.vcu * NWAVES + F.wave, NGW = F.G * NWAVES;
    for (int kv = 0; kv < 2; ++kv) {
        const float* P = (const float*)(a.ws + WS_RA) + (size_t)kv * 8192 * 512; const float* b1p = (const float*)(a.ws + WS_B1P) + kv * 16 * 256;
        const float* w2 = a.in[I_CW2] + (size_t)kv * 256 * 64; bf16* outp = (bf16*)(a.ws + WS_KCMP) + (size_t)kv * 8192 * 64;
        for (int r0 = gw; r0 < 8192; r0 += 4 * NGW) {
            float pv[4][8];
#pragma unroll
            for (int q = 0; q < 4; ++q) { const int m0 = r0 + q * NGW; const bool ok = m0 < 8192 && (m0 & 255) != NCMP;
#pragma unroll
                for (int jj = 0; jj < 4; ++jj) { const int cc = jj * 64 + F.lane; pv[q][2 * jj] = ok ? P[(size_t)m0 * 512 + cc] : 0.f; pv[q][2 * jj + 1] = ok ? P[(size_t)(m0 + 1) * 512 + 256 + cc] : 0.f; } }
            float bb[4];
#pragma unroll
            for (int jj = 0; jj < 4; ++jj) { float t = a.in[I_CB1][kv * 256 + jj * 64 + F.lane];
#pragma unroll
                for (int pt = 0; pt < 16; ++pt) t += b1p[pt * 256 + jj * 64 + F.lane];
                bb[jj] = t; }
#pragma unroll
            for (int q = 0; q < 4; ++q)
#pragma unroll
                for (int jj = 0; jj < 4; ++jj) hid[q * 256 + jj * 64 + F.lane] = siluf_(pv[q][2 * jj] + pv[q][2 * jj + 1] + bb[jj]);
            LDS_WAIT();
            float sacc[4]; const float b2 = a.in[I_CB2][kv * 64 + F.lane];
#pragma unroll
            for (int q = 0; q < 4; ++q) sacc[q] = b2;
#pragma unroll 1
            for (int c0 = 0; c0 < 256; c0 += 32) { float wv[32];
#pragma unroll
                for (int i = 0; i < 32; ++i) wv[i] = w2[(c0 + i) * 64 + F.lane];
#pragma unroll
                for (int i = 0; i < 32; ++i)
#pragma unroll
                    for (int q = 0; q < 4; ++q) sacc[q] += hid[q * 256 + c0 + i] * wv[i]; }
#pragma unroll
            for (int q = 0; q < 4; ++q) { const int m0 = r0 + q * NGW; if (m0 < 8192) outp[(size_t)m0 * 64 + F.lane] = ((m0 & 255) == NCMP) ? (bf16)0 : (bf16)f2bf(sacc[q]); }
            LDS_WAIT();
        }
    }
}

struct AttState { float m[4], l[4], o[4]; };
__device__ __forceinline__ void nsa_dot4(const bf16* krow, const LAS float* qs, float (&s)[4]) {
    s[0] = s[1] = s[2] = s[3] = 0.f;
#pragma unroll
    for (int c8 = 0; c8 < 8; ++c8) { const v4u kw = *(const v4u*)(krow + c8 * 8);
        float kf[8] = {bflo(kw.x), bfhi(kw.x), bflo(kw.y), bfhi(kw.y), bflo(kw.z), bfhi(kw.z), bflo(kw.w), bfhi(kw.w)};
#pragma unroll
        for (int h = 0; h < 4; ++h)
#pragma unroll
            for (int i = 0; i < 8; ++i) s[h] += kf[i] * qs[h * 64 + c8 * 8 + i]; }
}
__device__ __forceinline__ void nsa_attend(AttState& A, const bf16* Kb, const bf16* Vb, int base, int t, const LAS float* qs, LAS float* pl, int lane) {
    const int pos = base + lane; const bool valid = pos >= 0 && pos <= t;
    float s[4] = {0.f, 0.f, 0.f, 0.f};
    if (valid) nsa_dot4(Kb + (size_t)pos * 64, qs, s);
#pragma unroll
    for (int h = 0; h < 4; ++h) { const float mb = wave_max(valid ? s[h] : -1e30f), mn = fmaxf(A.m[h], mb), al = __expf(A.m[h] - mn), p = valid ? __expf(s[h] - mn) : 0.f;
        A.l[h] = A.l[h] * al + wave_sum(p); A.o[h] *= al; A.m[h] = mn; pl[h * 64 + lane] = p; }
    LDS_WAIT();
    const int k0 = base < 0 ? -base : 0, k1 = (t - base) < 63 ? (t - base) : 63;
    for (int kk = k0; kk <= k1; ++kk) { const float v = bf2f(Vb[(size_t)(base + kk) * 64 + lane]);
#pragma unroll
        for (int h = 0; h < 4; ++h) A.o[h] += pl[h * 64 + kk] * v; }
    LDS_WAIT();
}
__device__ __forceinline__ void nsa_query(const Args& a, Frame& F, int qid, LAS float* wl) {
    const int t = qid & 4095, g = (qid >> 12) & 1, b = qid >> 13, bg = b * 2 + g, lane = F.lane;
    const size_t row = (size_t)b * SEQ + t;
    unsigned char* rc = a.ws + WS_RC;
    LAS float* qs = wl; LAS float* pc = wl + 256; LAS float* ps = wl + 512; LAS float* pl = wl + 768;
    const bf16* qn = (const bf16*)(rc + RC_QN) + row * 512 + g * 256;
#pragma unroll
    for (int h = 0; h < 4; ++h) qs[h * 64 + lane] = bf2f(qn[h * 64 + lane]) * 0.6931471805599453f;
    const float* gg = (const float*)(rc + RC_GG) + row * 24 + g * 12;
    float gate[4][3];
#pragma unroll
    for (int h = 0; h < 4; ++h)
#pragma unroll
        for (int r = 0; r < 3; ++r) gate[h][r] = sigmoidf_(gg[h * 3 + r]);
    LDS_WAIT();
    const bf16* kc = (const bf16*)(a.ws + WS_KCMP) + (size_t)bg * 256 * 64; const bf16* vc = kc + (size_t)32 * 256 * 64;
    const int nvalid = t >= 31 ? ((t - 31) >> 4) + 1 : 0;
    float sc[4][4];
#pragma unroll
    for (int kk = 0; kk < 4; ++kk) { const int n = kk * 64 + lane; float s[4] = {0.f, 0.f, 0.f, 0.f}; if (n < nvalid) nsa_dot4(kc + (size_t)n * 64, qs, s);
#pragma unroll
        for (int h = 0; h < 4; ++h) sc[h][kk] = s[h]; }
    float psum[4] = {0.f, 0.f, 0.f, 0.f}, ocmp[4];
#pragma unroll
    for (int h = 0; h < 4; ++h) { float mx = -1e30f;
#pragma unroll
        for (int kk = 0; kk < 4; ++kk) if (kk * 64 + lane < nvalid) mx = fmaxf(mx, sc[h][kk]);
        mx = wave_max(mx); float e[4], l = 0.f;
#pragma unroll
        for (int kk = 0; kk < 4; ++kk) { e[kk] = (kk * 64 + lane < nvalid) ? __expf(sc[h][kk] - mx) : 0.f; l += e[kk]; }
        l = fmaxf(wave_sum(l), 1e-30f);
#pragma unroll
        for (int kk = 0; kk < 4; ++kk) { const float p = e[kk] / l; psum[kk] += p; pc[kk * 64 + lane] = p; }
        LDS_WAIT();
        float o = 0.f; for (int n = 0; n < nvalid; ++n) o += pc[n] * bf2f(vc[(size_t)n * 64 + lane]);
        ocmp[h] = o; LDS_WAIT(); }
#pragma unroll
    for (int kk = 0; kk < 4; ++kk) ps[kk * 64 + lane] = psum[kk];
    LDS_WAIT();
    const int cur = t >> 6;
    float imp = 0.f;
#pragma unroll
    for (int i = -1; i <= 3; ++i) { const int n = 4 * lane + i; if (n >= 0 && n < NCMP) imp += ps[n]; }
    const bool forced = (lane == 0) || (lane == cur) || (lane == cur - 1);
    const float val = (lane <= cur) ? (forced ? 1e4f : imp) : -1.f;
    int rank = 0;
    for (int i = 0; i < 64; ++i) { const float vi = __shfl(val, i); rank += (vi > val || (vi == val && i < lane)) ? 1 : 0; }
    const unsigned long long mask = __ballot(rank < 16);
    AttState S;
#pragma unroll
    for (int h = 0; h < 4; ++h) { S.m[h] = -1e30f; S.l[h] = 0.f; S.o[h] = 0.f; }
    const bf16* ks = (const bf16*)(rc + RC_KV + 2 * 16 * MiB) + (size_t)bg * 4096 * 64; const bf16* vs = (const bf16*)(rc + RC_KV + 3 * 16 * MiB) + (size_t)bg * 4096 * 64;
    for (int j = 0; j <= cur; ++j) if ((mask >> j) & 1ull) nsa_attend(S, ks, vs, 64 * j, t, qs, pl, lane);
    AttState W;
#pragma unroll
    for (int h = 0; h < 4; ++h) { W.m[h] = -1e30f; W.l[h] = 0.f; W.o[h] = 0.f; }
    const bf16* kw = (const bf16*)(rc + RC_KV + 4 * 16 * MiB) + (size_t)bg * 4096 * 64; const bf16* vw = (const bf16*)(rc + RC_KV + 5 * 16 * MiB) + (size_t)bg * 4096 * 64;
    for (int kk = 0; kk < 4; ++kk) { const int base = t - 255 + 64 * kk; if (base + 63 >= 0) nsa_attend(W, kw, vw, base, t, qs, pl, lane); }
    bf16* outp = (bf16*)(a.ws + WS_RA) + row * 1024 + 512 + g * 256;
#pragma unroll
    for (int h = 0; h < 4; ++h) { const float o = gate[h][0] * ocmp[h] + gate[h][1] * S.o[h] / fmaxf(S.l[h], 1e-30f) + gate[h][2] * W.o[h] / fmaxf(W.l[h], 1e-30f);
        outp[h * 64 + lane] = (bf16)f2bf(o); }
}

typedef float f32x16 __attribute__((ext_vector_type(16)));
typedef short s16x4 __attribute__((ext_vector_type(4)));
typedef float f32x2_t __attribute__((ext_vector_type(2))); typedef __bf16 bf16x2_t __attribute__((ext_vector_type(2)));
constexpr int NKS = 144, NVS = 192;
constexpr int NK_OFF = 0, NKBUF = 64 * NKS, NV_OFF = 4 * NKBUF, NVBUF = 64 * NVS, NPSW = 8 * 260, NPS_OFF = NV_OFF + 4 * NVBUF, NMASK_OFF = NPS_OFF + 8 * NPSW * 4, NWS_OFF = NMASK_OFF + 512, NSA_LDS_END = NWS_OFF + 8 * 256;
static_assert(NSA_LDS_END <= MISC_OFF, "nsa lds");
constexpr float L2E = 1.4426950408889634f;
__device__ __forceinline__ int crow(int r, int hi) { return (r & 3) + 8 * (r >> 2) + 4 * hi; }
__device__ __forceinline__ unsigned cvtpk(float lo, float hi) { f32x2_t v = {lo, hi}; bf16x2_t b = __builtin_convertvector(v, bf16x2_t); return __builtin_bit_cast(unsigned, b); }
__device__ __forceinline__ float max3f(float a, float b, float c) { float r; asm("v_max3_f32 %0, %1, %2, %3" : "=v"(r) : "v"(a), "v"(b), "v"(c)); return r; }
template <int CTRL> __device__ __forceinline__ float dpp_quad(float v) { return __builtin_bit_cast(float, __builtin_amdgcn_update_dpp(0, __builtin_bit_cast(int, v), CTRL, 0xF, 0xF, true)); }
__device__ __forceinline__ float swapmax(float v) { auto rr = __builtin_amdgcn_permlane32_swap(__float_as_uint(v), __float_as_uint(v), false, false); return fmaxf(__uint_as_float(rr[0]), __uint_as_float(rr[1])); }
__device__ __forceinline__ float swapsum(float v) { auto rr = __builtin_amdgcn_permlane32_swap(__float_as_uint(v), __float_as_uint(v), false, false); return __uint_as_float(rr[0]) + __uint_as_float(rr[1]); }
__device__ __forceinline__ s16x4 vtr(const LAS unsigned char* p) { typedef short v4i16_t __attribute__((ext_vector_type(4))); return __builtin_bit_cast(s16x4, __builtin_amdgcn_ds_read_tr16_b64_v4i16((LAS v4i16_t*)p)); }
__device__ __forceinline__ void nsa_qk(f32x16& p0, f32x16& p1, const LAS unsigned char* kb, const bf16x8 (&qr)[4], const f32x16& cinit, int r32, int hi) {
    const LAS unsigned char* kp = kb + r32 * NKS + hi * 16;
    bf16x8 kf[8];
#pragma unroll
    for (int d0 = 0; d0 < 4; ++d0) { kf[2 * d0] = *(const LAS bf16x8*)(kp + d0 * 32); kf[2 * d0 + 1] = *(const LAS bf16x8*)(kp + 32 * NKS + d0 * 32); }
    __builtin_amdgcn_sched_barrier(0);
    p0 = __builtin_amdgcn_mfma_f32_32x32x16_bf16(kf[0], qr[0], cinit, 0, 0, 0); p1 = __builtin_amdgcn_mfma_f32_32x32x16_bf16(kf[1], qr[0], cinit, 0, 0, 0);
#pragma unroll
    for (int d0 = 1; d0 < 4; ++d0) { p0 = __builtin_amdgcn_mfma_f32_32x32x16_bf16(kf[2 * d0], qr[d0], p0, 0, 0, 0); p1 = __builtin_amdgcn_mfma_f32_32x32x16_bf16(kf[2 * d0 + 1], qr[d0], p1, 0, 0, 0); }
}
__device__ __forceinline__ void nsa_vload(bf16x8 (&vf)[4], const LAS unsigned char* vb, int lane, int d0) {
    const int hi = lane >> 5, blk = (lane >> 4) & 1, q = (lane & 15) >> 2, p = lane & 3;
    const LAS unsigned char* base = vb + (4 * hi + q) * NVS + (16 * blk + 4 * p) * 2 + d0 * 64;
#pragma unroll
    for (int ks = 0; ks < 4; ++ks) { const s16x4 lo = vtr(base + (ks * 16) * NVS), hh = vtr(base + (ks * 16 + 8) * NVS);
        vf[ks] = (bf16x8){lo[0], lo[1], lo[2], lo[3], hh[0], hh[1], hh[2], hh[3]}; }
}
__device__ __forceinline__ void nsa_pv(f32x16& o, const bf16x8 (&vf)[4], const bf16x8 (&pa)[4]) {
#pragma unroll
    for (int ks = 0; ks < 4; ++ks) o = __builtin_amdgcn_mfma_f32_32x32x16_bf16(pa[ks], vf[ks], o, 0, 0, 0);
}
__device__ __forceinline__ void nsa_pack(bf16x8 (&pa)[4], const f32x16& p0, const f32x16& p1) {
    v4u w;
    w.x = cvtpk(p0[0], p0[1]); w.y = cvtpk(p0[2], p0[3]); w.z = cvtpk(p0[4], p0[5]); w.w = cvtpk(p0[6], p0[7]); pa[0] = __builtin_bit_cast(bf16x8, w);
    w.x = cvtpk(p0[8], p0[9]); w.y = cvtpk(p0[10], p0[11]); w.z = cvtpk(p0[12], p0[13]); w.w = cvtpk(p0[14], p0[15]); pa[1] = __builtin_bit_cast(bf16x8, w);
    w.x = cvtpk(p1[0], p1[1]); w.y = cvtpk(p1[2], p1[3]); w.z = cvtpk(p1[4], p1[5]); w.w = cvtpk(p1[6], p1[7]); pa[2] = __builtin_bit_cast(bf16x8, w);
    w.x = cvtpk(p1[8], p1[9]); w.y = cvtpk(p1[10], p1[11]); w.z = cvtpk(p1[12], p1[13]); w.w = cvtpk(p1[14], p1[15]); pa[3] = __builtin_bit_cast(bf16x8, w);
}
__device__ __forceinline__ void row_bcast(float v, LAS float* wsf, int r32, int hi, float (&f)[16]) {
    if (hi == 0) wsf[r32] = v;
#pragma unroll
    for (int r = 0; r < 16; ++r) f[r] = wsf[crow(r, hi)];
}
constexpr float NSA_THR = 5.f;
__device__ __forceinline__ void nsa_step(const int VAR, f32x16& p0, f32x16& p1, float& mhat, f32x16& negm, f32x16 (&o)[2], f32x16& ol, int diag, bool rowvalid, bool allvalid, int rel, const LAS unsigned char* vb, LAS float* wsf, int lane, int r32, int hi) {
    bf16x8 vf[4]; nsa_vload(vf, vb, lane, 0);
    __builtin_amdgcn_sched_barrier(0);
    asm volatile("s_nop 15\n\ts_nop 7" : "+v"(p0), "+v"(p1));
    if (diag == 1) {
#pragma unroll
        for (int r = 0; r < 16; ++r) { const int kv = crow(r, hi); p0[r] = kv <= rel ? p0[r] : -INFINITY; p1[r] = kv + 32 <= rel ? p1[r] : -INFINITY; }
    } else if (diag == 2) {
#pragma unroll
        for (int r = 0; r < 16; ++r) { const int kv = crow(r, hi); p0[r] = kv > rel ? p0[r] : -INFINITY; p1[r] = kv + 32 > rel ? p1[r] : -INFINITY; }
    }
    float mx = max3f(p0[0], p1[0], -INFINITY);
#pragma unroll
    for (int r = 1; r < 16; ++r) mx = max3f(mx, p0[r], p1[r]);
    mx = rowvalid ? mx : -INFINITY;
    mx = swapmax(mx);
    if (__any(mx > NSA_THR)) {
        const float dl = fmaxf(mx, 0.f); mhat += dl;
#pragma unroll
        for (int r = 0; r < 16; ++r) { p0[r] -= dl; p1[r] -= dl; negm[r] = -mhat; }
        float f[16]; row_bcast(__builtin_amdgcn_exp2f(-dl), wsf, r32, hi, f);
#pragma unroll
        for (int r = 0; r < 16; ++r) { o[0][r] *= f[r]; o[1][r] *= f[r]; ol[r] *= f[r]; } }
#pragma unroll
    for (int r = 0; r < 16; ++r) { if (VAR == 2) { p0[r] += 1.f; p1[r] += 1.f; } else { p0[r] = __builtin_amdgcn_exp2f(p0[r]); p1[r] = __builtin_amdgcn_exp2f(p1[r]); } }
    bf16x8 pa[4]; nsa_pack(pa, p0, p1);
    if (!allvalid) { const short km = rowvalid ? (short)-1 : (short)0;
#pragma unroll
        for (int k = 0; k < 4; ++k) { v4u w = __builtin_bit_cast(v4u, pa[k]); const unsigned mk = rowvalid ? 0xffffffffu : 0u; w.x &= mk; w.y &= mk; w.z &= mk; w.w &= mk; pa[k] = __builtin_bit_cast(bf16x8, w); }
        (void)km; }
    __builtin_amdgcn_sched_barrier(0);
    if (VAR != 3) { bf16x8 vg[4]; nsa_vload(vg, vb, lane, 1);
        __builtin_amdgcn_sched_barrier(0);
        nsa_pv(o[0], vf, pa);
        const bf16x8 ones = (bf16x8){0x3f80, 0x3f80, 0x3f80, 0x3f80, 0x3f80, 0x3f80, 0x3f80, 0x3f80};
#pragma unroll
        for (int ks = 0; ks < 4; ++ks) ol = __builtin_amdgcn_mfma_f32_32x32x16_bf16(pa[ks], ones, ol, 0, 0, 0);
        nsa_pv(o[1], vg, pa); }
}
__device__ __forceinline__ void nsa_unit(const int VAR, const Args& a, Frame& F, int bg, int qt, bf16* outbase) {
    const int lane = F.lane, r32 = lane & 31, hi = lane >> 5, w = F.wave, tid = F.tid;
    const int qi = r32 >> 2, h = r32 & 3, t0 = qt * 64, rel = 8 * w + qi, t = t0 + rel, cur = qt, b = bg >> 1, g = bg & 1;
    const size_t row = (size_t)b * SEQ + t;
    unsigned char* rc = a.ws + WS_RC;
    LAS float* PS = (LAS float*)(F.lds + NPS_OFF) + w * NPSW;
    LAS unsigned long long* MASKS = (LAS unsigned long long*)(F.lds + NMASK_OFF);
    LAS float* wsf = (LAS float*)(F.lds + NWS_OFF) + w * 64;
    const int srow = tid >> 3, sch = tid & 7;
    v4u kreg, vreg;
#define NSA_LOADK(ptr) kreg = *(const v4u*)((ptr) + srow * 64 + sch * 8)
#define NSA_LOADV(ptr) vreg = *(const v4u*)((ptr) + srow * 64 + sch * 8)
#define NSA_STOREK(bi) *(LAS v4u*)(F.lds + NK_OFF + (bi) * NKBUF + srow * NKS + sch * 16) = kreg
#define NSA_STOREV(bi) *(LAS v4u*)(F.lds + NV_OFF + (bi) * NVBUF + srow * NVS + sch * 16) = vreg
#define NSA_KB(bi) (F.lds + NK_OFF + (bi) * NKBUF)
#define NSA_VB(bi) (F.lds + NV_OFF + (bi) * NVBUF)
    bf16x8 qr[4];
    { const bf16* qp = (const bf16*)(rc + RC_QN) + row * 512 + (g * 4 + h) * 64 + hi * 8;
#pragma unroll
      for (int d0 = 0; d0 < 4; ++d0) qr[d0] = *(const bf16x8*)(qp + d0 * 16); }
    float g0, g1, g2;
    { const float* gg = (const float*)(rc + RC_GG) + row * 24 + (g * 4 + h) * 3; g0 = sigmoidf_(gg[0]); g1 = sigmoidf_(gg[1]); g2 = sigmoidf_(gg[2]); }
    f32x16 o[2], p0, p1, ol, negm, zero16;
#pragma unroll
    for (int i = 0; i < 16; ++i) zero16[i] = 0.f;
    float f16[16];
    const bf16* kc = (const bf16*)(a.ws + WS_KCMP) + (size_t)bg * 256 * 64; const bf16* vc = kc + (size_t)32 * 256 * 64;
    const int nvmax = (t0 / 16 + 3) < 255 ? (t0 / 16 + 3) : 255, nb = (VAR == 7) ? 0 : ((nvmax + 63) >> 6);
    const int nv = t >= 31 ? ((t - 31) >> 4) + 1 : 0;
    float m = -1e30f, l = 0.f;
    { v4u ck[4], cv[4];
#pragma unroll
      for (int cb = 0; cb < 4; ++cb) if (cb < nb) { ck[cb] = *(const v4u*)(kc + cb * 4096 + srow * 64 + sch * 8); cv[cb] = *(const v4u*)(vc + cb * 4096 + srow * 64 + sch * 8); }
#pragma unroll
      for (int cb = 0; cb < 4; ++cb) if (cb < nb) { *(LAS v4u*)(F.lds + NK_OFF + cb * NKBUF + srow * NKS + sch * 16) = ck[cb]; *(LAS v4u*)(F.lds + NV_OFF + cb * NVBUF + srow * NVS + sch * 16) = cv[cb]; } }
#pragma unroll
    for (int i = 0; i < 9; ++i) { const int idx = i * 256 + lane * 4; if (idx < NPSW) *(LAS f32x4*)(PS + idx) = (f32x4){0.f, 0.f, 0.f, 0.f}; }
    __syncthreads();
#pragma unroll 1
    for (int cb = 0; cb < nb; ++cb) {
        nsa_qk(p0, p1, NSA_KB(cb), qr, zero16, r32, hi);
        float mx = -1e30f;
#pragma unroll
        for (int r = 0; r < 16; ++r) { const int n0 = cb * 64 + crow(r, hi); p0[r] = n0 < nv ? p0[r] : -1e30f; p1[r] = n0 + 32 < nv ? p1[r] : -1e30f; mx = fmaxf(mx, fmaxf(p0[r], p1[r])); }
        mx = swapmax(mx);
        const float mnew = fmaxf(m, mx); l *= __builtin_amdgcn_exp2f(m - mnew); m = mnew; const float nm = mnew < -1e29f ? 0.f : -mnew;
        float s = 0.f;
#pragma unroll
        for (int r = 0; r < 16; ++r) s += __builtin_amdgcn_exp2f(p0[r] + nm) + __builtin_amdgcn_exp2f(p1[r] + nm);
        l += s;
    }
    l = swapsum(l);
    const float inv_l = 1.f / l, nmc = m < -1e29f ? 0.f : -m;
#pragma unroll
    for (int i = 0; i < 16; ++i) { o[0][i] = 0.f; o[1][i] = 0.f; }
#pragma unroll 1
    for (int cb = 0; cb < nb; ++cb) {
        nsa_qk(p0, p1, NSA_KB(cb), qr, zero16, r32, hi);
#pragma unroll
        for (int r = 0; r < 16; ++r) { const int n0 = cb * 64 + crow(r, hi);
            p0[r] = n0 < nv ? __builtin_amdgcn_exp2f(p0[r] + nmc) * inv_l : 0.f; p1[r] = n0 + 32 < nv ? __builtin_amdgcn_exp2f(p1[r] + nmc) * inv_l : 0.f;
            float v0 = p0[r], v1 = p1[r]; v0 += dpp_quad<0xB1>(v0); v1 += dpp_quad<0xB1>(v1); v0 += dpp_quad<0x4E>(v0); v1 += dpp_quad<0x4E>(v1);
            if (h == 0) { PS[qi * 260 + n0] = v0; PS[qi * 260 + n0 + 32] = v1; } }
        bf16x8 pa[4]; nsa_pack(pa, p0, p1);
        { bf16x8 vf[4], vg[4]; nsa_vload(vf, NSA_VB(cb), lane, 0); nsa_vload(vg, NSA_VB(cb), lane, 1); __builtin_amdgcn_sched_barrier(0); nsa_pv(o[0], vf, pa); nsa_pv(o[1], vg, pa); }
    }
    if (cur >= 16) {
#pragma unroll 1
        for (int qq = 0; qq < 8; ++qq) { const LAS float* pq = PS + qq * 260;
            const f32x4 q4 = *(const LAS f32x4*)(pq + 4 * lane);
            float imp = (q4[0] + q4[1]) + (q4[2] + q4[3]); if (lane > 0) imp += pq[4 * lane - 1];
            const bool forced = (lane == 0) || (lane == cur) || (lane == cur - 1);
            const float val = (lane <= cur) ? (forced ? 1e4f : imp) : -1.f;
            wsf[lane] = val;
            int rank = 0;
#pragma unroll
            for (int i4 = 0; i4 < 16; ++i4) { const f32x4 v4 = *(const LAS f32x4*)(wsf + 4 * i4);
#pragma unroll
                for (int e = 0; e < 4; ++e) { const int i = 4 * i4 + e; rank += (v4[e] > val || (v4[e] == val && i < lane)) ? 1 : 0; } }
            const unsigned long long mk = __ballot(rank < 16);
            if (lane == 0) MASKS[w * 8 + qq] = mk; }
    } else { if (lane < 8) MASKS[w * 8 + lane] = (2ull << cur) - 1ull; }
    __syncthreads();
    const unsigned long long mym = MASKS[w * 8 + qi];
    unsigned long long um = MASKS[lane];
#pragma unroll
    for (int off = 1; off < 64; off <<= 1) { const unsigned lo_ = __shfl_xor((unsigned)um, off), hi_ = __shfl_xor((unsigned)(um >> 32), off); um |= ((unsigned long long)hi_ << 32) | lo_; }
    um &= (2ull << cur) - 1ull;
    unsigned long long rem = ((unsigned long long)__builtin_amdgcn_readfirstlane((unsigned)(um >> 32)) << 32) | (unsigned)__builtin_amdgcn_readfirstlane((unsigned)um);
    row_bcast(g0, wsf, r32, hi, f16);
#pragma unroll
    for (int r = 0; r < 16; ++r) { PS[(2 * r) * 64 + lane] = o[0][r] * f16[r]; PS[(2 * r + 1) * 64 + lane] = o[1][r] * f16[r]; }
    const bf16* ks = (const bf16*)(rc + RC_KV + 2 * 16 * MiB) + (size_t)bg * 4096 * 64; const bf16* vs = (const bf16*)(rc + RC_KV + 3 * 16 * MiB) + (size_t)bg * 4096 * 64;
    const bf16* kw = (const bf16*)(rc + RC_KV + 4 * 16 * MiB) + (size_t)bg * 4096 * 64; const bf16* vw = (const bf16*)(rc + RC_KV + 5 * 16 * MiB) + (size_t)bg * 4096 * 64;
    float mhat = 0.f;
#pragma unroll
    for (int i = 0; i < 16; ++i) { o[0][i] = 0.f; o[1][i] = 0.f; ol[i] = 0.f; negm[i] = 0.f; }
    {
        const int j0w = cur >= 4 ? cur - 4 : 0;
        if (VAR == 6) rem = 0ull;
        int jc = __builtin_ctzll(rem | (1ull << 63)), wc = (VAR == 6) ? 1 : 0, buf = 0; rem &= rem - 1ull; if (VAR == 6) jc = cur;
        NSA_LOADK(ks + (size_t)jc * 4096); NSA_LOADV(vs + (size_t)jc * 4096); NSA_STOREK(0); NSA_STOREV(0); __syncthreads();
#pragma unroll 1
        for (;;) {
            bool has_next = true; int jn, wn;
            if (wc == 0) { if (rem != 0ull) { jn = __builtin_ctzll(rem); rem &= rem - 1ull; wn = 0; } else { jn = j0w; wn = 1; } }
            else { jn = jc + 1; wn = 1; has_next = jc < cur; }
            if (has_next && VAR != 1) { const bf16* kp = wn ? kw : ks; const bf16* vp = wn ? vw : vs; NSA_LOADK(kp + (size_t)jn * 4096); NSA_LOADV(vp + (size_t)jn * 4096); }
            const bool rv = wc ? true : (((mym >> jc) & 1ull) != 0ull);
            const int diag = (jc == cur) ? 1 : ((wc && jc == cur - 4) ? 2 : 0);
            if (__any(rv)) {
                nsa_qk(p0, p1, NSA_KB(buf), qr, negm, r32, hi);
                nsa_step(VAR, p0, p1, mhat, negm, o, ol, diag, rv, __all(rv), rel, NSA_VB(buf), wsf, lane, r32, hi); }
            if (has_next && VAR != 1) { NSA_STOREK(buf ^ 1); NSA_STOREV(buf ^ 1); }
            if (VAR != 4) __syncthreads();
            if (has_next && wn != wc) {
                row_bcast(g1, wsf, r32, hi, f16);
#pragma unroll
                for (int r = 0; r < 16; ++r) { const float fc = f16[r] * __builtin_amdgcn_rcpf(ol[r]); PS[(2 * r) * 64 + lane] += o[0][r] * fc; PS[(2 * r + 1) * 64 + lane] += o[1][r] * fc; o[0][r] = 0.f; o[1][r] = 0.f; ol[r] = 0.f; negm[r] = 0.f; }
                mhat = 0.f;
            }
            if (!has_next) break;
            jc = jn; wc = wn; buf ^= 1;
        }
    }
    row_bcast(g2, wsf, r32, hi, f16);
#pragma unroll
    for (int r = 0; r < 16; ++r) f16[r] *= __builtin_amdgcn_rcpf(ol[r]);
    bf16* outb = outbase + ((size_t)b * SEQ + t0 + 8 * w) * 1024 + 512 + g * 256 + r32;
    if (VAR == 0 || mhat == 12345.678f)
#pragma unroll
    for (int r = 0; r < 16; ++r) { const int rr = crow(r, hi), qo = rr >> 2, ho = rr & 3;
        outb[(size_t)qo * 1024 + ho * 64] = (bf16)f2bf(PS[(2 * r) * 64 + lane] + o[0][r] * f16[r]); outb[(size_t)qo * 1024 + ho * 64 + 32] = (bf16)f2bf(PS[(2 * r + 1) * 64 + lane] + o[1][r] * f16[r]); }
#undef NSA_LOADK
#undef NSA_LOADV
#undef NSA_STOREK
#undef NSA_STOREV
#undef NSA_KB
#undef NSA_VB
}

constexpr int ML_QS = 272, ML_VS = 320;
constexpr int ML_Q_OFF = 0, ML_K_OFF = 64 * ML_QS, ML_V_OFF = 2 * 64 * ML_QS, ML_CT_OFF = ML_V_OFF + 64 * ML_VS, ML_HS_OFF = ML_CT_OFF + 128 * ML_QS, ML_VEC_OFF = ML_HS_OFF + 128 * 65 * 4, ML_END = ML_VEC_OFF + 4096;
static_assert(ML_END <= MISC_OFF && 2 * 67 * 256 <= 128 * ML_QS, "mlstm mfma lds");
__device__ __forceinline__ void conv8(const LAS bf16* raw, int s, int c8, const float* cw, const float* cb, float (&out)[8]) {
    const f32x4 b0 = *(const f32x4*)(cb + c8 * 8), b1 = *(const f32x4*)(cb + c8 * 8 + 4);
    float acc[8] = {b0[0], b0[1], b0[2], b0[3], b1[0], b1[1], b1[2], b1[3]};
#pragma unroll
    for (int j = 0; j < 4; ++j) { float x[8]; unpack8(*(const LAS v4u*)(raw + (s + j) * 128 + c8 * 8), x);
        const f32x4 w0 = *(const f32x4*)(cw + j * 1024 + c8 * 8), w1 = *(const f32x4*)(cw + j * 1024 + c8 * 8 + 4);
        acc[0] += w0[0] * x[0]; acc[1] += w0[1] * x[1]; acc[2] += w0[2] * x[2]; acc[3] += w0[3] * x[3]; acc[4] += w1[0] * x[4]; acc[5] += w1[1] * x[5]; acc[6] += w1[2] * x[6]; acc[7] += w1[3] * x[7]; }
#pragma unroll
    for (int i = 0; i < 8; ++i) out[i] = siluf_(acc[i]);
}
__device__ __forceinline__ void mlstm_gates(const Args& a, Frame& F, int h, size_t row0, LAS float* bcum, LAS float* ig) {
    if (F.wave == 0) { const float* g = (const float*)(a.ws + WS_RC + RC_IF) + (row0 + F.lane) * 8; const float fp = g[4 + h] + a.in[I_GATEB][4 + h];
        ig[F.lane] = g[h] + a.in[I_GATEB][h];
        float v = fminf(fp, 0.f) - log1pf(__expf(-fabsf(fp)));
#pragma unroll
        for (int off = 1; off < 64; off <<= 1) { const float u = __shfl_up(v, off); if (F.lane >= off) v += u; }
        bcum[F.lane] = v; }
}
__device__ __forceinline__ void mlstm_stage_raw(Frame& F, const bf16* src, int b, int h, int t0, LAS bf16* raw) {
    for (int idx = F.tid; idx < 67 * 16; idx += NTHREADS) { const int rr = idx >> 4, c8 = idx & 15, tt = t0 - 3 + rr;
        v4u v = (v4u){0u, 0u, 0u, 0u}; if (tt >= 0) v = *(const v4u*)(src + ((size_t)b * SEQ + tt) * 512 + h * 128 + c8 * 8);
        *(LAS v4u*)(raw + rr * 128 + c8 * 8) = v; }
}
__device__ __forceinline__ void conv8r(const v4u (&tap)[4], int c8, const float* cw, const float* cb, float (&out)[8]) {
    const f32x4 b0 = *(const f32x4*)(cb + c8 * 8), b1 = *(const f32x4*)(cb + c8 * 8 + 4);
    float acc[8] = {b0[0], b0[1], b0[2], b0[3], b1[0], b1[1], b1[2], b1[3]};
#pragma unroll
    for (int j = 0; j < 4; ++j) { float x[8]; unpack8(tap[j], x);
        const f32x4 w0 = *(const f32x4*)(cw + j * 1024 + c8 * 8), w1 = *(const f32x4*)(cw + j * 1024 + c8 * 8 + 4);
        acc[0] += w0[0] * x[0]; acc[1] += w0[1] * x[1]; acc[2] += w0[2] * x[2]; acc[3] += w0[3] * x[3]; acc[4] += w1[0] * x[4]; acc[5] += w1[1] * x[5]; acc[6] += w1[2] * x[6]; acc[7] += w1[3] * x[7]; }
#pragma unroll
    for (int i = 0; i < 8; ++i) out[i] = siluf_(acc[i]);
}
__device__ __forceinline__ void load_taps(v4u (&tap)[4], const bf16* src, int b, int h, int t0, int s, int c8) {
#pragma unroll
    for (int j = 0; j < 4; ++j) { const int tt = t0 + s - 3 + j; tap[j] = (v4u){0u, 0u, 0u, 0u}; if (tt >= 0) tap[j] = *(const v4u*)(src + ((size_t)b * SEQ + tt) * 512 + h * 128 + c8 * 8); }
}
__device__ __forceinline__ void mlstm_gates_lane(const Args& a, int h, size_t row0, int lane, float& igv, float& bc) {
    const float* g = (const float*)(a.ws + WS_RC + RC_IF) + (row0 + lane) * 8; const float fp = g[4 + h] + a.in[I_GATEB][4 + h];
    igv = g[h] + a.in[I_GATEB][h];
    float v = fminf(fp, 0.f) - log1pf(__expf(-fabsf(fp)));
#pragma unroll
    for (int off = 1; off < 64; off <<= 1) { const float u = __shfl_up(v, off); if (lane >= off) v += u; }
    bc = v;
}
__device__ __forceinline__ void mlstm_local_mfma(const Args& a, Frame& F, int unit) {
    const int c = unit & 63, h = (unit >> 6) & 3, b = unit >> 8, t0 = c * CHUNK, lane = F.lane, w = F.wave, hi = lane >> 5, r32 = lane & 31;
    const size_t row0 = (size_t)b * SEQ + t0;
    unsigned char* rc = a.ws + WS_RC;
    LAS unsigned char* LK = F.lds; LAS unsigned char* LV = F.lds + 64 * ML_VS;
    v4u tk[2][4], vv[2];
#pragma unroll
    for (int u = 0; u < 2; ++u) { const int it = F.tid + u * NTHREADS, s = it >> 4, c8 = it & 15;
        load_taps(tk[u], (const bf16*)(rc + RC_KM), b, h, t0, s, c8);
        vv[u] = *(const v4u*)((const bf16*)(rc + RC_VM) + (row0 + s) * 512 + h * 128 + c8 * 8); }
    float igv, bc; mlstm_gates_lane(a, h, row0, lane, igv, bc);
    const float blast = __shfl(bc, 63), gv = blast - bc + igv, mloc = wave_max(gv), wvv = __expf(gv - mloc);
    if (F.tid == 0) { float* cs = (float*)(a.ws + WS_CSC) + (size_t)unit * 2; cs[0] = blast; cs[1] = mloc; }
    __syncthreads();
    { const float* cw = a.in[I_CONVW] + 512 + h * 128; const float* cb = a.in[I_CONVB] + 512 + h * 128;
#pragma unroll
      for (int u = 0; u < 2; ++u) { const int it = F.tid + u * NTHREADS, s = it >> 4, c8 = it & 15; float k8[8]; conv8r(tk[u], c8, cw, cb, k8);
          const float sc = 0.08838834764831845f * __shfl(wvv, s & 63);
          v4u o; o.x = pk2(k8[0] * sc, k8[1] * sc); o.y = pk2(k8[2] * sc, k8[3] * sc); o.z = pk2(k8[4] * sc, k8[5] * sc); o.w = pk2(k8[6] * sc, k8[7] * sc);
          *(LAS v4u*)(LK + s * ML_VS + c8 * 16) = o; *(LAS v4u*)(LV + s * ML_VS + c8 * 16) = vv[u]; } }
    __syncthreads();
    if (F.tid < 128) { float sacc = 0.f; for (int s = 0; s < 64; ++s) sacc += bf2f(*(const LAS bf16*)(LK + s * ML_VS + F.tid * 2)); ((float*)(a.ws + WS_NST))[(size_t)unit * 128 + F.tid] = sacc; }
    const int et = w >> 1, dt0 = (w & 1) * 2, blk = (lane >> 4) & 1, q = (lane & 15) >> 2, p = lane & 3;
    f32x16 acc[2];
#pragma unroll
    for (int i = 0; i < 16; ++i) { acc[0][i] = 0.f; acc[1][i] = 0.f; }
    const LAS unsigned char* abase = LV + (8 * hi + q) * ML_VS + (et * 32 + 16 * blk + 4 * p) * 2;
    const LAS unsigned char* bbase = LK + (8 * hi + q) * ML_VS + (dt0 * 32 + 16 * blk + 4 * p) * 2;
#pragma unroll
    for (int ks = 0; ks < 4; ++ks) { const s16x4 a0 = vtr(abase + ks * 16 * ML_VS), a1 = vtr(abase + (ks * 16 + 4) * ML_VS);
        const bf16x8 af = (bf16x8){a0[0], a0[1], a0[2], a0[3], a1[0], a1[1], a1[2], a1[3]};
#pragma unroll
        for (int n = 0; n < 2; ++n) { const s16x4 b0 = vtr(bbase + ks * 16 * ML_VS + n * 64), b1 = vtr(bbase + (ks * 16 + 4) * ML_VS + n * 64);
            const bf16x8 bfr = (bf16x8){b0[0], b0[1], b0[2], b0[3], b1[0], b1[1], b1[2], b1[3]};
            acc[n] = __builtin_amdgcn_mfma_f32_32x32x16_bf16(af, bfr, acc[n], 0, 0, 0); } }
    bf16* st = (bf16*)(a.ws + WS_RB) + (size_t)unit * 16384;
#pragma unroll
    for (int n = 0; n < 2; ++n)
#pragma unroll
        for (int r = 0; r < 16; ++r) st[(et * 32 + crow(r, hi)) * 128 + (dt0 + n) * 32 + r32] = (bf16)f2bf(acc[n][r]);
}
__device__ __forceinline__ void mlstm_out_mfma(const Args& a, Frame& F, int unit) {
    const int c = unit & 63, h = (unit >> 6) & 3, b = unit >> 8, t0 = c * CHUNK, lane = F.lane, w = F.wave, hi = lane >> 5, r32 = lane & 31;
    const size_t row0 = (size_t)b * SEQ + t0;
    unsigned char* rc = a.ws + WS_RC;
    LAS unsigned char* QB = F.lds + ML_Q_OFF; LAS unsigned char* KB = F.lds + ML_K_OFF; LAS unsigned char* VB = F.lds + ML_V_OFF;
    LAS float* HS = (LAS float*)(F.lds + ML_HS_OFF);
    LAS float* bcum = (LAS float*)(F.lds + ML_VEC_OFF); LAS float* ig = bcum + 64; LAS float* nv = bcum + 192; LAS float* ssq = bcum + 320;
    v4u tq[2][4], tk[2][4], vv[2];
#pragma unroll
    for (int u = 0; u < 2; ++u) { const int it = F.tid + u * NTHREADS, s = it >> 4, c8 = it & 15;
        load_taps(tq[u], (const bf16*)(rc + RC_QM), b, h, t0, s, c8); load_taps(tk[u], (const bf16*)(rc + RC_KM), b, h, t0, s, c8);
        vv[u] = *(const v4u*)((const bf16*)(rc + RC_VM) + (row0 + s) * 512 + h * 128 + c8 * 8); }
    const bf16* ctg = (const bf16*)(a.ws + WS_RB) + (size_t)unit * 16384;
    const int te = F.tid >> 3, e0 = (F.tid & 7) * 16;
    float nvr = 0.f; if (F.tid < 128) nvr = ((const float*)(a.ws + WS_NST))[(size_t)unit * 128 + F.tid];
    const float mp = ((const float*)(a.ws + WS_MPREV))[unit];
    float igv = 0.f, bc = 0.f; if (w == 0) mlstm_gates_lane(a, h, row0, lane, igv, bc);
    __syncthreads();
    if (w == 0) { ig[lane] = igv - bc; bcum[lane] = bc; }
    if (F.tid < 128) nv[F.tid] = nvr;
    { const float* cwq = a.in[I_CONVW] + h * 128; const float* cbq = a.in[I_CONVB] + h * 128;
#pragma unroll
      for (int u = 0; u < 2; ++u) { const int it = F.tid + u * NTHREADS, s = it >> 4, c8 = it & 15; float x8[8];
          conv8r(tq[u], c8, cwq, cbq, x8);
          v4u o; o.x = pk2(x8[0], x8[1]); o.y = pk2(x8[2], x8[3]); o.z = pk2(x8[4], x8[5]); o.w = pk2(x8[6], x8[7]);
          *(LAS v4u*)(QB + s * ML_QS + c8 * 16) = o;
          conv8r(tk[u], c8, cwq + 512, cbq + 512, x8); const float sc = 0.08838834764831845f;
          o.x = pk2(x8[0] * sc, x8[1] * sc); o.y = pk2(x8[2] * sc, x8[3] * sc); o.z = pk2(x8[4] * sc, x8[5] * sc); o.w = pk2(x8[6] * sc, x8[7] * sc);
          *(LAS v4u*)(KB + s * ML_QS + c8 * 16) = o;
          *(LAS v4u*)(VB + s * ML_VS + c8 * 16) = vv[u]; } }
    __syncthreads();
    const int et = w & 3, tt = w >> 2, t = tt * 32 + r32, blk = (lane >> 4) & 1, q = (lane & 15) >> 2, p = lane & 3;
    bf16x8 cf[8];
#pragma unroll
    for (int d0 = 0; d0 < 8; ++d0) cf[d0] = *(const bf16x8*)(ctg + (et * 32 + r32) * 128 + d0 * 16 + hi * 8);
    v4u omr[2]; { const bf16* om = (const bf16*)(rc + RC_OM) + (row0 + te) * 512 + h * 128 + e0; omr[0] = *(const v4u*)om; omr[1] = *(const v4u*)(om + 8); }
    bf16x8 qf[8];
#pragma unroll
    for (int d0 = 0; d0 < 8; ++d0) qf[d0] = *(const LAS bf16x8*)(QB + t * ML_QS + d0 * 32 + hi * 16);
    float qn = 0.f;
#pragma unroll
    for (int d0 = 0; d0 < 8; ++d0) { float x[8]; unpack8(__builtin_bit_cast(v4u, qf[d0]), x); const f32x4 n0 = *(const LAS f32x4*)(nv + d0 * 16 + hi * 8), n1 = *(const LAS f32x4*)(nv + d0 * 16 + hi * 8 + 4);
        qn += x[0] * n0[0] + x[1] * n0[1] + x[2] * n0[2] + x[3] * n0[3] + x[4] * n1[0] + x[5] * n1[1] + x[6] * n1[2] + x[7] * n1[3]; }
    qn = swapsum(qn);
    f32x16 p0, p1;
#pragma unroll
    for (int i = 0; i < 16; ++i) { p0[i] = 0.f; p1[i] = 0.f; }
#pragma unroll
    for (int hf = 0; hf < 2; ++hf) { bf16x8 kf[8];
#pragma unroll
        for (int dd = 0; dd < 4; ++dd) { const int d0 = hf * 4 + dd; kf[2 * dd] = *(const LAS bf16x8*)(KB + r32 * ML_QS + d0 * 32 + hi * 16); kf[2 * dd + 1] = *(const LAS bf16x8*)(KB + (32 + r32) * ML_QS + d0 * 32 + hi * 16); }
        __builtin_amdgcn_sched_barrier(0);
#pragma unroll
        for (int dd = 0; dd < 4; ++dd) { const int d0 = hf * 4 + dd; p0 = __builtin_amdgcn_mfma_f32_32x32x16_bf16(kf[2 * dd], qf[d0], p0, 0, 0, 0); p1 = __builtin_amdgcn_mfma_f32_32x32x16_bf16(kf[2 * dd + 1], qf[d0], p1, 0, 0, 0); } }
    const float bt = bcum[t], at = bt + mp;
    float mt = at;
#pragma unroll
    for (int r = 0; r < 16; ++r) { const int s0 = crow(r, hi), s1 = s0 + 32; const float a0 = ig[s0], a1 = ig[s1];
        if (s0 <= t) mt = fmaxf(mt, bt + a0); if (s1 <= t) mt = fmaxf(mt, bt + a1); }
    mt = swapmax(mt);
    float sden = 0.f;
#pragma unroll
    for (int r = 0; r < 16; ++r) { const int s0 = crow(r, hi), s1 = s0 + 32; const float a0 = ig[s0], a1 = ig[s1];
        p0[r] = s0 <= t ? p0[r] * __expf(bt + a0 - mt) : 0.f; p1[r] = s1 <= t ? p1[r] * __expf(bt + a1 - mt) : 0.f; sden += p0[r] + p1[r]; }
    sden = swapsum(sden);
    const float wi = __expf(at - mt), den = sden + wi * qn, dn = fmaxf(fabsf(den), __expf(-mt));
    bf16x8 pa[4]; nsa_pack(pa, p0, p1);
    f32x16 acc, acc2;
#pragma unroll
    for (int i = 0; i < 16; ++i) { acc[i] = 0.f; acc2[i] = 0.f; }
    { const LAS unsigned char* vbase = VB + (4 * hi + q) * ML_VS + (et * 32 + 16 * blk + 4 * p) * 2;
#pragma unroll
      for (int ks = 0; ks < 4; ++ks) { const s16x4 a0 = vtr(vbase + ks * 16 * ML_VS), a1 = vtr(vbase + (ks * 16 + 8) * ML_VS);
          const bf16x8 af = (bf16x8){a0[0], a0[1], a0[2], a0[3], a1[0], a1[1], a1[2], a1[3]};
          acc = __builtin_amdgcn_mfma_f32_32x32x16_bf16(af, pa[ks], acc, 0, 0, 0); } }
#pragma unroll
    for (int d0 = 0; d0 < 8; ++d0) acc2 = __builtin_amdgcn_mfma_f32_32x32x16_bf16(cf[d0], qf[d0], acc2, 0, 0, 0);
    float ss = 0.f; const float rdn = 1.f / dn;
#pragma unroll
    for (int r = 0; r < 16; ++r) { const float hv = (acc[r] + wi * acc2[r]) * rdn; ss += hv * hv; HS[(et * 32 + crow(r, hi)) * 65 + t] = hv; }
    ss = swapsum(ss);
    if (hi == 0) ssq[et * 64 + t] = ss;
    __syncthreads();
    { const float rstd = rsqrtf((ssq[te] + ssq[64 + te] + ssq[128 + te] + ssq[192 + te]) * (1.f / 128.f) + EPS);
      const size_t row = row0 + te; const int ch = h * 128 + e0;
      const float* hg = a.in[I_HGAIN] + ch;
      float o[16], og[16]; unpack8(omr[0], *(float(*)[8])&og[0]); unpack8(omr[1], *(float(*)[8])&og[8]);
#pragma unroll
      for (int i = 0; i < 16; ++i) o[i] = sigmoidf_(og[i]) * HS[(e0 + i) * 65 + te] * rstd * hg[i];
      bf16* hm = (bf16*)(a.ws + WS_RA) + row * 1024 + ch;
#pragma unroll
      for (int i = 0; i < 16; i += 8) { v4u wv4; wv4.x = pk2(o[i], o[i + 1]); wv4.y = pk2(o[i + 2], o[i + 3]); wv4.z = pk2(o[i + 4], o[i + 5]); wv4.w = pk2(o[i + 6], o[i + 7]); *(v4u*)(hm + i) = wv4; } }
}

__global__ void __launch_bounds__(NTHREADS, 2) mk_fwd(Args args) {
    extern __shared__ __attribute__((aligned(16))) unsigned char lds[];
    Frame F;
    F.lds = (LAS unsigned char*)lds;
    F.tid = threadIdx.x; F.lane = F.tid & 63; F.wave = __builtin_amdgcn_readfirstlane(F.tid >> 6);
    F.G = gridDim.x; { const int bx = blockIdx.x; F.vcu = (F.G % 8 == 0) ? (bx % 8) * (F.G / 8) + bx / 8 : bx; }
    volatile LAS unsigned* MISC = (volatile LAS unsigned*)(F.lds + MISC_OFF);
    if (F.tid < 64) MISC[F.tid] = 0u;
    __syncthreads();
    unsigned char* ws = args.ws;
    gu32* ctl = (gu32*)(ws + WS_CTL);
    XcdBarrier bar; bar.bar = (unsigned*)ctl + CW_BAR; bar.x = 0; bar.st = nullptr;
    if (MK_N_LAUNCHES == 1) bar = xcd_barrier_post((unsigned*)ctl + CW_BAR, MISC + 8);
    const int lo = args.ph_lo, hi = args.ph_hi;
#define IN(k) (lo <= (k) && (k) < hi)
#define SEAM(k) do { if (IN(k) && IN((k) + 1)) xcd_barrier(bar); } while (0)
    bf16* U = (bf16*)(ws + WS_RA); bf16* Fb = (bf16*)(ws + WS_RB); bf16* HID = (bf16*)(ws + WS_RC);
    PG8_LAS unsigned char* ring = (PG8_LAS unsigned char*)lds;

    if (IN(0)) { p0_prologue(args, F); } SEAM(0);
    if (IN(1)) { thin_phase<0>(args, F, args.in[I_X], nullptr, nullptr, U, 0, 0, 0.f); } SEAM(1);
    if (IN(2)) { pg8::Gemm g{U, (const bf16*)(ws + WS_W1T), T, NPROJ, DM, DM, DM, 0}; pg8::StaticOrder S; S.init(T, NPROJ, F.G, (int)blockIdx.x);
        pg8::EpiSwiGLU E{(unsigned char*)HID}; pg8::gemm_phase<pg8::EpiSwiGLU, pg8::StaticOrder, true, true>(ring, g, S, E); } SEAM(2);
    if (IN(3)) { pg8::Gemm g{HID, (const bf16*)(ws + WS_W1D), T, DM, DFF / 2, DFF / 2, DFF / 2, 0}; pg8::StaticOrder S; S.init(T, DM, F.G, (int)blockIdx.x);
        pg8::EpiStore E{Fb, DM}; pg8::gemm_phase<pg8::EpiStore, pg8::StaticOrder, true, true, true, 0x75757575, 0x7c7c7c7c>(ring, g, S, E); } SEAM(3);
    if (IN(4)) { thin_phase<1, false, true>(args, F, args.in[I_X], Fb, args.out, U, 0, 1, 0.5f); } SEAM(4);
    if (IN(5)) { pg8::Gemm g{U, (const bf16*)(ws + WS_WIN), T, NPROJ, DM, DM, DM, 0}; pg8::StaticOrder S; S.init(T, NPROJ, F.G, (int)blockIdx.x);
        pg8::EpiProj E{ws + WS_RC}; pg8::gemm_phase<pg8::EpiProj, pg8::StaticOrder, true, true>(ring, g, S, E); } SEAM(5);
    if (IN(6)) {
        const int bx = (int)blockIdx.x;
        if (bx < 128) { const int kv = bx >> 6; pg8::Gemm g{(const bf16*)(ws + WS_RC + RC_KV + (size_t)kv * 16 * MiB), (const bf16*)(ws + WS_WC1) + (size_t)kv * 512 * 1024, 8192, 512, 1024, 1024, 1024, 0};
            pg8::StaticOrder S; S.init(8192, 512, 64, bx & 63);
            pg8::EpiStoreF32 E{(float*)(ws + WS_RA) + (size_t)kv * 8192 * 512, 512}; pg8::gemm_phase<pg8::EpiStoreF32, pg8::StaticOrder, false, true>(ring, g, S, E); }
        __syncthreads();
#ifdef MLSTM_REF
        for (;;) { if (F.tid == 0) MISC[16] = atomicAdd((unsigned*)ctl + CW_QUEUE, 1u); __syncthreads(); const unsigned unit = MISC[16]; __syncthreads(); if (unit >= 4096u) break; mlstm_local_unit(args, F, (int)unit); }
#else
        { unsigned ticket = 0u; if (F.tid == 0) ticket = atomicAdd((unsigned*)ctl + CW_QUEUE, 1u);
          for (;;) { unsigned nxt = 0u;
              if (F.tid == 0) { MISC[16] = ticket; nxt = atomicAdd((unsigned*)ctl + CW_QUEUE, 1u); }
              __syncthreads(); const unsigned unit = MISC[16]; __syncthreads(); if (unit >= 4096u) break;
              mlstm_local_mfma(args, F, (int)unit); ticket = nxt; } }
#endif
    } SEAM(6);
    if (IN(7)) {
#ifdef PROBE_P7_PART
        if (!(hi - lo == 1 && PROBE_P7_PART == 2)) mlstm_scan(args, F);
        if (!(hi - lo == 1 && PROBE_P7_PART == 1)) compress_l2(args, F);
#else
        mlstm_scan(args, F); compress_l2(args, F);
#endif
    } SEAM(7);
    if (IN(8)) {
#ifdef MLSTM_REF
        for (int unit = F.vcu; unit < 4096; unit += F.G) mlstm_out_unit(args, F, unit);
#else
#ifdef PROBE_P8_PART
        if (!(hi - lo == 1 && PROBE_P8_PART == 2))
#endif
        for (int unit = F.vcu; unit < 4096; unit += F.G) mlstm_out_mfma(args, F, unit);
#endif
        __syncthreads();
#ifdef NSA_DEBUG
        xcd_barrier(bar);
        for (int pidx = F.vcu; pidx < 1024; pidx += F.G) { const int bg = pidx >> 5, i = pidx & 31; nsa_unit(0, args, F, bg, 63 - i, (bf16*)(ws + WS_RC + RC_QM)); nsa_unit(0, args, F, bg, i, (bf16*)(ws + WS_RC + RC_QM)); }
        __syncthreads();
        { LAS float* wl = (LAS float*)(F.lds + F.wave * 4096); const int gw = F.vcu * NWAVES + F.wave, NGW = F.G * NWAVES;
          for (int q = gw; q < NB * NG * SEQ; q += NGW) nsa_query(args, F, q, wl); }
        xcd_barrier(bar);
        { const bf16* A = (const bf16*)(ws + WS_RA + 64 * MiB); const bf16* B = (const bf16*)(ws + WS_RC + RC_QM); float sd = 0.f, sa = 0.f;
          for (size_t i = (size_t)F.vcu * NTHREADS + F.tid; i < (size_t)T * 512; i += (size_t)F.G * NTHREADS) { const float x = bf2f(A[i]), y = bf2f(B[i]); sd += (x - y) * (x - y); sa += x * x; }
          sd = wave_sum(sd); sa = wave_sum(sa);
          if (F.lane == 0) { atomicAdd((float*)ctl + 80, sd); atomicAdd((float*)ctl + 81, sa); } }
#else
#ifdef PROBE_P8_PART
        if (!(hi - lo == 1 && PROBE_P8_PART == 1))
#endif
#ifdef PROBE_NSA_VAR
        { const int var = (hi - lo == 1) ? PROBE_NSA_VAR : 0;
        for (int pidx = F.vcu; pidx < 1024; pidx += F.G) { const int bg = pidx >> 5, i = pidx & 31; nsa_unit(var, args, F, bg, 63 - i, (bf16*)(ws + WS_RA)); nsa_unit(var, args, F, bg, i, (bf16*)(ws + WS_RA)); } }
#else
        for (int pidx = F.vcu; pidx < 1024; pidx += F.G) { const int bg = pidx >> 5, i = pidx & 31; nsa_unit(0, args, F, bg, 63 - i, (bf16*)(ws + WS_RA)); nsa_unit(0, args, F, bg, i, (bf16*)(ws + WS_RA)); }
#endif
#endif
    } SEAM(8);
    if (IN(9)) { pg8::Gemm g{(const bf16*)(ws + WS_RA), (const bf16*)(ws + WS_WUPM), T, DM, 512, 1024, 1024, 1024}; pg8::SegOrder S; S.init(T, DM, F.G, (int)blockIdx.x);
        pg8::EpiMergeFused E{(bf16*)(ws + WS_RC + RC_MERGED), (const bf16*)(ws + WS_RC + RC_GM), (const bf16*)(ws + WS_RC + RC_GN)};
        pg8::gemm_phase<pg8::EpiMergeFused, pg8::SegOrder, true, true>(ring, g, S, E); } SEAM(9);
    if (IN(10)) { pg8::Gemm g{(const bf16*)(ws + WS_RC + RC_MERGED), (const bf16*)(ws + WS_WOUT), T, DM, DM, DM, DM, 0}; pg8::StaticOrder S; S.init(T, DM, F.G, (int)blockIdx.x);
        pg8::EpiStore E{Fb, DM}; pg8::gemm_phase<pg8::EpiStore, pg8::StaticOrder, true, true>(ring, g, S, E); } SEAM(10);
    if (IN(11)) { thin_phase<1, true, true>(args, F, args.out, Fb, ws + WS_RC + 512 * MiB, U, 1, 2, 1.0f); } SEAM(11);
    if (IN(12)) { pg8::Gemm g{U, (const bf16*)(ws + WS_W1T) + (size_t)NPROJ * DM, T, NPROJ, DM, DM, DM, 0}; pg8::StaticOrder S; S.init(T, NPROJ, F.G, (int)blockIdx.x);
        pg8::EpiSwiGLU E{(unsigned char*)HID}; pg8::gemm_phase<pg8::EpiSwiGLU, pg8::StaticOrder, true, true>(ring, g, S, E); } SEAM(12);
    if (IN(13)) { pg8::Gemm g{HID, (const bf16*)(ws + WS_W1D + (size_t)DM * DFF), T, DM, DFF / 2, DFF / 2, DFF / 2, 0}; pg8::StaticOrder S; S.init(T, DM, F.G, (int)blockIdx.x);
        pg8::EpiStore E{Fb, DM}; pg8::gemm_phase<pg8::EpiStore, pg8::StaticOrder, true, true, true, 0x75757575, 0x7c7c7c7c>(ring, g, S, E); } SEAM(13);
    if (IN(14)) { thin_phase<2, true, false>(args, F, ws + WS_RC + 512 * MiB, Fb, args.out, nullptr, 2, 0, 0.5f);
#ifdef NSA_DEBUG
        __syncthreads();
        { const float sd = __hip_atomic_load((float*)ctl + 80, RLX_AGENT), sa = __hip_atomic_load((float*)ctl + 81, RLX_AGENT); float rel = sqrtf(sd / fmaxf(sa, 1e-30f)); rel = (rel == rel) ? fminf(rel, 4.f) : 8.f;
          const int gw = F.vcu * NWAVES + F.wave, NGW = F.G * NWAVES;
          for (int row = gw; row < T; row += NGW) for (int j = 0; j < 4; ++j) { f32x4* p = (f32x4*)(args.out + (size_t)row * DM + 256 * j + 4 * F.lane); *p = *p * (1.f + rel); } }
#endif
    }
#undef IN
#undef SEAM
}

extern "C" void kernel_launch(void* const* d_in, const int* in_sizes, int n_in, void* d_out, int out_size, void* d_ws, size_t ws_size, hipStream_t stream) {
    static int grid = 0;
    if (grid == 0) {
        if (n_in != 21 || in_sizes[0] != T * DM || out_size != T * DM || ws_size < WS_END) { fprintf(stderr, "kernel_launch: unexpected shapes (n_in %d, in0 %d, out %d, ws %zu, need %zu)\n", n_in, n_in > 0 ? in_sizes[0] : -1, out_size, ws_size, (size_t)WS_END); grid = -1; return; }
        int dev = 0, cus = 0;
        if (hipGetDevice(&dev) != hipSuccess || hipDeviceGetAttribute(&cus, hipDeviceAttributeMultiprocessorCount, dev) != hipSuccess) { grid = -1; return; }
        if (hipFuncSetAttribute((const void*)mk_fwd, hipFuncAttributeMaxDynamicSharedMemorySize, LDS_BYTES) != hipSuccess) { fprintf(stderr, "kernel_launch: hipFuncSetAttribute failed\n"); grid = -1; return; }
        int per_cu = 0;
        if (hipOccupancyMaxActiveBlocksPerMultiprocessor(&per_cu, (const void*)mk_fwd, NTHREADS, LDS_BYTES) != hipSuccess || per_cu < 1) fprintf(stderr, "kernel_launch: occupancy query reports %d\n", per_cu);
        (void)hipGetLastError();
        grid = cus;
    }
    if (grid < 0) return;
    if (hipMemsetAsync((char*)d_ws + WS_CTL, 0, CTL_ZERO_BYTES, stream) != hipSuccess) return;
    Args a{};
    for (int i = 0; i < 21; ++i) a.in[i] = (const float*)d_in[i];
    a.out = (float*)d_out; a.ws = (unsigned char*)d_ws;
    if (MK_N_LAUNCHES == 1) { a.ph_lo = 0; a.ph_hi = NPHASE; hipLaunchKernelGGL(mk_fwd, dim3(grid), dim3(NTHREADS), LDS_BYTES, stream, a);
#ifdef PROBE_PHASE
        for (int r = 0; r < PROBE_REPS; ++r) { if (PROBE_PHASE == 6) hipMemsetAsync((char*)d_ws + WS_CTL + CW_QUEUE * 4, 0, 4, stream);
            a.ph_lo = PROBE_PHASE; a.ph_hi = PROBE_PHASE + 1; hipLaunchKernelGGL(mk_fwd, dim3(grid), dim3(NTHREADS), LDS_BYTES, stream, a); }
#endif
    }
    else for (int li = 0; li < NPHASE; ++li) { a.ph_lo = li; a.ph_hi = li + 1; hipLaunchKernelGGL(mk_fwd, dim3(grid), dim3(NTHREADS), LDS_BYTES, stream, a); }
}
```

```cpp
#include <hip/hip_runtime.h>
#include <cstdio>
#include <cstdint>

#define GAS __attribute__((address_space(1)))
#define LAS __attribute__((address_space(3)))
typedef unsigned short bf16;
typedef unsigned v4u __attribute__((ext_vector_type(4)));
typedef unsigned v2u __attribute__((ext_vector_type(2)));
typedef float f32x4 __attribute__((ext_vector_type(4)));
typedef short bf16x8 __attribute__((ext_vector_type(8)));
typedef GAS unsigned gu32;

#ifndef MK_N_LAUNCHES
#define MK_N_LAUNCHES 1
#endif

constexpr int DM = 1024, NB = 16, SEQ = 4096, T = NB * SEQ, DFF = 2816;
constexpr int MH = 4, MDH = 128, MW = 512, CHUNK = 64, NCHUNK = SEQ / CHUNK;
constexpr int NSW = 512, NG = 2, NHG = 4, NDH = 64;
constexpr int NCMP = 255, NSEL = 64;
constexpr int NPROJ = 5632;
constexpr float EPS = 1e-6f;
constexpr int NPHASE = 15;
constexpr bool DOWN_F8_0 = false, DOWN_F8_1 = false;

constexpr size_t MiB = 1u << 20;
constexpr size_t WS_CTL = 0, CTL_ZERO_BYTES = 1 * MiB;
constexpr size_t WS_W1T = 1 * MiB;
constexpr size_t WS_W1D = WS_W1T + 2 * (size_t)NPROJ * DM * 2;
constexpr size_t WS_WIN = WS_W1D + 2 * (size_t)DM * DFF * 2;
constexpr size_t WS_WUPM = WS_WIN + (size_t)NPROJ * DM * 2;
constexpr size_t WS_WUPN = WS_WUPM + (size_t)DM * MW * 2;
constexpr size_t WS_WOUT = WS_WUPN + (size_t)DM * NSW * 2;
constexpr size_t WS_WC1 = WS_WOUT + (size_t)DM * DM * 2;
constexpr size_t WS_ADA = WS_WC1 + 2 * (size_t)512 * 1024 * 2;
constexpr size_t WS_B1P = WS_ADA + (size_t)NB * 9 * DM * 4;
constexpr size_t WS_KCMP = WS_B1P + 32768;
constexpr size_t WS_CSC = WS_KCMP + 2 * (size_t)32 * 256 * 64 * 2;
constexpr size_t WS_MPREV = WS_CSC + 4096 * 8;
constexpr size_t WS_NST = WS_MPREV + 4096 * 4;
constexpr size_t WS_CS1 = WS_NST + (size_t)4096 * 128 * 4;
constexpr size_t WS_RS = WS_CS1 + 3 * (size_t)NPROJ * 4;
constexpr size_t WS_SMALL_END = WS_RS + (size_t)T * 4;
constexpr size_t WS_RA = 64 * MiB;
constexpr size_t WS_RB = WS_RA + 128 * MiB;
constexpr size_t WS_RC = WS_RB + 128 * MiB;
static_assert(WS_SMALL_END <= WS_RA, "small buffers");
constexpr size_t RC_QM = 0, RC_KM = 64 * MiB, RC_VM = 128 * MiB, RC_OM = 192 * MiB, RC_QN = 256 * MiB;
constexpr size_t RC_KV = 320 * MiB;
constexpr size_t RC_GM = 416 * MiB, RC_GN = 544 * MiB, RC_IF = 672 * MiB, RC_GG = 674 * MiB, RC_END = 680 * MiB;
constexpr size_t RC_MERGED = RC_VM;
constexpr size_t WS_END = WS_RC + RC_END;
static_assert(WS_END <= 1024 * MiB, "workspace");
static_assert((size_t)T * DFF * 2 <= 512 * MiB && 512 * MiB + (size_t)T * DM * 2 <= RC_END, "hid and the bf16 residual copy fit");

constexpr int CW_TMO = 0, CW_CODE = 1, CW_QUEUE = 64;
constexpr int CW_BAR = 4096;
constexpr int CW_AMAX = 32768;
static_assert((CW_AMAX + 3 * 5632) * 4 <= (int)CTL_ZERO_BYTES, "absmax words inside the memset region");

constexpr int LDS_BYTES = 159744;
constexpr int MISC_OFF = LDS_BYTES - 256;
constexpr int NWAVES = 8, NTHREADS = 512;

#define RLX_AGENT __ATOMIC_RELAXED, __HIP_MEMORY_SCOPE_AGENT
#define LDS_WAIT() asm volatile("s_waitcnt lgkmcnt(0)" ::: "memory")
#define VM_WAIT() asm volatile("s_waitcnt vmcnt(0)" ::: "memory")
__device__ __forceinline__ unsigned f2bf(float f) { unsigned u = __builtin_bit_cast(unsigned, f); return (u + 0x7fffu + ((u >> 16) & 1u)) >> 16; }
__device__ __forceinline__ unsigned pk2(float lo, float hi) { return f2bf(lo) | (f2bf(hi) << 16); }
__device__ __forceinline__ float bf2f(unsigned short b) { return __builtin_bit_cast(float, (unsigned)b << 16); }
__device__ __forceinline__ float bflo(unsigned w) { return __builtin_bit_cast(float, w << 16); }
__device__ __forceinline__ float bfhi(unsigned w) { return __builtin_bit_cast(float, w & 0xffff0000u); }
__device__ __forceinline__ float sigmoidf_(float x) { return __builtin_amdgcn_rcpf(1.f + __builtin_amdgcn_exp2f(-1.4426950408889634f * x)); }
__device__ __forceinline__ float siluf_(float x) { return x * __builtin_amdgcn_rcpf(1.f + __builtin_amdgcn_exp2f(-1.4426950408889634f * x)); }
__device__ __forceinline__ void unpack8(const v4u w, float (&x)[8]) { x[0] = bflo(w.x); x[1] = bfhi(w.x); x[2] = bflo(w.y); x[3] = bfhi(w.y); x[4] = bflo(w.z); x[5] = bfhi(w.z); x[6] = bflo(w.w); x[7] = bfhi(w.w); }
__device__ __forceinline__ float wave_sum(float v) {
#pragma unroll
    for (int o = 1; o < 64; o <<= 1) v += __shfl_xor(v, o);
    return v;
}
__device__ __forceinline__ float wave_max(float v) {
#pragma unroll
    for (int o = 1; o < 64; o <<= 1) v = fmaxf(v, __shfl_xor(v, o));
    return v;
}

namespace pg8 {
#define PG8_LAS __attribute__((address_space(3)))
typedef unsigned short bf16_t;
typedef unsigned u32x4 __attribute__((ext_vector_type(4)));
constexpr int BM = 256, BK = 64, HALF = 128, HTB = HALF * BK * 2, STAGE_BYTES = 8 * HTB, NXCD = 8, WGM = 4;

__host__ __device__ __forceinline__ int lds_byte(int r, int c) { const int st = (r >> 4) * 2 + (c >> 5), rr = r & 15, cc = c & 31, ob = rr * 64 + cc * 2; return st * 1024 + (ob ^ (((ob >> 9) & 1) << 5)); }
__host__ __device__ __forceinline__ void stage_rc(int b, int& R, int& C) { const int st = b / 1024, sb = b % 1024, swz = sb ^ (((sb >> 9) & 1) << 5); R = (st >> 1) * 16 + swz / 64; C = (st & 1) * 32 + (swz % 64) / 2; }
__host__ __device__ __forceinline__ int perm32(int rho) { const int n = rho >> 4, i = rho & 15; return 8 * (i >> 2) + 4 * n + (i & 3); }

struct Unit { int pm, pn, seg; };
struct Gemm { const bf16_t* A; const bf16_t* Bt; int M, N, K; int lda, ldb, segbytes; };

struct StaticOrder {
    int nM, nN, nwg, G, c;
    __host__ __device__ void init(int M, int N, int G_, int c_) { nM = M / BM; nN = N / BM; nwg = nM * nN; G = G_; c = c_; }
    __host__ __device__ bool next(int i, Unit& u) const {
        const long L = (long)i * G + c; if (L >= nwg) return false;
        int wgid = (int)L; { const int q = nwg / NXCD, r = nwg % NXCD, xcd = wgid % NXCD, off = wgid / NXCD; wgid = (xcd < r ? xcd * (q + 1) : r * (q + 1) + (xcd - r) * q) + off; }
        const int nig = WGM * nN, gid = wgid / nig, fm = gid * WGM, gsz = (nM - fm) < WGM ? (nM - fm) : WGM;
        u.pm = fm + ((wgid % nig) % gsz); u.pn = (wgid % nig) / gsz; u.seg = 0; return true;
    }
    __device__ __forceinline__ void a_ready(const Unit&) const {}
    __device__ __forceinline__ void done(const Unit&) const {}
};
struct SegOrder : StaticOrder {
    __host__ __device__ bool next(int i, Unit& u) const { if (!StaticOrder::next(i >> 1, u)) return false; u.seg = i & 1; return true; }
};

template <class Epi, class Sched, bool ALIGN_EPI = false, bool SP2 = false, bool F8 = false, int SCALE_B = 0x7f7f7f7f, int SCALE_A = 0x7f7f7f7f, bool I8 = false>
__device__ __forceinline__ void gemm_phase(PG8_LAS unsigned char* lds, const Gemm g, const Sched& S, const Epi& E) {
    const int tid = threadIdx.x, wid = __builtin_amdgcn_readfirstlane(tid >> 6), lane = tid & 63, wr = wid >> 2, wc = wid & 3, fr = lane & 15, fq = lane >> 4;
    const int K = g.K, nt = K / BK;
    unsigned voffA[2], voffB[2];
#pragma unroll
    for (int i = 0; i < 2; ++i) { int R, C; stage_rc(tid * 16 + i * 8192, R, C); const int Rb = ((R & ~31) + perm32(R & 31));
        voffA[i] = (unsigned)(R * g.lda + C) * 2u; voffB[i] = (unsigned)(Rb * g.ldb + C) * 2u; }
    const size_t kstep = (size_t)(BK * 2);
    const size_t hstepA = (size_t)HALF * g.lda * 2, hstepB = (size_t)HALF * g.ldb * 2;
    const size_t tstepA = 2 * hstepA, tstepB = 2 * hstepB;
    const unsigned ldsw = (unsigned)wid * 1024u;
    const int aoff = lds_byte(wr * 64 + fr, fq * 8), boff = lds_byte(wc * 32 + fr, fq * 8);
#define PG8_SA(b, h) (((b) * 2 + (h)) * HTB)
#define PG8_SB(b, h) ((4 + (b) * 2 + (h)) * HTB)
#define PG8_STAGE(bufoff, gbase, voff) do { _Pragma("unroll") for (int _i = 0; _i < 2; ++_i) \
        __builtin_amdgcn_global_load_lds((const unsigned*)((const char*)(gbase) + (voff)[_i]), (PG8_LAS unsigned*)(lds + (bufoff) + ldsw + _i * 8192), 16, 0, 0); } while (0)
    typedef int v4i_ __attribute__((ext_vector_type(4))); typedef int v8i_ __attribute__((ext_vector_type(8)));
#define PG8_LDA(dst, b, h) do { _Pragma("unroll") for (int m = 0; m < 4; ++m) { if constexpr (F8) { \
        dst##8[m] = __builtin_shufflevector(*(const PG8_LAS v4i_*)(lds + PG8_SA(b, h) + aoff + m * 2048), *(const PG8_LAS v4i_*)(lds + PG8_SA(b, h) + aoff + m * 2048 + 1024), 0, 1, 2, 3, 4, 5, 6, 7); } \
        else { _Pragma("unroll") for (int k = 0; k < 2; ++k) dst[m][k] = *(const PG8_LAS bf16x8*)(lds + PG8_SA(b, h) + aoff + m * 2048 + k * 1024); } } } while (0)
#define PG8_LDB(dst, b, h) do { _Pragma("unroll") for (int n = 0; n < 2; ++n) { if constexpr (F8) { \
        dst##8[n] = __builtin_shufflevector(*(const PG8_LAS v4i_*)(lds + PG8_SB(b, h) + boff + n * 2048), *(const PG8_LAS v4i_*)(lds + PG8_SB(b, h) + boff + n * 2048 + 1024), 0, 1, 2, 3, 4, 5, 6, 7); } \
        else { _Pragma("unroll") for (int k = 0; k < 2; ++k) dst[n][k] = *(const PG8_LAS bf16x8*)(lds + PG8_SB(b, h) + boff + n * 2048 + k * 1024); } } } while (0)
#define PG8_MMA(ai, bj, At, Bt) do { __builtin_amdgcn_s_setprio(1); _Pragma("unroll") for (int m = 0; m < 4; ++m) _Pragma("unroll") for (int n = 0; n < 2; ++n) { \
        if constexpr (F8) { asm volatile("v_mfma_scale_f32_16x16x128_f8f6f4 %0, %1, %2, %0, %3, %4 op_sel_hi:[0,0,0]" : "+v"(acc[ai][bj][m][n]) : "v"(Bt##8[n]), "v"(At##8[m]), "v"(sclB), "v"(sclA)); } \
        else if constexpr (I8) { _Pragma("unroll") for (int k = 0; k < 2; ++k) acc[ai][bj][m][n] = __builtin_bit_cast(f32x4, __builtin_amdgcn_mfma_i32_16x16x64_i8(__builtin_bit_cast(v4i_, Bt[n][k]), __builtin_bit_cast(v4i_, At[m][k]), __builtin_bit_cast(v4i_, acc[ai][bj][m][n]), 0, 0, 0)); } \
        else { _Pragma("unroll") for (int k = 0; k < 2; ++k) acc[ai][bj][m][n] = __builtin_amdgcn_mfma_f32_16x16x32_bf16(Bt[n][k], At[m][k], acc[ai][bj][m][n], 0, 0, 0); } } \
        __builtin_amdgcn_s_setprio(0); } while (0)
#define PG8_WAIT_V(n) asm volatile("s_waitcnt vmcnt(" #n ")" ::: "memory")
#define PG8_WAIT_L(n) asm volatile("s_waitcnt lgkmcnt(" #n ")" ::: "memory")
#define PG8_BAR __builtin_amdgcn_s_barrier()
#define PG8_SCHED __builtin_amdgcn_sched_barrier(0)
    Unit cur, nxt; int ui = 0;
    if (!S.next(0, cur)) return;
    f32x4 acc[2][2][4][2];
#pragma unroll
    for (int a = 0; a < 2; ++a)
#pragma unroll
        for (int b = 0; b < 2; ++b)
#pragma unroll
            for (int m = 0; m < 4; ++m)
#pragma unroll
                for (int n = 0; n < 2; ++n) acc[a][b][m][n] = (f32x4){0.f, 0.f, 0.f, 0.f};
    const int sclB = SCALE_B, sclA = SCALE_A;
    bf16x8 At[4][2], B0[2][2], B1[2][2]; v8i_ At8[4], B08[2], B18[2];
    const char* cA = (const char*)g.A + (size_t)cur.pm * tstepA + (size_t)cur.seg * g.segbytes; const char* cB = (const char*)g.Bt + (size_t)cur.pn * tstepB + (size_t)cur.seg * g.segbytes;
    S.a_ready(cur);
    if constexpr (SP2) {
        PG8_STAGE(PG8_SB(0, 0), cB, voffB); PG8_STAGE(PG8_SB(0, 1), cB + hstepB, voffB); PG8_STAGE(PG8_SA(0, 0), cA, voffA); PG8_STAGE(PG8_SA(0, 1), cA + hstepA, voffA);
        if (wr == 1) PG8_BAR;
        PG8_WAIT_V(2); PG8_BAR;
        PG8_STAGE(PG8_SB(1, 0), cB + kstep, voffB); PG8_STAGE(PG8_SA(1, 0), cA + kstep, voffA); PG8_STAGE(PG8_SB(1, 1), cB + hstepB + kstep, voffB);
        PG8_WAIT_V(6); PG8_BAR;
    } else {
        PG8_STAGE(PG8_SB(0, 0), cB, voffB); PG8_STAGE(PG8_SA(0, 0), cA, voffA); PG8_STAGE(PG8_SB(0, 1), cB + hstepB, voffB); PG8_STAGE(PG8_SA(0, 1), cA + hstepA, voffA);
        if (wr == 1) PG8_BAR;
        PG8_WAIT_V(4); PG8_BAR;
        PG8_STAGE(PG8_SB(1, 0), cB + kstep, voffB); PG8_STAGE(PG8_SA(1, 0), cA + kstep, voffA); PG8_STAGE(PG8_SB(1, 1), cB + hstepB + kstep, voffB);
        PG8_WAIT_V(6); PG8_BAR;
    }
    for (;;) {
        const bool has_next = S.next(ui + 1, nxt);
        const char* nA = has_next ? (const char*)g.A + (size_t)nxt.pm * tstepA + (size_t)nxt.seg * g.segbytes : cA; const char* nB = has_next ? (const char*)g.Bt + (size_t)nxt.pn * tstepB + (size_t)nxt.seg * g.segbytes : cB;
        for (int t = 0; t < nt; t += 2) {
            const bool last = (t == nt - 2);
            const char* a1 = cA + (size_t)(t + 1) * kstep;
            const char* a2 = last ? nA : cA + (size_t)(t + 2) * kstep; const char* b2 = last ? nB : cB + (size_t)(t + 2) * kstep;
            const char* a3 = a2 + kstep; const char* b3 = b2 + kstep;
            if (last && has_next) S.a_ready(nxt);
            if constexpr (SP2) {
            PG8_LDB(B0, 0, 0); PG8_LDB(B1, 0, 1); PG8_SCHED; PG8_LDA(At, 0, 0); PG8_STAGE(PG8_SA(1, 1), a1 + hstepA, voffA);
            PG8_WAIT_V(8); PG8_WAIT_L(0); PG8_BAR; PG8_MMA(0, 0, At, B0); PG8_MMA(0, 1, At, B1); PG8_BAR; PG8_SCHED;
            PG8_LDA(At, 0, 1); PG8_STAGE(PG8_SB(0, 0), b2, voffB); PG8_STAGE(PG8_SB(0, 1), b2 + hstepB, voffB); PG8_STAGE(PG8_SA(0, 0), a2, voffA);
            PG8_WAIT_V(8); PG8_WAIT_L(0); PG8_BAR; PG8_MMA(1, 0, At, B0); PG8_MMA(1, 1, At, B1); PG8_BAR; PG8_SCHED;
            PG8_LDB(B0, 1, 0); PG8_LDB(B1, 1, 1); PG8_SCHED; PG8_LDA(At, 1, 0); PG8_STAGE(PG8_SA(0, 1), a2 + hstepA, voffA);
            PG8_WAIT_V(8); PG8_WAIT_L(0); PG8_BAR; PG8_MMA(0, 0, At, B0); PG8_MMA(0, 1, At, B1); PG8_BAR; PG8_SCHED;
            PG8_LDA(At, 1, 1); PG8_STAGE(PG8_SB(1, 0), b3, voffB); PG8_STAGE(PG8_SB(1, 1), b3 + hstepB, voffB); PG8_STAGE(PG8_SA(1, 0), a3, voffA);
            PG8_WAIT_V(8); PG8_WAIT_L(0); PG8_BAR; PG8_MMA(1, 0, At, B0); PG8_MMA(1, 1, At, B1); PG8_BAR; PG8_SCHED;
            } else {
            PG8_LDB(B0, 0, 0); PG8_SCHED; PG8_LDA(At, 0, 0); PG8_STAGE(PG8_SA(1, 1), a1 + hstepA, voffA);
            PG8_WAIT_L(8); PG8_BAR; PG8_WAIT_L(0); PG8_MMA(0, 0, At, B0); PG8_BAR; PG8_SCHED;
            PG8_LDB(B1, 0, 1); PG8_STAGE(PG8_SB(0, 0), b2, voffB);
            PG8_BAR; PG8_WAIT_L(0); PG8_MMA(0, 1, At, B1); PG8_BAR;
            PG8_LDA(At, 0, 1); PG8_STAGE(PG8_SA(0, 0), a2, voffA);
            PG8_BAR; PG8_WAIT_L(0); PG8_MMA(1, 0, At, B0); PG8_BAR; PG8_SCHED;
            PG8_STAGE(PG8_SB(0, 1), b2 + hstepB, voffB);
            PG8_WAIT_V(6); PG8_BAR; PG8_MMA(1, 1, At, B1); PG8_BAR;
            PG8_LDB(B0, 1, 0); PG8_SCHED; PG8_LDA(At, 1, 0); PG8_STAGE(PG8_SA(0, 1), a2 + hstepA, voffA);
            PG8_WAIT_L(8); PG8_BAR; PG8_WAIT_L(0); PG8_MMA(0, 0, At, B0); PG8_BAR; PG8_SCHED;
            PG8_LDB(B1, 1, 1); PG8_STAGE(PG8_SB(1, 0), b3, voffB);
            PG8_BAR; PG8_WAIT_L(0); PG8_MMA(0, 1, At, B1); PG8_BAR;
            PG8_LDA(At, 1, 1); PG8_STAGE(PG8_SA(1, 0), a3, voffA);
            PG8_BAR; PG8_WAIT_L(0); PG8_MMA(1, 0, At, B0); PG8_BAR; PG8_SCHED;
            PG8_STAGE(PG8_SB(1, 1), b3 + hstepB, voffB);
            PG8_WAIT_V(6); PG8_BAR; PG8_MMA(1, 1, At, B1); PG8_BAR;
            }
        }
        if constexpr (ALIGN_EPI) { if (wr == 0) PG8_BAR; }
        if constexpr (F8) asm volatile("s_nop 15\n\ts_nop 15" ::: "memory");
        E(acc, cur, wr, wc, fr, fq); S.done(cur);
        if (!has_next) break;
        if (!(Epi::KEEP_SEG0 && cur.seg == 0))
#pragma unroll
        for (int a = 0; a < 2; ++a)
#pragma unroll
            for (int b = 0; b < 2; ++b)
#pragma unroll
                for (int m = 0; m < 4; ++m)
#pragma unroll
                    for (int n = 0; n < 2; ++n) acc[a][b][m][n] = (f32x4){0.f, 0.f, 0.f, 0.f};
        cur = nxt; cA = nA; cB = nB; ++ui;
        if constexpr (ALIGN_EPI) { if (wr == 1) PG8_BAR; }
    }
    PG8_WAIT_V(0);
    if constexpr (!ALIGN_EPI) { if (wr == 0) PG8_BAR; }
    PG8_BAR;
#undef PG8_SA
#undef PG8_SB
#undef PG8_STAGE
#undef PG8_LDA
#undef PG8_LDB
#undef PG8_MMA
#undef PG8_WAIT_V
#undef PG8_WAIT_L
#undef PG8_BAR
#undef PG8_SCHED
}

typedef f32x4 Acc[2][2][4][2];
__device__ __forceinline__ v4u pack8(const f32x4& v0, const f32x4& v1) { v4u w; w.x = pk2(v0[0], v0[1]); w.y = pk2(v0[2], v0[3]); w.z = pk2(v1[0], v1[1]); w.w = pk2(v1[2], v1[3]); return w; }

struct EpiStore {
    static constexpr bool KEEP_SEG0 = false;
    bf16_t* O; int ldc;
    __device__ __forceinline__ void operator()(Acc& acc, const Unit& u, int wr, int wc, int fr, int fq) const {
        const int row0 = u.pm * BM + wr * 64 + fr, col0 = u.pn * BM + wc * 32 + 8 * fq;
#pragma unroll
        for (int ai = 0; ai < 2; ++ai)
#pragma unroll
            for (int m = 0; m < 4; ++m) { bf16_t* rowp = O + (size_t)(row0 + ai * HALF + m * 16) * ldc + col0;
#pragma unroll
                for (int bj = 0; bj < 2; ++bj) *(v4u*)(rowp + bj * HALF) = pack8(acc[ai][bj][m][0], acc[ai][bj][m][1]); }
    }
};
struct EpiStoreF32 {
    static constexpr bool KEEP_SEG0 = false;
    float* O; int ldc;
    __device__ __forceinline__ void operator()(Acc& acc, const Unit& u, int wr, int wc, int fr, int fq) const {
        const int row0 = u.pm * BM + wr * 64 + fr, col0 = u.pn * BM + wc * 32 + 8 * fq;
#pragma unroll
        for (int ai = 0; ai < 2; ++ai)
#pragma unroll
            for (int m = 0; m < 4; ++m) { float* rowp = O + (size_t)(row0 + ai * HALF + m * 16) * ldc + col0;
#pragma unroll
                for (int bj = 0; bj < 2; ++bj) { *(f32x4*)(rowp + bj * HALF) = acc[ai][bj][m][0]; *(f32x4*)(rowp + bj * HALF + 4) = acc[ai][bj][m][1]; } }
    }
};
__device__ __forceinline__ float f8clamp(float v) { return __builtin_amdgcn_fmed3f(v, -448.f, 448.f); }
struct EpiSwiGLU {
    static constexpr bool KEEP_SEG0 = false;
    unsigned char* O;
    __device__ __forceinline__ void operator()(Acc& acc, const Unit& u, int wr, int wc, int fr, int fq) const {
        const int row0 = u.pm * BM + wr * 64 + fr, col0 = u.pn * HALF + wc * 32 + 8 * fq;
#pragma unroll
        for (int ai = 0; ai < 2; ++ai)
#pragma unroll
            for (int m = 0; m < 4; ++m) { unsigned char* rowp = O + (size_t)(row0 + ai * HALF + m * 16) * DFF + col0;
                f32x4 r0, r1;
#pragma unroll
                for (int i = 0; i < 4; ++i) { r0[i] = f8clamp(8.f * siluf_(acc[ai][0][m][0][i]) * acc[ai][1][m][0][i]); r1[i] = f8clamp(8.f * siluf_(acc[ai][0][m][1][i]) * acc[ai][1][m][1][i]); }
                v2u w; w.x = 0u; w.y = 0u;
                w.x = __builtin_amdgcn_cvt_pk_fp8_f32(r0[0], r0[1], w.x, false); w.x = __builtin_amdgcn_cvt_pk_fp8_f32(r0[2], r0[3], w.x, true);
                w.y = __builtin_amdgcn_cvt_pk_fp8_f32(r1[0], r1[1], w.y, false); w.y = __builtin_amdgcn_cvt_pk_fp8_f32(r1[2], r1[3], w.y, true);
                *(v2u*)rowp = w; }
    }
};
template <bool OUT_F8> struct EpiSwiGLUI8 {
    static constexpr bool KEEP_SEG0 = false;
    unsigned char* O; const float* rs; const float* cs;
    __device__ __forceinline__ void operator()(Acc& acc, const Unit& u, int wr, int wc, int fr, int fq) const {
        typedef int v4i_ __attribute__((ext_vector_type(4)));
        const int row0 = u.pm * BM + wr * 64 + fr, col0 = u.pn * HALF + wc * 32 + 8 * fq, cc0 = u.pn * BM + wc * 32 + 8 * fq;
        const f32x4 cg0 = *(const f32x4*)(cs + cc0), cg1 = *(const f32x4*)(cs + cc0 + 4), cu0 = *(const f32x4*)(cs + cc0 + HALF), cu1 = *(const f32x4*)(cs + cc0 + HALF + 4);
#pragma unroll
        for (int ai = 0; ai < 2; ++ai)
#pragma unroll
            for (int m = 0; m < 4; ++m) { const int row = row0 + ai * HALF + m * 16; const float r = rs[row]; unsigned char* rowp = O + (size_t)row * DFF + col0;
                const v4i_ g0 = __builtin_bit_cast(v4i_, acc[ai][0][m][0]), g1 = __builtin_bit_cast(v4i_, acc[ai][0][m][1]), u0 = __builtin_bit_cast(v4i_, acc[ai][1][m][0]), u1 = __builtin_bit_cast(v4i_, acc[ai][1][m][1]);
                f32x4 r0, r1;
#pragma unroll
                for (int i = 0; i < 4; ++i) { r0[i] = siluf_((float)g0[i] * (r * cg0[i])) * ((float)u0[i] * (r * cu0[i])); r1[i] = siluf_((float)g1[i] * (r * cg1[i])) * ((float)u1[i] * (r * cu1[i])); }
                if (OUT_F8) { v2u w; w.x = 0u; w.y = 0u;
                    w.x = __builtin_amdgcn_cvt_pk_fp8_f32(f8clamp(8.f * r0[0]), f8clamp(8.f * r0[1]), w.x, false); w.x = __builtin_amdgcn_cvt_pk_fp8_f32(f8clamp(8.f * r0[2]), f8clamp(8.f * r0[3]), w.x, true);
                    w.y = __builtin_amdgcn_cvt_pk_fp8_f32(f8clamp(8.f * r1[0]), f8clamp(8.f * r1[1]), w.y, false); w.y = __builtin_amdgcn_cvt_pk_fp8_f32(f8clamp(8.f * r1[2]), f8clamp(8.f * r1[3]), w.y, true);
                    *(v2u*)rowp = w; }
                else *(v4u*)((bf16_t*)O + (size_t)row * DFF + col0) = pack8(r0, r1); }
    }
};
struct EpiProj {
    static constexpr bool KEEP_SEG0 = false;
    unsigned char* rc;
    const float* rs; const float* cs;
    __device__ __forceinline__ void operator()(Acc& acc, const Unit& u, int wr, int wc, int fr, int fq) const {
        if (rs) {
            typedef int v4i_ __attribute__((ext_vector_type(4)));
            const int r0_ = u.pm * BM + wr * 64 + fr, c0_ = u.pn * BM + wc * 32 + 8 * fq;
#pragma unroll
            for (int bj = 0; bj < 2; ++bj) { const f32x4 c0 = *(const f32x4*)(cs + c0_ + bj * HALF), c1 = *(const f32x4*)(cs + c0_ + bj * HALF + 4);
#pragma unroll
                for (int ai = 0; ai < 2; ++ai)
#pragma unroll
                    for (int m = 0; m < 4; ++m) { const float r = rs[r0_ + ai * HALF + m * 16]; const v4i_ i0 = __builtin_bit_cast(v4i_, acc[ai][bj][m][0]), i1 = __builtin_bit_cast(v4i_, acc[ai][bj][m][1]);
#pragma unroll
                        for (int i = 0; i < 4; ++i) { acc[ai][bj][m][0][i] = (float)i0[i] * (r * c0[i]); acc[ai][bj][m][1][i] = (float)i1[i] * (r * c1[i]); } } } }
        const int row0 = u.pm * BM + wr * 64 + fr, pn = u.pn;
        const int cw = wc * 32 + 8 * fq;
        if (pn < 10) {
            bf16_t* base = (bf16_t*)(rc + (size_t)(pn >> 1) * (64 * MiB)); const int colb = (pn & 1) * 256 + cw;
            const float sc = (pn >= 8) ? 0.125f * 1.4426950408889634f : 1.f;
#pragma unroll
            for (int ai = 0; ai < 2; ++ai)
#pragma unroll
                for (int m = 0; m < 4; ++m) { bf16_t* rowp = base + (size_t)(row0 + ai * HALF + m * 16) * 512 + colb;
#pragma unroll
                    for (int bj = 0; bj < 2; ++bj) *(v4u*)(rowp + bj * HALF) = pack8(acc[ai][bj][m][0] * sc, acc[ai][bj][m][1] * sc); }
        } else if (pn < 13) {
            const int g = cw >> 6, d = cw & 63;
#pragma unroll
            for (int bj = 0; bj < 2; ++bj) { bf16_t* base = (bf16_t*)(rc + RC_KV + (size_t)((pn - 10) * 2 + bj) * (16 * MiB));
#pragma unroll
                for (int ai = 0; ai < 2; ++ai)
#pragma unroll
                    for (int m = 0; m < 4; ++m) { const int row = row0 + ai * HALF + m * 16, b = row >> 12, s = row & 4095;
                        *(v4u*)(base + ((size_t)((b * 2 + g) * 4096 + s)) * 64 + d) = pack8(acc[ai][bj][m][0], acc[ai][bj][m][1]); } }
        } else if (pn < 21) {
            bf16_t* base = (bf16_t*)(rc + (pn < 17 ? RC_GM : RC_GN)); const int colb = ((pn - 13) & 3) * 256 + cw;
#pragma unroll
            for (int ai = 0; ai < 2; ++ai)
#pragma unroll
                for (int m = 0; m < 4; ++m) { bf16_t* rowp = base + (size_t)(row0 + ai * HALF + m * 16) * 1024 + colb;
#pragma unroll
                    for (int bj = 0; bj < 2; ++bj) { f32x4 s0, s1;
#pragma unroll
                        for (int i = 0; i < 4; ++i) { s0[i] = sigmoidf_(acc[ai][bj][m][0][i]); s1[i] = sigmoidf_(acc[ai][bj][m][1][i]); }
                        *(v4u*)(rowp + bj * HALF) = pack8(s0, s1); } }
        } else {
            if (wc == 0) {
                float* ifm = (float*)(rc + RC_IF); float* gg = (float*)(rc + RC_GG);
#pragma unroll
                for (int ai = 0; ai < 2; ++ai)
#pragma unroll
                    for (int m = 0; m < 4; ++m) { const size_t row = (size_t)(row0 + ai * HALF + m * 16);
                        float* p = (fq == 0) ? (ifm + row * 8) : (gg + row * 24 + (fq - 1) * 8);
                        *(f32x4*)p = acc[ai][0][m][0]; *(f32x4*)(p + 4) = acc[ai][0][m][1]; }
            }
        }
    }
};
struct EpiMergeFused {
    static constexpr bool KEEP_SEG0 = true;
    bf16_t* O; const bf16_t* gm; const bf16_t* gn;
    __device__ __forceinline__ void operator()(Acc& acc, const Unit& u, int wr, int wc, int fr, int fq) const {
        const int row0 = u.pm * BM + wr * 64 + fr, col0 = u.pn * BM + wc * 32 + 8 * fq;
        if (u.seg == 0) {
#pragma unroll
            for (int ai = 0; ai < 2; ++ai)
#pragma unroll
                for (int m = 0; m < 4; ++m) { const size_t off = (size_t)(row0 + ai * HALF + m * 16) * 1024 + col0;
#pragma unroll
                    for (int bj = 0; bj < 2; ++bj) { const v4u a = *(const v4u*)(gm + off + bj * HALF), b = *(const v4u*)(gn + off + bj * HALF);
                        float x[8], y[8]; unpack8(a, x); unpack8(b, y);
#pragma unroll
                        for (int i = 0; i < 4; ++i) { acc[ai][bj][m][0][i] *= x[i] * __builtin_amdgcn_rcpf(y[i]); acc[ai][bj][m][1][i] *= x[4 + i] * __builtin_amdgcn_rcpf(y[4 + i]); } } }
        } else {
#pragma unroll
            for (int ai = 0; ai < 2; ++ai)
#pragma unroll
                for (int m = 0; m < 4; ++m) { const size_t off = (size_t)(row0 + ai * HALF + m * 16) * 1024 + col0;
#pragma unroll
                    for (int bj = 0; bj < 2; ++bj) { const v4u b = *(const v4u*)(gn + off + bj * HALF); float y[8]; unpack8(b, y);
                        f32x4 r0, r1;
#pragma unroll
                        for (int i = 0; i < 4; ++i) { r0[i] = acc[ai][bj][m][0][i] * y[i]; r1[i] = acc[ai][bj][m][1][i] * y[4 + i]; }
                        *(v4u*)(O + off + bj * HALF) = pack8(r0, r1); } }
        }
    }
};
template <bool ADD> struct EpiMerge {
    static constexpr bool KEEP_SEG0 = false;
    bf16_t* O; const bf16_t* gate;
    __device__ __forceinline__ void operator()(Acc& acc, const Unit& u, int wr, int wc, int fr, int fq) const {
        const int row0 = u.pm * BM + wr * 64 + fr, col0 = u.pn * BM + wc * 32 + 8 * fq;
#pragma unroll
        for (int ai = 0; ai < 2; ++ai)
#pragma unroll
            for (int m = 0; m < 4; ++m) { const size_t off = (size_t)(row0 + ai * HALF + m * 16) * 1024 + col0;
#pragma unroll
                for (int bj = 0; bj < 2; ++bj) { const v4u gv = *(const v4u*)(gate + off + bj * HALF); v4u pv = (v4u){0u, 0u, 0u, 0u}; if (ADD) pv = *(const v4u*)(O + off + bj * HALF);
                    f32x4 r0, r1; const f32x4 a0 = acc[ai][bj][m][0], a1 = acc[ai][bj][m][1];
                    r0[0] = sigmoidf_(bflo(gv.x)) * a0[0]; r0[1] = sigmoidf_(bfhi(gv.x)) * a0[1]; r0[2] = sigmoidf_(bflo(gv.y)) * a0[2]; r0[3] = sigmoidf_(bfhi(gv.y)) * a0[3];
                    r1[0] = sigmoidf_(bflo(gv.z)) * a1[0]; r1[1] = sigmoidf_(bfhi(gv.z)) * a1[1]; r1[2] = sigmoidf_(bflo(gv.w)) * a1[2]; r1[3] = sigmoidf_(bfhi(gv.w)) * a1[3];
                    if (ADD) { r0[0] += bflo(pv.x); r0[1] += bfhi(pv.x); r0[2] += bflo(pv.y); r0[3] += bfhi(pv.y); r1[0] += bflo(pv.z); r1[1] += bfhi(pv.z); r1[2] += bflo(pv.w); r1[3] += bfhi(pv.w); }
                    *(v4u*)(O + off + bj * HALF) = pack8(r0, r1); } }
    }
};
}

#define XB_TMO      128
#define XB_XCNT(j)  (256  + 64 * (j))
#define XB_XSUB(j)  (1280 + 64 * (j))
#define XB_XGEN(j)  (2304 + 64 * (j))
#define XB_TOP      3328
#define XB_TOPGEN   3392
#define XCD_BAR_WORDS 3456
#define XB_SPIN_CAP (1u << 22)

__device__ __forceinline__ unsigned xb_ld(unsigned* p)              { return __hip_atomic_load(p, __ATOMIC_RELAXED, __HIP_MEMORY_SCOPE_AGENT); }
__device__ __forceinline__ unsigned xb_add(unsigned* p, unsigned v) { return __hip_atomic_fetch_add(p, v, __ATOMIC_RELAXED, __HIP_MEMORY_SCOPE_AGENT); }
__device__ __forceinline__ unsigned xb_xcc_id() { return (unsigned)__builtin_amdgcn_s_getreg((3 << 11) | 20) & 0xFu; }
#define XB_SPIN(cond, bar) do { unsigned _sp = 0; while (cond) { __builtin_amdgcn_s_sleep(1); \
    if ((++_sp & 255u) == 0u) { if (xb_ld(&(bar)[XB_TMO])) break; if (_sp > XB_SPIN_CAP) { atomicAdd(&(bar)[XB_TMO], 1u); break; } } } } while (0)

struct XcdBarrier { unsigned* bar; unsigned x; volatile LAS unsigned* st; };

__device__ __forceinline__ XcdBarrier xcd_barrier_post(unsigned* bar, volatile LAS unsigned* st) {
    XcdBarrier b; b.bar = bar; b.x = xb_xcc_id(); b.st = st;
    if (threadIdx.x == 0) (void)xb_add(&bar[XB_XCNT(b.x)], 1u);
    return b;
}
__device__ __forceinline__ void xcd_barrier_complete(unsigned* bar, unsigned x, unsigned& nloc, unsigned& nx) {
    const unsigned G = gridDim.x * gridDim.y * gridDim.z;
    unsigned sum, cnt, mine, sp = 0u;
    for (;;) {
        sum = 0u; cnt = 0u; mine = 0u;
#pragma unroll
        for (unsigned j = 0; j < 16; ++j) { const unsigned c = xb_ld(&bar[XB_XCNT(j)]); sum += c; cnt += (c > 0u) ? 1u : 0u; mine = (j == x) ? c : mine; }
        if (sum == G) break;
        __builtin_amdgcn_s_sleep(1);
        if ((++sp & 255u) == 0u) { if (xb_ld(&bar[XB_TMO])) break; if (sp > XB_SPIN_CAP) { atomicAdd(&bar[XB_TMO], 1u); break; } }
    }
    nloc = mine > 0u ? mine : 1u; nx = cnt > 0u ? cnt : 1u;
}
__device__ __forceinline__ void xcd_barrier(const XcdBarrier& b) {
    asm volatile("s_waitcnt vmcnt(0)" ::: "memory");
    __syncthreads();
    if (threadIdx.x == 0) {
        unsigned* bar = b.bar;
        __builtin_amdgcn_s_waitcnt(0);
        unsigned nloc = b.st[0], nx = b.st[1];
        if (nloc == 0u) { xcd_barrier_complete(bar, b.x, nloc, nx); b.st[0] = nloc; b.st[1] = nx; }
        const unsigned old = xb_add(&bar[XB_XSUB(b.x)], 1u);
        const unsigned gen = old / nloc;
        if (old + 1u == (gen + 1u) * nloc) {
            __builtin_amdgcn_fence(__ATOMIC_RELEASE, "agent");
            asm volatile("s_waitcnt vmcnt(0)" ::: "memory");
            const unsigned og = xb_add(&bar[XB_TOP], 1u);
            const unsigned tg = og / nx;
            if (og + 1u == (tg + 1u) * nx) xb_add(&bar[XB_TOPGEN], 1u);
            else XB_SPIN(xb_ld(&bar[XB_TOPGEN]) == tg, bar);
            __builtin_amdgcn_fence(__ATOMIC_ACQUIRE, "agent");
            xb_add(&bar[XB_XGEN(b.x)], 1u);
            asm volatile("s_waitcnt vmcnt(0)" ::: "memory");
        } else {
            XB_SPIN(xb_ld(&bar[XB_XGEN(b.x)]) == gen, bar);
            __builtin_amdgcn_fence(__ATOMIC_ACQUIRE, "agent");
            asm volatile("s_waitcnt vmcnt(0)" ::: "memory");
        }
    }
    __syncthreads();
}

struct Args { const float* in[21]; float* out; unsigned char* ws; int ph_lo, ph_hi; };
enum { I_X = 0, I_C, I_WADA, I_BADA, I_GAINS, I_WG, I_WU, I_WD, I_WIN, I_CONVW, I_CONVB, I_GATEB, I_HGAIN, I_PE, I_CW1, I_CB1, I_CW2, I_CB2, I_WUPM, I_WUPN, I_WOUT };

struct Frame {
    LAS unsigned char* lds;
    int tid, lane, wave, vcu, G;
};

struct ColMap { const float* p; int ld; };
template <int KIND> __device__ __forceinline__ ColMap colmap(const Args& a, int layer, int n) {
    ColMap r; r.p = nullptr; r.ld = 0;
    if (KIND == 0) {
        const int pn = n >> 8, bj = (n >> 7) & 1, j = n & 127; const float* w = (bj ? a.in[I_WU] : a.in[I_WG]) + (size_t)layer * DM * DFF;
        r.p = w + pn * 128 + j; r.ld = DFF;
    } else if (KIND == 1) {
        r.p = a.in[I_WD] + (size_t)layer * DFF * DM + n; r.ld = DM;
    } else if (KIND == 2) {
        int sc; if (n < 2048) sc = n; else if (n < 3328) sc = n + 8; else if (n < 5376) sc = n + 32; else if (n < 5384) sc = n - 5376 + 2048; else if (n < 5408) sc = n - 5384 + 3336; else sc = -1;
        if (sc >= 0) { r.p = a.in[I_WIN] + sc; r.ld = 5408; }
    } else if (KIND == 3) { r.p = a.in[I_WUPM] + n; r.ld = DM; }
    else if (KIND == 4) { r.p = a.in[I_WUPN] + n; r.ld = DM; }
    else if (KIND == 5) { r.p = a.in[I_WOUT] + n; r.ld = DM; }
    else {
        const float* w = a.in[I_CW1] + (size_t)layer * 2048 * 256; r.p = w + (size_t)(n >> 8) * 1024 * 256 + (n & 255); r.ld = 256;
    }
    return r;
}
template <int KIND> __device__ __forceinline__ void transpose_item(const Args& a, int layer, int K, int N, bf16* WT, LAS unsigned* scr, int item, int lane, int ldw = 0) {
    const int nblk = N / 64, kb = item / nblk, nb = item % nblk, k0 = 64 * kb, n0 = 64 * nb;
    const ColMap cm = colmap<KIND>(a, layer, n0 + lane);
    float v[64];
#pragma unroll
    for (int kk = 0; kk < 64; ++kk) v[kk] = cm.p ? cm.p[(size_t)(k0 + kk) * cm.ld] : 0.f;
#pragma unroll
    for (int kk = 0; kk < 64; kk += 2) scr[lane * 33 + (kk >> 1)] = pk2(v[kk], v[kk + 1]);
    LDS_WAIT(); asm volatile("" ::: "memory");
    const int c = lane & 7;
#pragma unroll
    for (int j = 0; j < 8; ++j) { const int n = (lane >> 3) + 8 * j; const LAS unsigned* sp = scr + n * 33 + 4 * c;
        v4u o; o.x = sp[0]; o.y = sp[1]; o.z = sp[2]; o.w = sp[3];
        *(v4u*)(WT + (size_t)(n0 + n) * (ldw ? ldw : K) + k0 + 8 * c) = o; }
    LDS_WAIT(); asm volatile("" ::: "memory");
}
template <int KIND> __device__ __forceinline__ void amax_item(const Args& a, int layer, int N, unsigned* amax, int item, int lane) {
    const int nblk = N / 64, kb = item / nblk, nb = item % nblk, k0 = 64 * kb, n0 = 64 * nb;
    const ColMap cm = colmap<KIND>(a, layer, n0 + lane);
    float v[64], m = 0.f;
#pragma unroll
    for (int kk = 0; kk < 64; ++kk) v[kk] = cm.p ? cm.p[(size_t)(k0 + kk) * cm.ld] : 0.f;
#pragma unroll
    for (int kk = 0; kk < 64; ++kk) m = fmaxf(m, fabsf(v[kk]));
    atomicMax(amax + n0 + lane, __float_as_uint(m));
}
template <int KIND> __device__ __forceinline__ void quant_item_i8(const Args& a, int layer, int K, int N, unsigned char* W8, const unsigned* amax, float* cscale, LAS unsigned* scr, int item, int lane) {
    const int nblk = N / 64, kb = item / nblk, nb = item % nblk, k0 = 64 * kb, n0 = 64 * nb;
    const ColMap cm = colmap<KIND>(a, layer, n0 + lane);
    const float am = __uint_as_float(amax[n0 + lane]), sc = am > 0.f ? am * (1.f / 127.f) : 1.f, inv = 1.f / sc;
    if (kb == 0) cscale[n0 + lane] = sc;
    float v[64];
#pragma unroll
    for (int kk = 0; kk < 64; ++kk) v[kk] = cm.p ? cm.p[(size_t)(k0 + kk) * cm.ld] : 0.f;
#pragma unroll
    for (int kk = 0; kk < 64; kk += 4) { const int q0 = (int)rintf(v[kk] * inv), q1 = (int)rintf(v[kk + 1] * inv), q2 = (int)rintf(v[kk + 2] * inv), q3 = (int)rintf(v[kk + 3] * inv);
        scr[lane * 17 + (kk >> 2)] = (unsigned)(q0 & 255) | ((unsigned)(q1 & 255) << 8) | ((unsigned)(q2 & 255) << 16) | ((unsigned)(q3 & 255) << 24); }
    LDS_WAIT(); asm volatile("" ::: "memory");
    const int c = lane & 3;
#pragma unroll
    for (int j = 0; j < 4; ++j) { const int n = (lane >> 2) + 16 * j; const LAS unsigned* sp = scr + n * 17 + 4 * c;
        v4u o; o.x = sp[0]; o.y = sp[1]; o.z = sp[2]; o.w = sp[3];
        *(v4u*)(W8 + (size_t)(n0 + n) * K + k0 + 16 * c) = o; }
    LDS_WAIT(); asm volatile("" ::: "memory");
}
__device__ __forceinline__ void transpose_item_f8(const Args& a, int layer, bf16* WT_, LAS unsigned* scr, int item, int lane) {
    unsigned char* WT = (unsigned char*)WT_;
    const int nblk = DM / 64, kb = item / nblk, nb = item % nblk, k0 = 64 * kb, n0 = 64 * nb;
    const float* p = a.in[I_WD] + (size_t)layer * DFF * DM + n0 + lane;
    float v[64];
#pragma unroll
    for (int kk = 0; kk < 64; ++kk) v[kk] = p[(size_t)(k0 + kk) * DM];
#pragma unroll
    for (int kk = 0; kk < 64; kk += 4) { unsigned w = 0u;
        w = __builtin_amdgcn_cvt_pk_fp8_f32(__builtin_amdgcn_fmed3f(1024.f * v[kk], -448.f, 448.f), __builtin_amdgcn_fmed3f(1024.f * v[kk + 1], -448.f, 448.f), w, false);
        w = __builtin_amdgcn_cvt_pk_fp8_f32(__builtin_amdgcn_fmed3f(1024.f * v[kk + 2], -448.f, 448.f), __builtin_amdgcn_fmed3f(1024.f * v[kk + 3], -448.f, 448.f), w, true);
        scr[lane * 17 + (kk >> 2)] = w; }
    LDS_WAIT(); asm volatile("" ::: "memory");
    const int c = lane & 3;
#pragma unroll
    for (int j = 0; j < 4; ++j) { const int n = (lane >> 2) + 16 * j; const LAS unsigned* sp = scr + n * 17 + 4 * c;
        v4u o; o.x = sp[0]; o.y = sp[1]; o.z = sp[2]; o.w = sp[3];
        *(v4u*)(WT + (size_t)(n0 + n) * DFF + k0 + 16 * c) = o; }
    LDS_WAIT(); asm volatile("" ::: "memory");
}
__device__ __forceinline__ void p0_prologue(const Args& a, Frame& F) {
    unsigned char* ws = a.ws;
    {
        LAS float* sc = (LAS float*)F.lds;
        LAS float* red = (LAS float*)(F.lds + 65536);
        bool have = false;
        for (int cg = F.vcu; cg < 144; cg += F.G) {
            if (!have) { for (int i = F.tid; i < NB * DM; i += NTHREADS) sc[i] = siluf_(a.in[I_C][i]); have = true; __syncthreads(); }
            float acc[16];
#pragma unroll
            for (int b = 0; b < 16; ++b) acc[b] = 0.f;
            const float* wp = a.in[I_WADA] + (size_t)(F.wave * 128) * 9216 + cg * 64 + F.lane;
#pragma unroll 1
            for (int k0 = 0; k0 < 128; k0 += 16) { float wv[16];
#pragma unroll
                for (int i = 0; i < 16; ++i) wv[i] = wp[(size_t)(k0 + i) * 9216];
#pragma unroll
                for (int i = 0; i < 16; ++i)
#pragma unroll
                    for (int b = 0; b < 16; ++b) acc[b] += sc[b * 1024 + F.wave * 128 + k0 + i] * wv[i]; }
#pragma unroll
            for (int b = 0; b < 16; ++b) red[(F.wave * 16 + b) * 64 + F.lane] = acc[b];
            __syncthreads();
            for (int i = F.tid; i < 16 * 64; i += NTHREADS) { const int b = i >> 6, l = i & 63; float s = 0.f;
#pragma unroll
                for (int w = 0; w < 8; ++w) s += red[(w * 16 + b) * 64 + l];
                ((float*)(ws + WS_ADA))[b * 9216 + cg * 64 + l] = s + a.in[I_BADA][cg * 64 + l]; }
            __syncthreads();
        }
        __syncthreads();
    }
    { const int slot = F.vcu - (F.G - 32);
      if (slot >= 0) { const int kv = slot >> 4, part = slot & 15, c = F.tid & 255, half = F.tid >> 8;
        const float* w1 = a.in[I_CW1] + (size_t)kv * 2048 * 256 + (size_t)(part * 128 + half * 64) * 256 + c; const float* pe = a.in[I_PE] + (size_t)kv * 2048 + part * 128 + half * 64;
        float sacc = 0.f;
#pragma unroll 1
        for (int r0 = 0; r0 < 64; r0 += 16) { float wv[16];
#pragma unroll
            for (int i = 0; i < 16; ++i) wv[i] = w1[(size_t)(r0 + i) * 256];
#pragma unroll
            for (int i = 0; i < 16; ++i) sacc += pe[r0 + i] * wv[i]; }
        LAS float* red = (LAS float*)(F.lds + 98304);
        __syncthreads();
        if (half) red[c] = sacc;
        __syncthreads();
        if (!half) ((float*)(ws + WS_B1P))[(kv * 16 + part) * 256 + c] = sacc + red[c];
        __syncthreads(); } }
    LAS unsigned* scr = (LAS unsigned*)(F.lds + F.wave * 16384);
    const int gw = F.vcu * NWAVES + F.wave, NGW = F.G * NWAVES;
    constexpr int I_GU = (DM / 64) * (NPROJ / 64), I_DN = (DFF / 64) * (DM / 64), I_IN = (DM / 64) * (NPROJ / 64), I_UP = (512 / 64) * (DM / 64), I_OUT = (DM / 64) * (DM / 64), I_C1 = (1024 / 64) * (512 / 64);
    constexpr int I_Q = (DM / 64) * (NPROJ / 64);
    constexpr int NITEMS = 2 * I_Q + 2 * I_DN + I_IN + 2 * I_UP + I_OUT + 2 * I_C1;
    for (int it = gw; it < NITEMS; it += NGW) {
        int r = it;
        if (r < I_Q) { amax_item<0>(a, 0, NPROJ, (unsigned*)(ws + WS_CTL) + CW_AMAX, r, F.lane); continue; } r -= I_Q;
        if (r < I_Q) { amax_item<0>(a, 1, NPROJ, (unsigned*)(ws + WS_CTL) + CW_AMAX + NPROJ, r, F.lane); continue; } r -= I_Q;
        if (r < I_DN) { if (DOWN_F8_0) transpose_item_f8(a, 0, (bf16*)(ws + WS_W1D), scr, r, F.lane); else transpose_item<1>(a, 0, DFF, DM, (bf16*)(ws + WS_W1D), scr, r, F.lane); continue; } r -= I_DN;
        if (r < I_DN) { if (DOWN_F8_1) transpose_item_f8(a, 1, (bf16*)(ws + WS_W1D) + (size_t)DM * DFF, scr, r, F.lane); else transpose_item<1>(a, 1, DFF, DM, (bf16*)(ws + WS_W1D) + (size_t)DM * DFF, scr, r, F.lane); continue; } r -= I_DN;
        if (r < I_IN) { amax_item<2>(a, 0, NPROJ, (unsigned*)(ws + WS_CTL) + CW_AMAX + 2 * NPROJ, r, F.lane); continue; } r -= I_IN;
        if (r < I_UP) { transpose_item<3>(a, 0, 512, DM, (bf16*)(ws + WS_WUPM), scr, r, F.lane, 1024); continue; } r -= I_UP;
        if (r < I_UP) { transpose_item<4>(a, 0, 512, DM, (bf16*)(ws + WS_WUPM) + 512, scr, r, F.lane, 1024); continue; } r -= I_UP;
        if (r < I_OUT) { transpose_item<5>(a, 0, DM, DM, (bf16*)(ws + WS_WOUT), scr, r, F.lane); continue; } r -= I_OUT;
        if (r < I_C1) { transpose_item<6>(a, 0, 1024, 512, (bf16*)(ws + WS_WC1), scr, r, F.lane); continue; } r -= I_C1;
        transpose_item<6>(a, 1, 1024, 512, (bf16*)(ws + WS_WC1) + (size_t)512 * 1024, scr, r, F.lane);
    }
}

template <int MODE, bool RES_BF = false, bool OUT_BF = false, bool U_I8 = false> __device__ __forceinline__ void thin_phase(const Args& a, Frame& F, const void* res_, const bf16* f, void* out_, bf16* u, int s_post, int s_pre, float rw) {
    const float* res = (const float*)res_; const bf16* resb = (const bf16*)res_; float* out = (float*)out_; bf16* outb = (bf16*)out_;
    constexpr int R = 4;
    const float* ada = (const float*)(a.ws + WS_ADA); const float* gains = a.in[I_GAINS];
    const int gw = F.vcu * NWAVES + F.wave, NGW = F.G * NWAVES;
    for (int row0 = gw * R; row0 < T; row0 += NGW * R) {
        const int b = row0 >> 12;
        f32x4 h[R][4]; v2u fw[R][4];
#pragma unroll
        for (int r = 0; r < R; ++r)
#pragma unroll
            for (int j = 0; j < 4; ++j) { if (RES_BF) { const v2u w = *(const v2u*)(resb + (size_t)(row0 + r) * DM + 256 * j + 4 * F.lane); h[r][j] = (f32x4){bflo(w.x), bfhi(w.x), bflo(w.y), bfhi(w.y)}; }
                else h[r][j] = *(const f32x4*)(res + (size_t)(row0 + r) * DM + 256 * j + 4 * F.lane);
                if (MODE != 0) fw[r][j] = *(const v2u*)(f + (size_t)(row0 + r) * DM + 256 * j + 4 * F.lane); }
        if (MODE != 0) {
            const float* gp = gains + (2 * s_post + 1) * DM; const float* gt = ada + (size_t)b * 9216 + (s_post * 3 + 2) * DM;
            f32x4 g4[4], t4[4];
#pragma unroll
            for (int j = 0; j < 4; ++j) { g4[j] = *(const f32x4*)(gp + 256 * j + 4 * F.lane); t4[j] = *(const f32x4*)(gt + 256 * j + 4 * F.lane) * rw; }
#pragma unroll
            for (int r = 0; r < R; ++r) { f32x4 fv[4]; float ss = 0.f;
#pragma unroll
                for (int j = 0; j < 4; ++j) { const v2u w = fw[r][j]; fv[j] = (f32x4){bflo(w.x), bfhi(w.x), bflo(w.y), bfhi(w.y)};
                    ss += fv[j][0] * fv[j][0] + fv[j][1] * fv[j][1] + fv[j][2] * fv[j][2] + fv[j][3] * fv[j][3]; }
                const float rstd = rsqrtf(wave_sum(ss) * (1.f / DM) + EPS);
#pragma unroll
                for (int j = 0; j < 4; ++j) { h[r][j] = h[r][j] + t4[j] * (fv[j] * rstd * g4[j]);
                    if (OUT_BF) { v2u w; w.x = pk2(h[r][j][0], h[r][j][1]); w.y = pk2(h[r][j][2], h[r][j][3]); *(v2u*)(outb + (size_t)(row0 + r) * DM + 256 * j + 4 * F.lane) = w; }
                    else *(f32x4*)(out + (size_t)(row0 + r) * DM + 256 * j + 4 * F.lane) = h[r][j]; } }
        }
        if (MODE != 2) {
            const float* gp = gains + (2 * s_pre) * DM; const float* sh = ada + (size_t)b * 9216 + (s_pre * 3 + 0) * DM; const float* sc = sh + DM;
            f32x4 g4[4], s4[4], c4[4];
#pragma unroll
            for (int j = 0; j < 4; ++j) { g4[j] = *(const f32x4*)(gp + 256 * j + 4 * F.lane); s4[j] = *(const f32x4*)(sh + 256 * j + 4 * F.lane); c4[j] = 1.f + *(const f32x4*)(sc + 256 * j + 4 * F.lane); }
#pragma unroll
            for (int r = 0; r < R; ++r) { float ss = 0.f;
#pragma unroll
                for (int j = 0; j < 4; ++j) ss += h[r][j][0] * h[r][j][0] + h[r][j][1] * h[r][j][1] + h[r][j][2] * h[r][j][2] + h[r][j][3] * h[r][j][3];
                const float rstd = rsqrtf(wave_sum(ss) * (1.f / DM) + EPS);
                if (U_I8) { f32x4 y[4]; float am = 0.f;
#pragma unroll
                    for (int j = 0; j < 4; ++j) { y[j] = (h[r][j] * rstd * g4[j]) * c4[j] + s4[j]; am = fmaxf(am, fmaxf(fmaxf(fabsf(y[j][0]), fabsf(y[j][1])), fmaxf(fabsf(y[j][2]), fabsf(y[j][3])))); }
                    am = wave_max(am); const float sc_ = am > 0.f ? am * (1.f / 127.f) : 1.f, inv = 1.f / sc_;
                    if (F.lane == 0) ((float*)(a.ws + WS_RS))[row0 + r] = sc_;
#pragma unroll
                    for (int j = 0; j < 4; ++j) { const int q0 = (int)rintf(y[j][0] * inv), q1 = (int)rintf(y[j][1] * inv), q2 = (int)rintf(y[j][2] * inv), q3 = (int)rintf(y[j][3] * inv);
                        *(unsigned*)((unsigned char*)u + (size_t)(row0 + r) * DM + 256 * j + 4 * F.lane) = (unsigned)(q0 & 255) | ((unsigned)(q1 & 255) << 8) | ((unsigned)(q2 & 255) << 16) | ((unsigned)(q3 & 255) << 24); } }
                else
#pragma unroll
                for (int j = 0; j < 4; ++j) { const f32x4 y = (h[r][j] * rstd * g4[j]) * c4[j] + s4[j];
                    v2u w; w.x = pk2(y[0], y[1]); w.y = pk2(y[2], y[3]);
                    *(v2u*)(u + (size_t)(row0 + r) * DM + 256 * j + 4 * F.lane) = w; } }
        }
    }
}

constexpr int MQ_OFF = 0, MK_OFF = 64 * 129 * 4, MV_OFF = 2 * 64 * 129 * 4, MS_OFF = 3 * 64 * 129 * 4, MCT_OFF = MS_OFF + 64 * 65 * 4, MVEC_OFF = MCT_OFF + 128 * 130 * 2;
static_assert(MVEC_OFF + 8 * 256 <= MISC_OFF, "mlstm lds");
template <bool WANTQ> __device__ __forceinline__ void mlstm_load_chunk(const Args& a, Frame& F, int b, int h, int c) {
    unsigned char* rc = a.ws + WS_RC;
    const bf16* qm = (const bf16*)(rc + RC_QM); const bf16* km = (const bf16*)(rc + RC_KM); const bf16* vm = (const bf16*)(rc + RC_VM); const float* ifm = (const float*)(rc + RC_IF);
    LAS float* Qs = (LAS float*)(F.lds + MQ_OFF); LAS float* Ks = (LAS float*)(F.lds + MK_OFF); LAS float* Vs = (LAS float*)(F.lds + MV_OFF);
    LAS float* bcum = (LAS float*)(F.lds + MVEC_OFF); LAS float* ig = bcum + 64;
    const int t0 = c * CHUNK; const size_t row0 = (size_t)b * SEQ + t0;
    if (F.tid < 64) { const float* g = ifm + (row0 + F.tid) * 8; const float fp = g[4 + h] + a.in[I_GATEB][4 + h];
        ig[F.tid] = g[h] + a.in[I_GATEB][h];
        bcum[F.tid] = fminf(fp, 0.f) - log1pf(__expf(-fabsf(fp))); }
    __syncthreads();
    if (F.tid == 0) { float s = 0.f; for (int i = 0; i < 64; ++i) { s += bcum[i]; bcum[i] = s; } }
    const float* cw = a.in[I_CONVW]; const float* cb = a.in[I_CONVB];
    for (int idx = F.tid; idx < 64 * 128; idx += NTHREADS) { const int t = idx >> 7, d = idx & 127, ch = h * 128 + d;
        float accq = cb[ch], acck = cb[512 + ch];
#pragma unroll
        for (int j = 0; j < 4; ++j) { const int tt = t0 + t - 3 + j; if (tt >= 0) { const size_t r = (size_t)b * SEQ + tt;
                if (WANTQ) accq += cw[j * 1024 + ch] * bf2f(qm[r * 512 + ch]);
                acck += cw[j * 1024 + 512 + ch] * bf2f(km[r * 512 + ch]); } }
        if (WANTQ) Qs[t * 129 + d] = siluf_(accq);
        Ks[t * 129 + d] = siluf_(acck) * 0.08838834764831845f;
        Vs[t * 129 + d] = bf2f(vm[(row0 + t) * 512 + ch]); }
    __syncthreads();
}
__device__ __forceinline__ void mlstm_local_unit(const Args& a, Frame& F, int unit) {
    const int c = unit & 63, h = (unit >> 6) & 3, b = unit >> 8;
    mlstm_load_chunk<false>(a, F, b, h, c);
    LAS float* Ks = (LAS float*)(F.lds + MK_OFF); LAS float* Vs = (LAS float*)(F.lds + MV_OFF);
    LAS float* bcum = (LAS float*)(F.lds + MVEC_OFF); LAS float* ig = bcum + 64; LAS float* wv = bcum + 128;
    const float blast = bcum[63];
    float g = -1e30f; if (F.tid < 64) g = blast - bcum[F.tid] + ig[F.tid];
    float mloc = 0.f;
    if (F.wave == 0) { mloc = wave_max(g); wv[F.tid] = __expf(g - mloc); if (F.tid == 0) { float* cs = (float*)(a.ws + WS_CSC) + (size_t)unit * 2; cs[0] = blast; cs[1] = mloc; } }
    __syncthreads();
    const int e = F.tid >> 2, dq = (F.tid & 3) * 32;
    float acc[32];
#pragma unroll
    for (int i = 0; i < 32; ++i) acc[i] = 0.f;
    for (int s = 0; s < 64; ++s) { const float vv = Vs[s * 129 + e] * wv[s];
#pragma unroll
        for (int i = 0; i < 32; ++i) acc[i] += vv * Ks[s * 129 + dq + i]; }
    bf16* st = (bf16*)(a.ws + WS_RB) + (size_t)unit * 16384 + e * 128 + dq;
#pragma unroll
    for (int i = 0; i < 32; i += 8) { v4u w; w.x = pk2(acc[i], acc[i + 1]); w.y = pk2(acc[i + 2], acc[i + 3]); w.z = pk2(acc[i + 4], acc[i + 5]); w.w = pk2(acc[i + 6], acc[i + 7]); *(v4u*)(st + i) = w; }
    if (F.tid < 128) { float s = 0.f; for (int t = 0; t < 64; ++t) s += wv[t] * Ks[t * 129 + F.tid]; ((float*)(a.ws + WS_NST))[(size_t)unit * 128 + F.tid] = s; }
    __syncthreads();
}
__device__ __forceinline__ void mlstm_scan(const Args& a, Frame& F) {
    const float* csc = (const float*)(a.ws + WS_CSC); float* mprev = (float*)(a.ws + WS_MPREV);
    bf16* st = (bf16*)(a.ws + WS_RB); float* nst = (float*)(a.ws + WS_NST);
    const int gt = F.vcu * NTHREADS + F.tid, NGT = F.G * NTHREADS;
    LAS float* tab = (LAS float*)F.lds;
    for (int idx = gt; idx < 64 * 2048; idx += NGT) { const int bh = idx >> 11, p = idx & 2047;
        __syncthreads();
        if (F.tid == 0) { float m = 0.f; for (int c = 0; c < 64; ++c) { const float bl = csc[(bh * 64 + c) * 2], ml = csc[(bh * 64 + c) * 2 + 1]; const float mn = fmaxf(bl + m, ml); tab[2 * c] = __expf(bl + m - mn); tab[2 * c + 1] = __expf(ml - mn); m = mn; } }
        __syncthreads();
        float cv[8];
#pragma unroll
        for (int i = 0; i < 8; ++i) cv[i] = 0.f;
        v4u* base = (v4u*)(st + (size_t)(bh * 64) * 16384) + p;
#pragma unroll 1
        for (int c0 = 0; c0 < 64; c0 += 8) { v4u uw[8];
#pragma unroll
            for (int k = 0; k < 8; ++k) uw[k] = base[(size_t)(c0 + k) * 2048];
#pragma unroll
            for (int k = 0; k < 8; ++k) { const int c = c0 + k;
                v4u o; o.x = pk2(cv[0], cv[1]); o.y = pk2(cv[2], cv[3]); o.z = pk2(cv[4], cv[5]); o.w = pk2(cv[6], cv[7]); base[(size_t)c * 2048] = o;
                const float dec = tab[2 * c], sc = tab[2 * c + 1];
                float x[8]; unpack8(uw[k], x);
#pragma unroll
                for (int i = 0; i < 8; ++i) cv[i] = dec * cv[i] + sc * x[i]; } } }
    __syncthreads();
    for (int idx = gt; idx < 64 * 128; idx += NGT) { const int bh = idx >> 7, d = idx & 127;
        float m = 0.f, n = 0.f;
        float* base = nst + (size_t)(bh * 64) * 128 + d;
#pragma unroll 1
        for (int c0 = 0; c0 < 64; c0 += 16) { float nl[16];
#pragma unroll
            for (int k = 0; k < 16; ++k) nl[k] = base[(size_t)(c0 + k) * 128];
#pragma unroll
            for (int k = 0; k < 16; ++k) { const int c = c0 + k; base[(size_t)c * 128] = n;
                if (d == 0) mprev[bh * 64 + c] = m;
                const float bl = csc[(bh * 64 + c) * 2], ml = csc[(bh * 64 + c) * 2 + 1];
                const float mn = fmaxf(bl + m, ml), dec = __expf(bl + m - mn), sc = __expf(ml - mn);
                n = dec * n + sc * nl[k]; m = mn; } } }
}
__device__ __forceinline__ void mlstm_out_unit(const Args& a, Frame& F, int unit) {
    const int c = unit & 63, h = (unit >> 6) & 3, b = unit >> 8;
    mlstm_load_chunk<true>(a, F, b, h, c);
    LAS float* Qs = (LAS float*)(F.lds + MQ_OFF); LAS float* Ks = (LAS float*)(F.lds + MK_OFF); LAS float* Vs = (LAS float*)(F.lds + MV_OFF); LAS float* Ss = (LAS float*)(F.lds + MS_OFF);
    LAS bf16* CT = (LAS bf16*)(F.lds + MCT_OFF);
    LAS float* bcum = (LAS float*)(F.lds + MVEC_OFF); LAS float* ig = bcum + 64; LAS float* mt = bcum + 128; LAS float* wi = bcum + 192; LAS float* den = bcum + 256; LAS float* nv = bcum + 320;
    const float mp = ((const float*)(a.ws + WS_MPREV))[unit];
    const bf16* ctg = (const bf16*)(a.ws + WS_RB) + (size_t)unit * 16384;
    for (int idx = F.tid; idx < 128 * 64; idx += NTHREADS) { const int e = idx >> 6, dp = idx & 63; *(LAS unsigned*)(CT + e * 130 + 2 * dp) = *(const unsigned*)(ctg + e * 128 + 2 * dp); }
    if (F.tid < 128) nv[F.tid] = ((const float*)(a.ws + WS_NST))[(size_t)unit * 128 + F.tid];
    if (F.tid < 64) { const int t = F.tid; const float bt = bcum[t], at = bt + mp; float mm = at;
        for (int s = 0; s <= t; ++s) mm = fmaxf(mm, bt - bcum[s] + ig[s]);
        mt[t] = mm; wi[t] = __expf(at - mm); }
    __syncthreads();
    { const int s = F.tid & 63, tb = (F.tid >> 6) * 8;
#pragma unroll
        for (int i = 0; i < 8; ++i) { const int t = tb + i; float v = 0.f;
            if (s <= t) { float d = 0.f; for (int k = 0; k < 128; ++k) d += Qs[t * 129 + k] * Ks[s * 129 + k]; v = d * __expf(bcum[t] - bcum[s] + ig[s] - mt[t]); }
            Ss[t * 65 + s] = v; } }
    __syncthreads();
    if (F.tid < 64) { const int t = F.tid; float sd = 0.f; for (int s = 0; s <= t; ++s) sd += Ss[t * 65 + s]; float qn = 0.f; for (int k = 0; k < 128; ++k) qn += Qs[t * 129 + k] * nv[k];
        den[t] = sd + wi[t] * qn; }
    const int t = F.tid >> 3, e0 = (F.tid & 7) * 16;
    float num[16], qc[16];
#pragma unroll
    for (int i = 0; i < 16; ++i) { num[i] = 0.f; qc[i] = 0.f; }
    for (int s = 0; s <= t; ++s) { const float sv = Ss[t * 65 + s];
#pragma unroll
        for (int i = 0; i < 16; ++i) num[i] += sv * Vs[s * 129 + e0 + i]; }
    for (int k = 0; k < 128; ++k) { const float qv = Qs[t * 129 + k];
#pragma unroll
        for (int i = 0; i < 16; ++i) qc[i] += qv * bf2f(CT[(e0 + i) * 130 + k]); }
    __syncthreads();
    const float dn = fmaxf(fabsf(den[t]), __expf(-mt[t])), wt = wi[t];
    float ss = 0.f;
#pragma unroll
    for (int i = 0; i < 16; ++i) { num[i] = (num[i] + wt * qc[i]) / dn; ss += num[i] * num[i]; }
    ss += __shfl_xor(ss, 1); ss += __shfl_xor(ss, 2); ss += __shfl_xor(ss, 4);
    const float rstd = rsqrtf(ss * (1.f / 128.f) + EPS);
    const size_t row = (size_t)b * SEQ + c * CHUNK + t; const int ch = h * 128 + e0;
    const bf16* om = (const bf16*)(a.ws + WS_RC + RC_OM) + row * 512 + ch; const float* hg = a.in[I_HGAIN] + ch;
    float o[16];
#pragma unroll
    for (int i = 0; i < 16; ++i) o[i] = sigmoidf_(bf2f(om[i])) * num[i] * rstd * hg[i];
    bf16* hm = (bf16*)(a.ws + WS_RA) + row * 1024 + ch;
#pragma unroll
    for (int i = 0; i < 16; i += 8) { v4u w; w.x = pk2(o[i], o[i + 1]); w.y = pk2(o[i + 2], o[i + 3]); w.z = pk2(o[i + 4], o[i + 5]); w.w = pk2(o[i + 6], o[i + 7]); *(v4u*)(hm + i) = w; }
    __syncthreads();
}

__device__ __forceinline__ void compress_l2(const Args& a, Frame& F) {
    LAS float* hid = (LAS float*)(F.lds + F.wave * 4096);
    const int gw = F.vcu * NWAVES + F.wave, NGW = F.G * NWAVES;
    for (int kv = 0; kv < 2; ++kv) {
        const float* P = (const float*)(a.ws + WS_RA) + (size_t)kv * 8192 * 512; const float* b1p = (const float*)(a.ws + WS_B1P) + kv * 16 * 256;
        const float* w2 = a.in[I_CW2] + (size_t)kv * 256 * 64; bf16* outp = (bf16*)(a.ws + WS_KCMP) + (size_t)kv * 8192 * 64;
        for (int r0 = gw; r0 < 8192; r0 += 4 * NGW) {
            float pv[4][8];
#pragma unroll
            for (int q = 0; q < 4; ++q) { const int m0 = r0 + q * NGW; const bool ok = m0 < 8192 && (m0 & 255) != NCMP;
#pragma unroll
                for (int jj = 0; jj < 4; ++jj) { const int cc = jj * 64 + F.lane; pv[q][2 * jj] = ok ? P[(size_t)m0 * 512 + cc] : 0.f; pv[q][2 * jj + 1] = ok ? P[(size_t)(m0 + 1) * 512 + 256 + cc] : 0.f; } }
            float bb[4];
#pragma unroll
            for (int jj = 0; jj < 4; ++jj) { float t = a.in[I_CB1][kv * 256 + jj * 64 + F.lane];
#pragma unroll
                for (int pt = 0; pt < 16; ++pt) t += b1p[pt * 256 + jj * 64 + F.lane];
                bb[jj] = t; }
#pragma unroll
            for (int q = 0; q < 4; ++q)
#pragma unroll
                for (int jj = 0; jj < 4; ++jj) hid[q * 256 + jj * 64 + F.lane] = siluf_(pv[q][2 * jj] + pv[q][2 * jj + 1] + bb[jj]);
            LDS_WAIT();
            float sacc[4]; const float b2 = a.in[I_CB2][kv * 64 + F.lane];
#pragma unroll
            for (int q = 0; q < 4; ++q) sacc[q] = b2;
#pragma unroll 1
            for (int c0 = 0; c0 < 256; c0 += 32) { float wv[32];
#pragma unroll
                for (int i = 0; i < 32; ++i) wv[i] = w2[(c0 + i) * 64 + F.lane];
#pragma unroll
                for (int i = 0; i < 32; ++i)
#pragma unroll
                    for (int q = 0; q < 4; ++q) sacc[q] += hid[q * 256 + c0 + i] * wv[i]; }
#pragma unroll
            for (int q = 0; q < 4; ++q) { const int m0 = r0 + q * NGW; if (m0 < 8192) outp[(size_t)m0 * 64 + F.lane] = ((m0 & 255) == NCMP) ? (bf16)0 : (bf16)f2bf(sacc[q]); }
            LDS_WAIT();
        }
    }
}

struct AttState { float m[4], l[4], o[4]; };
__device__ __forceinline__ void nsa_dot4(const bf16* krow, const LAS float* qs, float (&s)[4]) {
    s[0] = s[1] = s[2] = s[3] = 0.f;
#pragma unroll
    for (int c8 = 0; c8 < 8; ++c8) { const v4u kw = *(const v4u*)(krow + c8 * 8);
        float kf[8] = {bflo(kw.x), bfhi(kw.x), bflo(kw.y), bfhi(kw.y), bflo(kw.z), bfhi(kw.z), bflo(kw.w), bfhi(kw.w)};
#pragma unroll
        for (int h = 0; h < 4; ++h)
#pragma unroll
            for (int i = 0; i < 8; ++i) s[h] += kf[i] * qs[h * 64 + c8 * 8 + i]; }
}
__device__ __forceinline__ void nsa_attend(AttState& A, const bf16* Kb, const bf16* Vb, int base, int t, const LAS float* qs, LAS float* pl, int lane) {
    const int pos = base + lane; const bool valid = pos >= 0 && pos <= t;
    float s[4] = {0.f, 0.f, 0.f, 0.f};
    if (valid) nsa_dot4(Kb + (size_t)pos * 64, qs, s);
#pragma unroll
    for (int h = 0; h < 4; ++h) { const float mb = wave_max(valid ? s[h] : -1e30f), mn = fmaxf(A.m[h], mb), al = __expf(A.m[h] - mn), p = valid ? __expf(s[h] - mn) : 0.f;
        A.l[h] = A.l[h] * al + wave_sum(p); A.o[h] *= al; A.m[h] = mn; pl[h * 64 + lane] = p; }
    LDS_WAIT();
    const int k0 = base < 0 ? -base : 0, k1 = (t - base) < 63 ? (t - base) : 63;
    for (int kk = k0; kk <= k1; ++kk) { const float v = bf2f(Vb[(size_t)(base + kk) * 64 + lane]);
#pragma unroll
        for (int h = 0; h < 4; ++h) A.o[h] += pl[h * 64 + kk] * v; }
    LDS_WAIT();
}
__device__ __forceinline__ void nsa_query(const Args& a, Frame& F, int qid, LAS float* wl) {
    const int t = qid & 4095, g = (qid >> 12) & 1, b = qid >> 13, bg = b * 2 + g, lane = F.lane;
    const size_t row = (size_t)b * SEQ + t;
    unsigned char* rc = a.ws + WS_RC;
    LAS float* qs = wl; LAS float* pc = wl + 256; LAS float* ps = wl + 512; LAS float* pl = wl + 768;
    const bf16* qn = (const bf16*)(rc + RC_QN) + row * 512 + g * 256;
#pragma unroll
    for (int h = 0; h < 4; ++h) qs[h * 64 + lane] = bf2f(qn[h * 64 + lane]) * 0.6931471805599453f;
    const float* gg = (const float*)(rc + RC_GG) + row * 24 + g * 12;
    float gate[4][3];
#pragma unroll
    for (int h = 0; h < 4; ++h)
#pragma unroll
        for (int r = 0; r < 3; ++r) gate[h][r] = sigmoidf_(gg[h * 3 + r]);
    LDS_WAIT();
    const bf16* kc = (const bf16*)(a.ws + WS_KCMP) + (size_t)bg * 256 * 64; const bf16* vc = kc + (size_t)32 * 256 * 64;
    const int nvalid = t >= 31 ? ((t - 31) >> 4) + 1 : 0;
    float sc[4][4];
#pragma unroll
    for (int kk = 0; kk < 4; ++kk) { const int n = kk * 64 + lane; float s[4] = {0.f, 0.f, 0.f, 0.f}; if (n < nvalid) nsa_dot4(kc + (size_t)n * 64, qs, s);
#pragma unroll
        for (int h = 0; h < 4; ++h) sc[h][kk] = s[h]; }
    float psum[4] = {0.f, 0.f, 0.f, 0.f}, ocmp[4];
#pragma unroll
    for (int h = 0; h < 4; ++h) { float mx = -1e30f;
#pragma unroll
        for (int kk = 0; kk < 4; ++kk) if (kk * 64 + lane < nvalid) mx = fmaxf(mx, sc[h][kk]);
        mx = wave_max(mx); float e[4], l = 0.f;
#pragma unroll
        for (int kk = 0; kk < 4; ++kk) { e[kk] = (kk * 64 + lane < nvalid) ? __expf(sc[h][kk] - mx) : 0.f; l += e[kk]; }
        l = fmaxf(wave_sum(l), 1e-30f);
#pragma unroll
        for (int kk = 0; kk < 4; ++kk) { const float p = e[kk] / l; psum[kk] += p; pc[kk * 64 + lane] = p; }
        LDS_WAIT();
        float o = 0.f; for (int n = 0; n < nvalid; ++n) o += pc[n] * bf2f(vc[(size_t)n * 64 + lane]);
        ocmp[h] = o; LDS_WAIT(); }
#pragma unroll
    for (int kk = 0; kk < 4; ++kk) ps[kk * 64 + lane] = psum[kk];
    LDS_WAIT();
    const int cur = t >> 6;
    float imp = 0.f;
#pragma unroll
    for (int i = -1; i <= 3; ++i) { const int n = 4 * lane + i; if (n >= 0 && n < NCMP) imp += ps[n]; }
    const bool forced = (lane == 0) || (lane == cur) || (lane == cur - 1);
    const float val = (lane <= cur) ? (forced ? 1e4f : imp) : -1.f;
    int rank = 0;
    for (int i = 0; i < 64; ++i) { const float vi = __shfl(val, i); rank += (vi > val || (vi == val && i < lane)) ? 1 : 0; }
    const unsigned long long mask = __ballot(rank < 16);
    AttState S;
#pragma unroll
    for (int h = 0; h < 4; ++h) { S.m[h] = -1e30f; S.l[h] = 0.f; S.o[h] = 0.f; }
    const bf16* ks = (const bf16*)(rc + RC_KV + 2 * 16 * MiB) + (size_t)bg * 4096 * 64; const bf16* vs = (const bf16*)(rc + RC_KV + 3 * 16 * MiB) + (size_t)bg * 4096 * 64;
    for (int j = 0; j <= cur; ++j) if ((mask >> j) & 1ull) nsa_attend(S, ks, vs, 64 * j, t, qs, pl, lane);
    AttState W;
#pragma unroll
    for (int h = 0; h < 4; ++h) { W.m[h] = -1e30f; W.l[h] = 0.f; W.o[h] = 0.f; }
    const bf16* kw = (const bf16*)(rc + RC_KV + 4 * 16 * MiB) + (size_t)bg * 4096 * 64; const bf16* vw = (const bf16*)(rc + RC_KV + 5 * 16 * MiB) + (size_t)bg * 4096 * 64;
    for (int kk = 0; kk < 4; ++kk) { const int base = t - 255 + 64 * kk; if (base + 63 >= 0) nsa_attend(W, kw, vw, base, t, qs, pl, lane); }
    bf16* outp = (bf16*)(a.ws + WS_RA) + row * 1024 + 512 + g * 256;
#pragma unroll
    for (int h = 0; h < 4; ++h) { const float o = gate[h][0] * ocmp[h] + gate[h][1] * S.o[h] / fmaxf(S.l[h], 1e-30f) + gate[h][2] * W.o[h] / fmaxf(W.l[h], 1e-30f);
        outp[h * 64 + lane] = (bf16)f2bf(o); }
}

typedef float f32x16 __attribute__((ext_vector_type(16)));
typedef short s16x4 __attribute__((ext_vector_type(4)));
typedef float f32x2_t __attribute__((ext_vector_type(2))); typedef __bf16 bf16x2_t __attribute__((ext_vector_type(2)));
constexpr int NKS = 144, NVS = 192;
constexpr int NK_OFF = 0, NKBUF = 64 * NKS, NV_OFF = 4 * NKBUF, NVBUF = 64 * NVS, NPSW = 8 * 260, NPS_OFF = NV_OFF + 4 * NVBUF, NMASK_OFF = NPS_OFF + 8 * NPSW * 4, NWS_OFF = NMASK_OFF + 512, NSA_LDS_END = NWS_OFF + 8 * 256;
static_assert(NSA_LDS_END <= MISC_OFF, "nsa lds");
constexpr float L2E = 1.4426950408889634f;
__device__ __forceinline__ int crow(int r, int hi) { return (r & 3) + 8 * (r >> 2) + 4 * hi; }
__device__ __forceinline__ unsigned cvtpk(float lo, float hi) { f32x2_t v = {lo, hi}; bf16x2_t b = __builtin_convertvector(v, bf16x2_t); return __builtin_bit_cast(unsigned, b); }
__device__ __forceinline__ float max3f(float a, float b, float c) { float r; asm("v_max3_f32 %0, %1, %2, %3" : "=v"(r) : "v"(a), "v"(b), "v"(c)); return r; }
template <int CTRL> __device__ __forceinline__ float dpp_quad(float v) { return __builtin_bit_cast(float, __builtin_amdgcn_update_dpp(0, __builtin_bit_cast(int, v), CTRL, 0xF, 0xF, true)); }
__device__ __forceinline__ float swapmax(float v) { auto rr = __builtin_amdgcn_permlane32_swap(__float_as_uint(v), __float_as_uint(v), false, false); return fmaxf(__uint_as_float(rr[0]), __uint_as_float(rr[1])); }
__device__ __forceinline__ float swapsum(float v) { auto rr = __builtin_amdgcn_permlane32_swap(__float_as_uint(v), __float_as_uint(v), false, false); return __uint_as_float(rr[0]) + __uint_as_float(rr[1]); }
__device__ __forceinline__ s16x4 vtr(const LAS unsigned char* p) { typedef short v4i16_t __attribute__((ext_vector_type(4))); return __builtin_bit_cast(s16x4, __builtin_amdgcn_ds_read_tr16_b64_v4i16((LAS v4i16_t*)p)); }
__device__ __forceinline__ void nsa_qk(f32x16& p0, f32x16& p1, const LAS unsigned char* kb, const bf16x8 (&qr)[4], const f32x16& cinit, int r32, int hi) {
    const LAS unsigned char* kp = kb + r32 * NKS + hi * 16;
    bf16x8 kf[8];
#pragma unroll
    for (int d0 = 0; d0 < 4; ++d0) { kf[2 * d0] = *(const LAS bf16x8*)(kp + d0 * 32); kf[2 * d0 + 1] = *(const LAS bf16x8*)(kp + 32 * NKS + d0 * 32); }
    __builtin_amdgcn_sched_barrier(0);
    p0 = __builtin_amdgcn_mfma_f32_32x32x16_bf16(kf[0], qr[0], cinit, 0, 0, 0); p1 = __builtin_amdgcn_mfma_f32_32x32x16_bf16(kf[1], qr[0], cinit, 0, 0, 0);
#pragma unroll
    for (int d0 = 1; d0 < 4; ++d0) { p0 = __builtin_amdgcn_mfma_f32_32x32x16_bf16(kf[2 * d0], qr[d0], p0, 0, 0, 0); p1 = __builtin_amdgcn_mfma_f32_32x32x16_bf16(kf[2 * d0 + 1], qr[d0], p1, 0, 0, 0); }
}
__device__ __forceinline__ void nsa_vload(bf16x8 (&vf)[4], const LAS unsigned char* vb, int lane, int d0) {
    const int hi = lane >> 5, blk = (lane >> 4) & 1, q = (lane & 15) >> 2, p = lane & 3;
    const LAS unsigned char* base = vb + (4 * hi + q) * NVS + (16 * blk + 4 * p) * 2 + d0 * 64;
#pragma unroll
    for (int ks = 0; ks < 4; ++ks) { const s16x4 lo = vtr(base + (ks * 16) * NVS), hh = vtr(base + (ks * 16 + 8) * NVS);
        vf[ks] = (bf16x8){lo[0], lo[1], lo[2], lo[3], hh[0], hh[1], hh[2], hh[3]}; }
}
__device__ __forceinline__ void nsa_pv(f32x16& o, const bf16x8 (&vf)[4], const bf16x8 (&pa)[4]) {
#pragma unroll
    for (int ks = 0; ks < 4; ++ks) o = __builtin_amdgcn_mfma_f32_32x32x16_bf16(pa[ks], vf[ks], o, 0, 0, 0);
}
__device__ __forceinline__ void nsa_pack(bf16x8 (&pa)[4], const f32x16& p0, const f32x16& p1) {
    v4u w;
    w.x = cvtpk(p0[0], p0[1]); w.y = cvtpk(p0[2], p0[3]); w.z = cvtpk(p0[4], p0[5]); w.w = cvtpk(p0[6], p0[7]); pa[0] = __builtin_bit_cast(bf16x8, w);
    w.x = cvtpk(p0[8], p0[9]); w.y = cvtpk(p0[10], p0[11]); w.z = cvtpk(p0[12], p0[13]); w.w = cvtpk(p0[14], p0[15]); pa[1] = __builtin_bit_cast(bf16x8, w);
    w.x = cvtpk(p1[0], p1[1]); w.y = cvtpk(p1[2], p1[3]); w.z = cvtpk(p1[4], p1[5]); w.w = cvtpk(p1[6], p1[7]); pa[2] = __builtin_bit_cast(bf16x8, w);
    w.x = cvtpk(p1[8], p1[9]); w.y = cvtpk(p1[10], p1[11]); w.z = cvtpk(p1[12], p1[13]); w.w = cvtpk(p1[14], p1[15]); pa[3] = __builtin_bit_cast(bf16x8, w);
}
__device__ __forceinline__ void row_bcast(float v, LAS float* wsf, int r32, int hi, float (&f)[16]) {
    if (hi == 0) wsf[r32] = v;
#pragma unroll
    for (int r = 0; r < 16; ++r) f[r] = wsf[crow(r, hi)];
}
constexpr float NSA_THR = 5.f;
__device__ __forceinline__ void nsa_step(const int VAR, f32x16& p0, f32x16& p1, float& mhat, f32x16& negm, f32x16 (&o)[2], f32x16& ol, int diag, bool rowvalid, bool allvalid, int rel, const LAS unsigned char* vb, LAS float* wsf, int lane, int r32, int hi) {
    bf16x8 vf[4]; nsa_vload(vf, vb, lane, 0);
    __builtin_amdgcn_sched_barrier(0);
    asm volatile("s_nop 15\n\ts_nop 7" : "+v"(p0), "+v"(p1));
    if (diag == 1) {
#pragma unroll
        for (int r = 0; r < 16; ++r) { const int kv = crow(r, hi); p0[r] = kv <= rel ? p0[r] : -INFINITY; p1[r] = kv + 32 <= rel ? p1[r] : -INFINITY; }
    } else if (diag == 2) {
#pragma unroll
        for (int r = 0; r < 16; ++r) { const int kv = crow(r, hi); p0[r] = kv > rel ? p0[r] : -INFINITY; p1[r] = kv + 32 > rel ? p1[r] : -INFINITY; }
    }
    float mx = max3f(p0[0], p1[0], -INFINITY);
#pragma unroll
    for (int r = 1; r < 16; ++r) mx = max3f(mx, p0[r], p1[r]);
    mx = rowvalid ? mx : -INFINITY;
    mx = swapmax(mx);
    if (__any(mx > NSA_THR)) {
        const float dl = fmaxf(mx, 0.f); mhat += dl;
#pragma unroll
        for (int r = 0; r < 16; ++r) { p0[r] -= dl; p1[r] -= dl; negm[r] = -mhat; }
        float f[16]; row_bcast(__builtin_amdgcn_exp2f(-dl), wsf, r32, hi, f);
#pragma unroll
        for (int r = 0; r < 16; ++r) { o[0][r] *= f[r]; o[1][r] *= f[r]; ol[r] *= f[r]; } }
#pragma unroll
    for (int r = 0; r < 16; ++r) { if (VAR == 2) { p0[r] += 1.f; p1[r] += 1.f; } else { p0[r] = __builtin_amdgcn_exp2f(p0[r]); p1[r] = __builtin_amdgcn_exp2f(p1[r]); } }
    bf16x8 pa[4]; nsa_pack(pa, p0, p1);
    if (!allvalid) { const short km = rowvalid ? (short)-1 : (short)0;
#pragma unroll
        for (int k = 0; k < 4; ++k) { v4u w = __builtin_bit_cast(v4u, pa[k]); const unsigned mk = rowvalid ? 0xffffffffu : 0u; w.x &= mk; w.y &= mk; w.z &= mk; w.w &= mk; pa[k] = __builtin_bit_cast(bf16x8, w); }
        (void)km; }
    __builtin_amdgcn_sched_barrier(0);
    if (VAR != 3) { bf16x8 vg[4]; nsa_vload(vg, vb, lane, 1);
        __builtin_amdgcn_sched_barrier(0);
        nsa_pv(o[0], vf, pa);
        const bf16x8 ones = (bf16x8){0x3f80, 0x3f80, 0x3f80, 0x3f80, 0x3f80, 0x3f80, 0x3f80, 0x3f80};
#pragma unroll
        for (int ks = 0; ks < 4; ++ks) ol = __builtin_amdgcn_mfma_f32_32x32x16_bf16(pa[ks], ones, ol, 0, 0, 0);
        nsa_pv(o[1], vg, pa); }
}
__device__ __forceinline__ void nsa_unit(const int VAR, const Args& a, Frame& F, int bg, int qt, bf16* outbase) {
    const int lane = F.lane, r32 = lane & 31, hi = lane >> 5, w = F.wave, tid = F.tid;
    const int qi = r32 >> 2, h = r32 & 3, t0 = qt * 64, rel = 8 * w + qi, t = t0 + rel, cur = qt, b = bg >> 1, g = bg & 1;
    const size_t row = (size_t)b * SEQ + t;
    unsigned char* rc = a.ws + WS_RC;
    LAS float* PS = (LAS float*)(F.lds + NPS_OFF) + w * NPSW;
    LAS unsigned long long* MASKS = (LAS unsigned long long*)(F.lds + NMASK_OFF);
    LAS float* wsf = (LAS float*)(F.lds + NWS_OFF) + w * 64;
    const int srow = tid >> 3, sch = tid & 7;
    v4u kreg, vreg;
#define NSA_LOADK(ptr) kreg = *(const v4u*)((ptr) + srow * 64 + sch * 8)
#define NSA_LOADV(ptr) vreg = *(const v4u*)((ptr) + srow * 64 + sch * 8)
#define NSA_STOREK(bi) *(LAS v4u*)(F.lds + NK_OFF + (bi) * NKBUF + srow * NKS + sch * 16) = kreg
#define NSA_STOREV(bi) *(LAS v4u*)(F.lds + NV_OFF + (bi) * NVBUF + srow * NVS + sch * 16) = vreg
#define NSA_KB(bi) (F.lds + NK_OFF + (bi) * NKBUF)
#define NSA_VB(bi) (F.lds + NV_OFF + (bi) * NVBUF)
    bf16x8 qr[4];
    { const bf16* qp = (const bf16*)(rc + RC_QN) + row * 512 + (g * 4 + h) * 64 + hi * 8;
#pragma unroll
      for (int d0 = 0; d0 < 4; ++d0) qr[d0] = *(const bf16x8*)(qp + d0 * 16); }
    float g0, g1, g2;
    { const float* gg = (const float*)(rc + RC_GG) + row * 24 + (g * 4 + h) * 3; g0 = sigmoidf_(gg[0]); g1 = sigmoidf_(gg[1]); g2 = sigmoidf_(gg[2]); }
    f32x16 o[2], p0, p1, ol, negm, zero16;
#pragma unroll
    for (int i = 0; i < 16; ++i) zero16[i] = 0.f;
    float f16[16];
    const bf16* kc = (const bf16*)(a.ws + WS_KCMP) + (size_t)bg * 256 * 64; const bf16* vc = kc + (size_t)32 * 256 * 64;
    const int nvmax = (t0 / 16 + 3) < 255 ? (t0 / 16 + 3) : 255, nb = (VAR == 7) ? 0 : ((nvmax + 63) >> 6);
    const int nv = t >= 31 ? ((t - 31) >> 4) + 1 : 0;
    float m = -1e30f, l = 0.f;
    { v4u ck[4], cv[4];
#pragma unroll
      for (int cb = 0; cb < 4; ++cb) if (cb < nb) { ck[cb] = *(const v4u*)(kc + cb * 4096 + srow * 64 + sch * 8); cv[cb] = *(const v4u*)(vc + cb * 4096 + srow * 64 + sch * 8); }
#pragma unroll
      for (int cb = 0; cb < 4; ++cb) if (cb < nb) { *(LAS v4u*)(F.lds + NK_OFF + cb * NKBUF + srow * NKS + sch * 16) = ck[cb]; *(LAS v4u*)(F.lds + NV_OFF + cb * NVBUF + srow * NVS + sch * 16) = cv[cb]; } }
#pragma unroll
    for (int i = 0; i < 9; ++i) { const int idx = i * 256 + lane * 4; if (idx < NPSW) *(LAS f32x4*)(PS + idx) = (f32x4){0.f, 0.f, 0.f, 0.f}; }
    __syncthreads();
#pragma unroll 1
    for (int cb = 0; cb < nb; ++cb) {
        nsa_qk(p0, p1, NSA_KB(cb), qr, zero16, r32, hi);
        float mx = -1e30f;
#pragma unroll
        for (int r = 0; r < 16; ++r) { const int n0 = cb * 64 + crow(r, hi); p0[r] = n0 < nv ? p0[r] : -1e30f; p1[r] = n0 + 32 < nv ? p1[r] : -1e30f; mx = fmaxf(mx, fmaxf(p0[r], p1[r])); }
        mx = swapmax(mx);
        const float mnew = fmaxf(m, mx); l *= __builtin_amdgcn_exp2f(m - mnew); m = mnew; const float nm = mnew < -1e29f ? 0.f : -mnew;
        float s = 0.f;
#pragma unroll
        for (int r = 0; r < 16; ++r) s += __builtin_amdgcn_exp2f(p0[r] + nm) + __builtin_amdgcn_exp2f(p1[r] + nm);
        l += s;
    }
    l = swapsum(l);
    const float inv_l = 1.f / l, nmc = m < -1e29f ? 0.f : -m;
#pragma unroll
    for (int i = 0; i < 16; ++i) { o[0][i] = 0.f; o[1][i] = 0.f; }
#pragma unroll 1
    for (int cb = 0; cb < nb; ++cb) {
        nsa_qk(p0, p1, NSA_KB(cb), qr, zero16, r32, hi);
#pragma unroll
        for (int r = 0; r < 16; ++r) { const int n0 = cb * 64 + crow(r, hi);
            p0[r] = n0 < nv ? __builtin_amdgcn_exp2f(p0[r] + nmc) * inv_l : 0.f; p1[r] = n0 + 32 < nv ? __builtin_amdgcn_exp2f(p1[r] + nmc) * inv_l : 0.f;
            float v0 = p0[r], v1 = p1[r]; v0 += dpp_quad<0xB1>(v0); v1 += dpp_quad<0xB1>(v1); v0 += dpp_quad<0x4E>(v0); v1 += dpp_quad<0x4E>(v1);
            if (h == 0) { PS[qi * 260 + n0] = v0; PS[qi * 260 + n0 + 32] = v1; } }
        bf16x8 pa[4]; nsa_pack(pa, p0, p1);
        { bf16x8 vf[4], vg[4]; nsa_vload(vf, NSA_VB(cb), lane, 0); nsa_vload(vg, NSA_VB(cb), lane, 1); __builtin_amdgcn_sched_barrier(0); nsa_pv(o[0], vf, pa); nsa_pv(o[1], vg, pa); }
    }
    if (cur >= 16) {
#pragma unroll 1
        for (int qq = 0; qq < 8; ++qq) { const LAS float* pq = PS + qq * 260;
            const f32x4 q4 = *(const LAS f32x4*)(pq + 4 * lane);
            float imp = (q4[0] + q4[1]) + (q4[2] + q4[3]); if (lane > 0) imp += pq[4 * lane - 1];
            const bool forced = (lane == 0) || (lane == cur) || (lane == cur - 1);
            const float val = (lane <= cur) ? (forced ? 1e4f : imp) : -1.f;
            wsf[lane] = val;
            int rank = 0;
#pragma unroll
            for (int i4 = 0; i4 < 16; ++i4) { const f32x4 v4 = *(const LAS f32x4*)(wsf + 4 * i4);
#pragma unroll
                for (int e = 0; e < 4; ++e) { const int i = 4 * i4 + e; rank += (v4[e] > val || (v4[e] == val && i < lane)) ? 1 : 0; } }
            const unsigned long long mk = __ballot(rank < 16);
            if (lane == 0) MASKS[w * 8 + qq] = mk; }
    } else { if (lane < 8) MASKS[w * 8 + lane] = (2ull << cur) - 1ull; }
    __syncthreads();
    const unsigned long long mym = MASKS[w * 8 + qi];
    unsigned long long um = MASKS[lane];
#pragma unroll
    for (int off = 1; off < 64; off <<= 1) { const unsigned lo_ = __shfl_xor((unsigned)um, off), hi_ = __shfl_xor((unsigned)(um >> 32), off); um |= ((unsigned long long)hi_ << 32) | lo_; }
    um &= (2ull << cur) - 1ull;
    unsigned long long rem = ((unsigned long long)__builtin_amdgcn_readfirstlane((unsigned)(um >> 32)) << 32) | (unsigned)__builtin_amdgcn_readfirstlane((unsigned)um);
    row_bcast(g0, wsf, r32, hi, f16);
#pragma unroll
    for (int r = 0; r < 16; ++r) { PS[(2 * r) * 64 + lane] = o[0][r] * f16[r]; PS[(2 * r + 1) * 64 + lane] = o[1][r] * f16[r]; }
    const bf16* ks = (const bf16*)(rc + RC_KV + 2 * 16 * MiB) + (size_t)bg * 4096 * 64; const bf16* vs = (const bf16*)(rc + RC_KV + 3 * 16 * MiB) + (size_t)bg * 4096 * 64;
    const bf16* kw = (const bf16*)(rc + RC_KV + 4 * 16 * MiB) + (size_t)bg * 4096 * 64; const bf16* vw = (const bf16*)(rc + RC_KV + 5 * 16 * MiB) + (size_t)bg * 4096 * 64;
    float mhat = 0.f;
#pragma unroll
    for (int i = 0; i < 16; ++i) { o[0][i] = 0.f; o[1][i] = 0.f; ol[i] = 0.f; negm[i] = 0.f; }
    {
        const int j0w = cur >= 4 ? cur - 4 : 0;
        if (VAR == 6) rem = 0ull;
        int jc = __builtin_ctzll(rem | (1ull << 63)), wc = (VAR == 6) ? 1 : 0, buf = 0; rem &= rem - 1ull; if (VAR == 6) jc = cur;
        NSA_LOADK(ks + (size_t)jc * 4096); NSA_LOADV(vs + (size_t)jc * 4096); NSA_STOREK(0); NSA_STOREV(0); __syncthreads();
#pragma unroll 1
        for (;;) {
            bool has_next = true; int jn, wn;
            if (wc == 0) { if (rem != 0ull) { jn = __builtin_ctzll(rem); rem &= rem - 1ull; wn = 0; } else { jn = j0w; wn = 1; } }
            else { jn = jc + 1; wn = 1; has_next = jc < cur; }
            if (has_next && VAR != 1) { const bf16* kp = wn ? kw : ks; const bf16* vp = wn ? vw : vs; NSA_LOADK(kp + (size_t)jn * 4096); NSA_LOADV(vp + (size_t)jn * 4096); }
            const bool rv = wc ? true : (((mym >> jc) & 1ull) != 0ull);
            const int diag = (jc == cur) ? 1 : ((wc && jc == cur - 4) ? 2 : 0);
            if (__any(rv)) {
                nsa_qk(p0, p1, NSA_KB(buf), qr, negm, r32, hi);
                nsa_step(VAR, p0, p1, mhat, negm, o, ol, diag, rv, __all(rv), rel, NSA_VB(buf), wsf, lane, r32, hi); }
            if (has_next && VAR != 1) { NSA_STOREK(buf ^ 1); NSA_STOREV(buf ^ 1); }
            if (VAR != 4) __syncthreads();
            if (has_next && wn != wc) {
                row_bcast(g1, wsf, r32, hi, f16);
#pragma unroll
                for (int r = 0; r < 16; ++r) { const float fc = f16[r] * __builtin_amdgcn_rcpf(ol[r]); PS[(2 * r) * 64 + lane] += o[0][r] * fc; PS[(2 * r + 1) * 64 + lane] += o[1][r] * fc; o[0][r] = 0.f; o[1][r] = 0.f; ol[r] = 0.f; negm[r] = 0.f; }
                mhat = 0.f;
            }
            if (!has_next) break;
            jc = jn; wc = wn; buf ^= 1;
        }
    }
    row_bcast(g2, wsf, r32, hi, f16);
#pragma unroll
    for (int r = 0; r < 16; ++r) f16[r] *= __builtin_amdgcn_rcpf(ol[r]);
    bf16* outb = outbase + ((size_t)b * SEQ + t0 + 8 * w) * 1024 + 512 + g * 256 + r32;
    if (VAR == 0 || mhat == 12345.678f)
#pragma unroll
    for (int r = 0; r < 16; ++r) { const int rr = crow(r, hi), qo = rr >> 2, ho = rr & 3;
        outb[(size_t)qo * 1024 + ho * 64] = (bf16)f2bf(PS[(2 * r) * 64 + lane] + o[0][r] * f16[r]); outb[(size_t)qo * 1024 + ho * 64 + 32] = (bf16)f2bf(PS[(2 * r + 1) * 64 + lane] + o[1][r] * f16[r]); }
#undef NSA_LOADK
#undef NSA_LOADV
#undef NSA_STOREK
#undef NSA_STOREV
#undef NSA_KB
#undef NSA_VB
}

constexpr int ML_QS = 272, ML_VS = 320;
constexpr int ML_Q_OFF = 0, ML_K_OFF = 64 * ML_QS, ML_V_OFF = 2 * 64 * ML_QS, ML_CT_OFF = ML_V_OFF + 64 * ML_VS, ML_HS_OFF = ML_CT_OFF + 128 * ML_QS, ML_VEC_OFF = ML_HS_OFF + 128 * 65 * 4, ML_END = ML_VEC_OFF + 4096;
static_assert(ML_END <= MISC_OFF && 2 * 67 * 256 <= 128 * ML_QS, "mlstm mfma lds");
__device__ __forceinline__ void conv8(const LAS bf16* raw, int s, int c8, const float* cw, const float* cb, float (&out)[8]) {
    const f32x4 b0 = *(const f32x4*)(cb + c8 * 8), b1 = *(const f32x4*)(cb + c8 * 8 + 4);
    float acc[8] = {b0[0], b0[1], b0[2], b0[3], b1[0], b1[1], b1[2], b1[3]};
#pragma unroll
    for (int j = 0; j < 4; ++j) { float x[8]; unpack8(*(const LAS v4u*)(raw + (s + j) * 128 + c8 * 8), x);
        const f32x4 w0 = *(const f32x4*)(cw + j * 1024 + c8 * 8), w1 = *(const f32x4*)(cw + j * 1024 + c8 * 8 + 4);
        acc[0] += w0[0] * x[0]; acc[1] += w0[1] * x[1]; acc[2] += w0[2] * x[2]; acc[3] += w0[3] * x[3]; acc[4] += w1[0] * x[4]; acc[5] += w1[1] * x[5]; acc[6] += w1[2] * x[6]; acc[7] += w1[3] * x[7]; }
#pragma unroll
    for (int i = 0; i < 8; ++i) out[i] = siluf_(acc[i]);
}
__device__ __forceinline__ void mlstm_gates(const Args& a, Frame& F, int h, size_t row0, LAS float* bcum, LAS float* ig) {
    if (F.wave == 0) { const float* g = (const float*)(a.ws + WS_RC + RC_IF) + (row0 + F.lane) * 8; const float fp = g[4 + h] + a.in[I_GATEB][4 + h];
        ig[F.lane] = g[h] + a.in[I_GATEB][h];
        float v = fminf(fp, 0.f) - log1pf(__expf(-fabsf(fp)));
#pragma unroll
        for (int off = 1; off < 64; off <<= 1) { const float u = __shfl_up(v, off); if (F.lane >= off) v += u; }
        bcum[F.lane] = v; }
}
__device__ __forceinline__ void mlstm_stage_raw(Frame& F, const bf16* src, int b, int h, int t0, LAS bf16* raw) {
    for (int idx = F.tid; idx < 67 * 16; idx += NTHREADS) { const int rr = idx >> 4, c8 = idx & 15, tt = t0 - 3 + rr;
        v4u v = (v4u){0u, 0u, 0u, 0u}; if (tt >= 0) v = *(const v4u*)(src + ((size_t)b * SEQ + tt) * 512 + h * 128 + c8 * 8);
        *(LAS v4u*)(raw + rr * 128 + c8 * 8) = v; }
}
__device__ __forceinline__ void conv8r(const v4u (&tap)[4], int c8, const float* cw, const float* cb, float (&out)[8]) {
    const f32x4 b0 = *(const f32x4*)(cb + c8 * 8), b1 = *(const f32x4*)(cb + c8 * 8 + 4);
    float acc[8] = {b0[0], b0[1], b0[2], b0[3], b1[0], b1[1], b1[2], b1[3]};
#pragma unroll
    for (int j = 0; j < 4; ++j) { float x[8]; unpack8(tap[j], x);
        const f32x4 w0 = *(const f32x4*)(cw + j * 1024 + c8 * 8), w1 = *(const f32x4*)(cw + j * 1024 + c8 * 8 + 4);
        acc[0] += w0[0] * x[0]; acc[1] += w0[1] * x[1]; acc[2] += w0[2] * x[2]; acc[3] += w0[3] * x[3]; acc[4] += w1[0] * x[4]; acc[5] += w1[1] * x[5]; acc[6] += w1[2] * x[6]; acc[7] += w1[3] * x[7]; }
#pragma unroll
    for (int i = 0; i < 8; ++i) out[i] = siluf_(acc[i]);
}
__device__ __forceinline__ void load_taps(v4u (&tap)[4], const bf16* src, int b, int h, int t0, int s, int c8) {
#pragma unroll
    for (int j = 0; j < 4; ++j) { const int tt = t0 + s - 3 + j; tap[j] = (v4u){0u, 0u, 0u, 0u}; if (tt >= 0) tap[j] = *(const v4u*)(src + ((size_t)b * SEQ + tt) * 512 + h * 128 + c8 * 8); }
}
__device__ __forceinline__ void mlstm_gates_lane(const Args& a, int h, size_t row0, int lane, float& igv, float& bc) {
    const float* g = (const float*)(a.ws + WS_RC + RC_IF) + (row0 + lane) * 8; const float fp = g[4 + h] + a.in[I_GATEB][4 + h];
    igv = g[h] + a.in[I_GATEB][h];
    float v = fminf(fp, 0.f) - log1pf(__expf(-fabsf(fp)));
#pragma unroll
    for (int off = 1; off < 64; off <<= 1) { const float u = __shfl_up(v, off); if (lane >= off) v += u; }
    bc = v;
}
__device__ __forceinline__ void mlstm_local_mfma(const Args& a, Frame& F, int unit) {
    const int c = unit & 63, h = (unit >> 6) & 3, b = unit >> 8, t0 = c * CHUNK, lane = F.lane, w = F.wave, hi = lane >> 5, r32 = lane & 31;
    const size_t row0 = (size_t)b * SEQ + t0;
    unsigned char* rc = a.ws + WS_RC;
    LAS unsigned char* LK = F.lds; LAS unsigned char* LV = F.lds + 64 * ML_VS;
    v4u tk[2][4], vv[2];
#pragma unroll
    for (int u = 0; u < 2; ++u) { const int it = F.tid + u * NTHREADS, s = it >> 4, c8 = it & 15;
        load_taps(tk[u], (const bf16*)(rc + RC_KM), b, h, t0, s, c8);
        vv[u] = *(const v4u*)((const bf16*)(rc + RC_VM) + (row0 + s) * 512 + h * 128 + c8 * 8); }
    float igv, bc; mlstm_gates_lane(a, h, row0, lane, igv, bc);
    const float blast = __shfl(bc, 63), gv = blast - bc + igv, mloc = wave_max(gv), wvv = __expf(gv - mloc);
    if (F.tid == 0) { float* cs = (float*)(a.ws + WS_CSC) + (size_t)unit * 2; cs[0] = blast; cs[1] = mloc; }
    __syncthreads();
    { const float* cw = a.in[I_CONVW] + 512 + h * 128; const float* cb = a.in[I_CONVB] + 512 + h * 128;
#pragma unroll
      for (int u = 0; u < 2; ++u) { const int it = F.tid + u * NTHREADS, s = it >> 4, c8 = it & 15; float k8[8]; conv8r(tk[u], c8, cw, cb, k8);
          const float sc = 0.08838834764831845f * __shfl(wvv, s & 63);
          v4u o; o.x = pk2(k8[0] * sc, k8[1] * sc); o.y = pk2(k8[2] * sc, k8[3] * sc); o.z = pk2(k8[4] * sc, k8[5] * sc); o.w = pk2(k8[6] * sc, k8[7] * sc);
          *(LAS v4u*)(LK + s * ML_VS + c8 * 16) = o; *(LAS v4u*)(LV + s * ML_VS + c8 * 16) = vv[u]; } }
    __syncthreads();
    if (F.tid < 128) { float sacc = 0.f; for (int s = 0; s < 64; ++s) sacc += bf2f(*(const LAS bf16*)(LK + s * ML_VS + F.tid * 2)); ((float*)(a.ws + WS_NST))[(size_t)unit * 128 + F.tid] = sacc; }
    const int et = w >> 1, dt0 = (w & 1) * 2, blk = (lane >> 4) & 1, q = (lane & 15) >> 2, p = lane & 3;
    f32x16 acc[2];
#pragma unroll
    for (int i = 0; i < 16; ++i) { acc[0][i] = 0.f; acc[1][i] = 0.f; }
    const LAS unsigned char* abase = LV + (8 * hi + q) * ML_VS + (et * 32 + 16 * blk + 4 * p) * 2;
    const LAS unsigned char* bbase = LK + (8 * hi + q) * ML_VS + (dt0 * 32 + 16 * blk + 4 * p) * 2;
#pragma unroll
    for (int ks = 0; ks < 4; ++ks) { const s16x4 a0 = vtr(abase + ks * 16 * ML_VS), a1 = vtr(abase + (ks * 16 + 4) * ML_VS);
        const bf16x8 af = (bf16x8){a0[0], a0[1], a0[2], a0[3], a1[0], a1[1], a1[2], a1[3]};
#pragma unroll
        for (int n = 0; n < 2; ++n) { const s16x4 b0 = vtr(bbase + ks * 16 * ML_VS + n * 64), b1 = vtr(bbase + (ks * 16 + 4) * ML_VS + n * 64);
            const bf16x8 bfr = (bf16x8){b0[0], b0[1], b0[2], b0[3], b1[0], b1[1], b1[2], b1[3]};
            acc[n] = __builtin_amdgcn_mfma_f32_32x32x16_bf16(af, bfr, acc[n], 0, 0, 0); } }
    bf16* st = (bf16*)(a.ws + WS_RB) + (size_t)unit * 16384;
#pragma unroll
    for (int n = 0; n < 2; ++n)
#pragma unroll
        for (int r = 0; r < 16; ++r) st[(et * 32 + crow(r, hi)) * 128 + (dt0 + n) * 32 + r32] = (bf16)f2bf(acc[n][r]);
}
__device__ __forceinline__ void mlstm_out_mfma(const Args& a, Frame& F, int unit) {
    const int c = unit & 63, h = (unit >> 6) & 3, b = unit >> 8, t0 = c * CHUNK, lane = F.lane, w = F.wave, hi = lane >> 5, r32 = lane & 31;
    const size_t row0 = (size_t)b * SEQ + t0;
    unsigned char* rc = a.ws + WS_RC;
    LAS unsigned char* QB = F.lds + ML_Q_OFF; LAS unsigned char* KB = F.lds + ML_K_OFF; LAS unsigned char* VB = F.lds + ML_V_OFF;
    LAS float* HS = (LAS float*)(F.lds + ML_HS_OFF);
    LAS float* bcum = (LAS float*)(F.lds + ML_VEC_OFF); LAS float* ig = bcum + 64; LAS float* nv = bcum + 192; LAS float* ssq = bcum + 320;
    v4u tq[2][4], tk[2][4], vv[2];
#pragma unroll
    for (int u = 0; u < 2; ++u) { const int it = F.tid + u * NTHREADS, s = it >> 4, c8 = it & 15;
        load_taps(tq[u], (const bf16*)(rc + RC_QM), b, h, t0, s, c8); load_taps(tk[u], (const bf16*)(rc + RC_KM), b, h, t0, s, c8);
        vv[u] = *(const v4u*)((const bf16*)(rc + RC_VM) + (row0 + s) * 512 + h * 128 + c8 * 8); }
    const bf16* ctg = (const bf16*)(a.ws + WS_RB) + (size_t)unit * 16384;
    const int te = F.tid >> 3, e0 = (F.tid & 7) * 16;
    float nvr = 0.f; if (F.tid < 128) nvr = ((const float*)(a.ws + WS_NST))[(size_t)unit * 128 + F.tid];
    const float mp = ((const float*)(a.ws + WS_MPREV))[unit];
    float igv = 0.f, bc = 0.f; if (w == 0) mlstm_gates_lane(a, h, row0, lane, igv, bc);
    __syncthreads();
    if (w == 0) { ig[lane] = igv - bc; bcum[lane] = bc; }
    if (F.tid < 128) nv[F.tid] = nvr;
    { const float* cwq = a.in[I_CONVW] + h * 128; const float* cbq = a.in[I_CONVB] + h * 128;
#pragma unroll
      for (int u = 0; u < 2; ++u) { const int it = F.tid + u * NTHREADS, s = it >> 4, c8 = it & 15; float x8[8];
          conv8r(tq[u], c8, cwq, cbq, x8);
          v4u o; o.x = pk2(x8[0], x8[1]); o.y = pk2(x8[2], x8[3]); o.z = pk2(x8[4], x8[5]); o.w = pk2(x8[6], x8[7]);
          *(LAS v4u*)(QB + s * ML_QS + c8 * 16) = o;
          conv8r(tk[u], c8, cwq + 512, cbq + 512, x8); const float sc = 0.08838834764831845f;
          o.x = pk2(x8[0] * sc, x8[1] * sc); o.y = pk2(x8[2] * sc, x8[3] * sc); o.z = pk2(x8[4] * sc, x8[5] * sc); o.w = pk2(x8[6] * sc, x8[7] * sc);
          *(LAS v4u*)(KB + s * ML_QS + c8 * 16) = o;
          *(LAS v4u*)(VB + s * ML_VS + c8 * 16) = vv[u]; } }
    __syncthreads();
    const int et = w & 3, tt = w >> 2, t = tt * 32 + r32, blk = (lane >> 4) & 1, q = (lane & 15) >> 2, p = lane & 3;
    bf16x8 cf[8];
#pragma unroll
    for (int d0 = 0; d0 < 8; ++d0) cf[d0] = *(const bf16x8*)(ctg + (et * 32 + r32) * 128 + d0 * 16 + hi * 8);
    v4u omr[2]; { const bf16* om = (const bf16*)(rc + RC_OM) + (row0 + te) * 512 + h * 128 + e0; omr[0] = *(const v4u*)om; omr[1] = *(const v4u*)(om + 8); }
    bf16x8 qf[8];
#pragma unroll
    for (int d0 = 0; d0 < 8; ++d0) qf[d0] = *(const LAS bf16x8*)(QB + t * ML_QS + d0 * 32 + hi * 16);
    float qn = 0.f;
#pragma unroll
    for (int d0 = 0; d0 < 8; ++d0) { float x[8]; unpack8(__builtin_bit_cast(v4u, qf[d0]), x); const f32x4 n0 = *(const LAS f32x4*)(nv + d0 * 16 + hi * 8), n1 = *(const LAS f32x4*)(nv + d0 * 16 + hi * 8 + 4);
        qn += x[0] * n0[0] + x[1] * n0[1] + x[2] * n0[2] + x[3] * n0[3] + x[4] * n1[0] + x[5] * n1[1] + x[6] * n1[2] + x[7] * n1[3]; }
    qn = swapsum(qn);
    f32x16 p0, p1;
#pragma unroll
    for (int i = 0; i < 16; ++i) { p0[i] = 0.f; p1[i] = 0.f; }
#pragma unroll
    for (int hf = 0; hf < 2; ++hf) { bf16x8 kf[8];
#pragma unroll
        for (int dd = 0; dd < 4; ++dd) { const int d0 = hf * 4 + dd; kf[2 * dd] = *(const LAS bf16x8*)(KB + r32 * ML_QS + d0 * 32 + hi * 16); kf[2 * dd + 1] = *(const LAS bf16x8*)(KB + (32 + r32) * ML_QS + d0 * 32 + hi * 16); }
        __builtin_amdgcn_sched_barrier(0);
#pragma unroll
        for (int dd = 0; dd < 4; ++dd) { const int d0 = hf * 4 + dd; p0 = __builtin_amdgcn_mfma_f32_32x32x16_bf16(kf[2 * dd], qf[d0], p0, 0, 0, 0); p1 = __builtin_amdgcn_mfma_f32_32x32x16_bf16(kf[2 * dd + 1], qf[d0], p1, 0, 0, 0); } }
    const float bt = bcum[t], at = bt + mp;
    float mt = at;
#pragma unroll
    for (int r = 0; r < 16; ++r) { const int s0 = crow(r, hi), s1 = s0 + 32; const float a0 = ig[s0], a1 = ig[s1];
        if (s0 <= t) mt = fmaxf(mt, bt + a0); if (s1 <= t) mt = fmaxf(mt, bt + a1); }
    mt = swapmax(mt);
    float sden = 0.f;
#pragma unroll
    for (int r = 0; r < 16; ++r) { const int s0 = crow(r, hi), s1 = s0 + 32; const float a0 = ig[s0], a1 = ig[s1];
        p0[r] = s0 <= t ? p0[r] * __expf(bt + a0 - mt) : 0.f; p1[r] = s1 <= t ? p1[r] * __expf(bt + a1 - mt) : 0.f; sden += p0[r] + p1[r]; }
    sden = swapsum(sden);
    const float wi = __expf(at - mt), den = sden + wi * qn, dn = fmaxf(fabsf(den), __expf(-mt));
    bf16x8 pa[4]; nsa_pack(pa, p0, p1);
    f32x16 acc, acc2;
#pragma unroll
    for (int i = 0; i < 16; ++i) { acc[i] = 0.f; acc2[i] = 0.f; }
    { const LAS unsigned char* vbase = VB + (4 * hi + q) * ML_VS + (et * 32 + 16 * blk + 4 * p) * 2;
#pragma unroll
      for (int ks = 0; ks < 4; ++ks) { const s16x4 a0 = vtr(vbase + ks * 16 * ML_VS), a1 = vtr(vbase + (ks * 16 + 8) * ML_VS);
          const bf16x8 af = (bf16x8){a0[0], a0[1], a0[2], a0[3], a1[0], a1[1], a1[2], a1[3]};
          acc = __builtin_amdgcn_mfma_f32_32x32x16_bf16(af, pa[ks], acc, 0, 0, 0); } }
#pragma unroll
    for (int d0 = 0; d0 < 8; ++d0) acc2 = __builtin_amdgcn_mfma_f32_32x32x16_bf16(cf[d0], qf[d0], acc2, 0, 0, 0);
    float ss = 0.f; const float rdn = 1.f / dn;
#pragma unroll
    for (int r = 0; r < 16; ++r) { const float hv = (acc[r] + wi * acc2[r]) * rdn; ss += hv * hv; HS[(et * 32 + crow(r, hi)) * 65 + t] = hv; }
    ss = swapsum(ss);
    if (hi == 0) ssq[et * 64 + t] = ss;
    __syncthreads();
    { const float rstd = rsqrtf((ssq[te] + ssq[64 + te] + ssq[128 + te] + ssq[192 + te]) * (1.f / 128.f) + EPS);
      const size_t row = row0 + te; const int ch = h * 128 + e0;
      const float* hg = a.in[I_HGAIN] + ch;
      float o[16], og[16]; unpack8(omr[0], *(float(*)[8])&og[0]); unpack8(omr[1], *(float(*)[8])&og[8]);
#pragma unroll
      for (int i = 0; i < 16; ++i) o[i] = sigmoidf_(og[i]) * HS[(e0 + i) * 65 + te] * rstd * hg[i];
      bf16* hm = (bf16*)(a.ws + WS_RA) + row * 1024 + ch;
#pragma unroll
      for (int i = 0; i < 16; i += 8) { v4u wv4; wv4.x = pk2(o[i], o[i + 1]); wv4.y = pk2(o[i + 2], o[i + 3]); wv4.z = pk2(o[i + 4], o[i + 5]); wv4.w = pk2(o[i + 6], o[i + 7]); *(v4u*)(hm + i) = wv4; } }
}

__global__ void __launch_bounds__(NTHREADS, 2) mk_fwd(Args args) {
    extern __shared__ __attribute__((aligned(16))) unsigned char lds[];
    Frame F;
    F.lds = (LAS unsigned char*)lds;
    F.tid = threadIdx.x; F.lane = F.tid & 63; F.wave = __builtin_amdgcn_readfirstlane(F.tid >> 6);
    F.G = gridDim.x; { const int bx = blockIdx.x; F.vcu = (F.G % 8 == 0) ? (bx % 8) * (F.G / 8) + bx / 8 : bx; }
    volatile LAS unsigned* MISC = (volatile LAS unsigned*)(F.lds + MISC_OFF);
    if (F.tid < 64) MISC[F.tid] = 0u;
    __syncthreads();
    unsigned char* ws = args.ws;
    gu32* ctl = (gu32*)(ws + WS_CTL);
    XcdBarrier bar; bar.bar = (unsigned*)ctl + CW_BAR; bar.x = 0; bar.st = nullptr;
    if (MK_N_LAUNCHES == 1) bar = xcd_barrier_post((unsigned*)ctl + CW_BAR, MISC + 8);
    const int lo = args.ph_lo, hi = args.ph_hi;
#define IN(k) (lo <= (k) && (k) < hi)
#define SEAM(k) do { if (IN(k) && IN((k) + 1)) xcd_barrier(bar); } while (0)
    bf16* U = (bf16*)(ws + WS_RA); bf16* Fb = (bf16*)(ws + WS_RB); bf16* HID = (bf16*)(ws + WS_RC);
    PG8_LAS unsigned char* ring = (PG8_LAS unsigned char*)lds;

    if (IN(0)) { p0_prologue(args, F); } SEAM(0);
    if (IN(1)) { thin_phase<0, false, false, true>(args, F, args.in[I_X], nullptr, nullptr, U, 0, 0, 0.f);
        { LAS unsigned* scr = (LAS unsigned*)(F.lds + F.wave * 16384); const int gw = F.vcu * NWAVES + F.wave, NGW = F.G * NWAVES; constexpr int I_Q = (DM / 64) * (NPROJ / 64);
          const unsigned* am = (const unsigned*)(ws + WS_CTL) + CW_AMAX;
          for (int it = gw; it < 3 * I_Q; it += NGW) { const int layer = it / I_Q, r = it - layer * I_Q;
              if (layer < 2) quant_item_i8<0>(args, layer, DM, NPROJ, (unsigned char*)(ws + WS_W1T) + (size_t)layer * NPROJ * DM, am + layer * NPROJ, (float*)(ws + WS_CS1) + layer * NPROJ, scr, r, F.lane);
              else quant_item_i8<2>(args, 0, DM, NPROJ, (unsigned char*)(ws + WS_WIN), am + 2 * NPROJ, (float*)(ws + WS_CS1) + 2 * NPROJ, scr, r, F.lane); } }
    } SEAM(1);
    if (IN(2)) { pg8::Gemm g{U, (const bf16*)(ws + WS_W1T), T, NPROJ, DM / 2, DM / 2, DM / 2, 0}; pg8::StaticOrder S; S.init(T, NPROJ, F.G, (int)blockIdx.x);
        pg8::EpiSwiGLUI8<DOWN_F8_0> E{(unsigned char*)HID, (const float*)(ws + WS_RS), (const float*)(ws + WS_CS1)}; pg8::gemm_phase<pg8::EpiSwiGLUI8<DOWN_F8_0>, pg8::StaticOrder, true, true, false, 0x7f7f7f7f, 0x7f7f7f7f, true>(ring, g, S, E); } SEAM(2);
    if (IN(3)) { pg8::StaticOrder S; S.init(T, DM, F.G, (int)blockIdx.x); pg8::EpiStore E{Fb, DM}; const bf16* wd = (const bf16*)(ws + WS_W1D);
        if constexpr (DOWN_F8_0) { pg8::Gemm g{HID, wd, T, DM, DFF / 2, DFF / 2, DFF / 2, 0}; pg8::gemm_phase<pg8::EpiStore, pg8::StaticOrder, true, true, true, 0x75757575, 0x7c7c7c7c>(ring, g, S, E); }
        else { pg8::Gemm g{HID, wd, T, DM, DFF, DFF, DFF, 0}; pg8::gemm_phase<pg8::EpiStore, pg8::StaticOrder, true, true>(ring, g, S, E); } } SEAM(3);
    if (IN(4)) { thin_phase<1, false, true, true>(args, F, args.in[I_X], Fb, args.out, U, 0, 1, 0.5f); } SEAM(4);
    if (IN(5)) { pg8::Gemm g{U, (const bf16*)(ws + WS_WIN), T, NPROJ, DM / 2, DM / 2, DM / 2, 0}; pg8::StaticOrder S; S.init(T, NPROJ, F.G, (int)blockIdx.x);
        pg8::EpiProj E{ws + WS_RC, (const float*)(ws + WS_RS), (const float*)(ws + WS_CS1) + 2 * NPROJ}; pg8::gemm_phase<pg8::EpiProj, pg8::StaticOrder, true, true, false, 0x7f7f7f7f, 0x7f7f7f7f, true>(ring, g, S, E); } SEAM(5);
    if (IN(6)) {
        const int bx = (int)blockIdx.x;
        if (bx < 128) { const int kv = bx >> 6; pg8::Gemm g{(const bf16*)(ws + WS_RC + RC_KV + (size_t)kv * 16 * MiB), (const bf16*)(ws + WS_WC1) + (size_t)kv * 512 * 1024, 8192, 512, 1024, 1024, 1024, 0};
            pg8::StaticOrder S; S.init(8192, 512, 64, bx & 63);
            pg8::EpiStoreF32 E{(float*)(ws + WS_RA) + (size_t)kv * 8192 * 512, 512}; pg8::gemm_phase<pg8::EpiStoreF32, pg8::StaticOrder, false, true>(ring, g, S, E); }
        __syncthreads();
#ifdef MLSTM_REF
        for (;;) { if (F.tid == 0) MISC[16] = atomicAdd((unsigned*)ctl + CW_QUEUE, 1u); __syncthreads(); const unsigned unit = MISC[16]; __syncthreads(); if (unit >= 4096u) break; mlstm_local_unit(args, F, (int)unit); }
#else
        { unsigned ticket = 0u; if (F.tid == 0) ticket = atomicAdd((unsigned*)ctl + CW_QUEUE, 1u);
          for (;;) { unsigned nxt = 0u;
              if (F.tid == 0) { MISC[16] = ticket; nxt = atomicAdd((unsigned*)ctl + CW_QUEUE, 1u); }
              __syncthreads(); const unsigned unit = MISC[16]; __syncthreads(); if (unit >= 4096u) break;
              mlstm_local_mfma(args, F, (int)unit); ticket = nxt; } }
#endif
    } SEAM(6);
    if (IN(7)) {
#ifdef PROBE_P7_PART
        if (!(hi - lo == 1 && PROBE_P7_PART == 2)) mlstm_scan(args, F);
        if (!(hi - lo == 1 && PROBE_P7_PART == 1)) compress_l2(args, F);
#else
        mlstm_scan(args, F); compress_l2(args, F);
#endif
    } SEAM(7);
    if (IN(8)) {
#ifdef MLSTM_REF
        for (int unit = F.vcu; unit < 4096; unit += F.G) mlstm_out_unit(args, F, unit);
#else
#ifdef PROBE_P8_PART
        if (!(hi - lo == 1 && PROBE_P8_PART == 2))
#endif
        for (int unit = F.vcu; unit < 4096; unit += F.G) mlstm_out_mfma(args, F, unit);
#endif
        __syncthreads();
#ifdef NSA_DEBUG
        xcd_barrier(bar);
        for (int pidx = F.vcu; pidx < 1024; pidx += F.G) { const int bg = pidx >> 5, i = pidx & 31; nsa_unit(0, args, F, bg, 63 - i, (bf16*)(ws + WS_RC + RC_QM)); nsa_unit(0, args, F, bg, i, (bf16*)(ws + WS_RC + RC_QM)); }
        __syncthreads();
        { LAS float* wl = (LAS float*)(F.lds + F.wave * 4096); const int gw = F.vcu * NWAVES + F.wave, NGW = F.G * NWAVES;
          for (int q = gw; q < NB * NG * SEQ; q += NGW) nsa_query(args, F, q, wl); }
        xcd_barrier(bar);
        { const bf16* A = (const bf16*)(ws + WS_RA + 64 * MiB); const bf16* B = (const bf16*)(ws + WS_RC + RC_QM); float sd = 0.f, sa = 0.f;
          for (size_t i = (size_t)F.vcu * NTHREADS + F.tid; i < (size_t)T * 512; i += (size_t)F.G * NTHREADS) { const float x = bf2f(A[i]), y = bf2f(B[i]); sd += (x - y) * (x - y); sa += x * x; }
          sd = wave_sum(sd); sa = wave_sum(sa);
          if (F.lane == 0) { atomicAdd((float*)ctl + 80, sd); atomicAdd((float*)ctl + 81, sa); } }
#else
#ifdef PROBE_P8_PART
        if (!(hi - lo == 1 && PROBE_P8_PART == 1))
#endif
#ifdef PROBE_NSA_VAR
        { const int var = (hi - lo == 1) ? PROBE_NSA_VAR : 0;
        for (int pidx = F.vcu; pidx < 1024; pidx += F.G) { const int bg = pidx >> 5, i = pidx & 31; nsa_unit(var, args, F, bg, 63 - i, (bf16*)(ws + WS_RA)); nsa_unit(var, args, F, bg, i, (bf16*)(ws + WS_RA)); } }
#else
        for (int pidx = F.vcu; pidx < 1024; pidx += F.G) { const int bg = pidx >> 5, i = pidx & 31; nsa_unit(0, args, F, bg, 63 - i, (bf16*)(ws + WS_RA)); nsa_unit(0, args, F, bg, i, (bf16*)(ws + WS_RA)); }
#endif
#endif
    } SEAM(8);
    if (IN(9)) { pg8::Gemm g{(const bf16*)(ws + WS_RA), (const bf16*)(ws + WS_WUPM), T, DM, 512, 1024, 1024, 1024}; pg8::SegOrder S; S.init(T, DM, F.G, (int)blockIdx.x);
        pg8::EpiMergeFused E{(bf16*)(ws + WS_RC + RC_MERGED), (const bf16*)(ws + WS_RC + RC_GM), (const bf16*)(ws + WS_RC + RC_GN)};
        pg8::gemm_phase<pg8::EpiMergeFused, pg8::SegOrder, true, true>(ring, g, S, E); } SEAM(9);
    if (IN(10)) { pg8::Gemm g{(const bf16*)(ws + WS_RC + RC_MERGED), (const bf16*)(ws + WS_WOUT), T, DM, DM, DM, DM, 0}; pg8::StaticOrder S; S.init(T, DM, F.G, (int)blockIdx.x);
        pg8::EpiStore E{Fb, DM}; pg8::gemm_phase<pg8::EpiStore, pg8::StaticOrder, true, true>(ring, g, S, E); } SEAM(10);
    if (IN(11)) { thin_phase<1, true, true, true>(args, F, args.out, Fb, ws + WS_RC + 512 * MiB, U, 1, 2, 1.0f); } SEAM(11);
    if (IN(12)) { pg8::Gemm g{U, (const bf16*)(ws + WS_W1T + (size_t)NPROJ * DM), T, NPROJ, DM / 2, DM / 2, DM / 2, 0}; pg8::StaticOrder S; S.init(T, NPROJ, F.G, (int)blockIdx.x);
        pg8::EpiSwiGLUI8<DOWN_F8_1> E{(unsigned char*)HID, (const float*)(ws + WS_RS), (const float*)(ws + WS_CS1) + NPROJ}; pg8::gemm_phase<pg8::EpiSwiGLUI8<DOWN_F8_1>, pg8::StaticOrder, true, true, false, 0x7f7f7f7f, 0x7f7f7f7f, true>(ring, g, S, E); } SEAM(12);
    if (IN(13)) { pg8::StaticOrder S; S.init(T, DM, F.G, (int)blockIdx.x); pg8::EpiStore E{Fb, DM}; const bf16* wd = (const bf16*)(ws + WS_W1D) + (size_t)DM * DFF;
        if constexpr (DOWN_F8_1) { pg8::Gemm g{HID, wd, T, DM, DFF / 2, DFF / 2, DFF / 2, 0}; pg8::gemm_phase<pg8::EpiStore, pg8::StaticOrder, true, true, true, 0x75757575, 0x7c7c7c7c>(ring, g, S, E); }
        else { pg8::Gemm g{HID, wd, T, DM, DFF, DFF, DFF, 0}; pg8::gemm_phase<pg8::EpiStore, pg8::StaticOrder, true, true>(ring, g, S, E); } } SEAM(13);
    if (IN(14)) { thin_phase<2, true, false>(args, F, ws + WS_RC + 512 * MiB, Fb, args.out, nullptr, 2, 0, 0.5f);
#ifdef NSA_DEBUG
        __syncthreads();
        { const float sd = __hip_atomic_load((float*)ctl + 80, RLX_AGENT), sa = __hip_atomic_load((float*)ctl + 81, RLX_AGENT); float rel = sqrtf(sd / fmaxf(sa, 1e-30f)); rel = (rel == rel) ? fminf(rel, 4.f) : 8.f;
          const int gw = F.vcu * NWAVES + F.wave, NGW = F.G * NWAVES;
          for (int row = gw; row < T; row += NGW) for (int j = 0; j < 4; ++j) { f32x4* p = (f32x4*)(args.out + (size_t)row * DM + 256 * j + 4 * F.lane); *p = *p * (1.f + rel); } }
#endif
    }
#undef IN
#undef SEAM
}

extern "C" void kernel_launch(void* const* d_in, const int* in_sizes, int n_in, void* d_out, int out_size, void* d_ws, size_t ws_size, hipStream_t stream) {
    static int grid = 0;
    if (grid == 0) {
        if (n_in != 21 || in_sizes[0] != T * DM || out_size != T * DM || ws_size < WS_END) { fprintf(stderr, "kernel_launch: unexpected shapes (n_in %d, in0 %d, out %d, ws %zu, need %zu)\n", n_in, n_in > 0 ? in_sizes[0] : -1, out_size, ws_size, (size_t)WS_END); grid = -1; return; }
        int dev = 0, cus = 0;
        if (hipGetDevice(&dev) != hipSuccess || hipDeviceGetAttribute(&cus, hipDeviceAttributeMultiprocessorCount, dev) != hipSuccess) { grid = -1; return; }
        if (hipFuncSetAttribute((const void*)mk_fwd, hipFuncAttributeMaxDynamicSharedMemorySize, LDS_BYTES) != hipSuccess) { fprintf(stderr, "kernel_launch: hipFuncSetAttribute failed\n"); grid = -1; return; }
        int per_cu = 0;
        if (hipOccupancyMaxActiveBlocksPerMultiprocessor(&per_cu, (const void*)mk_fwd, NTHREADS, LDS_BYTES) != hipSuccess || per_cu < 1) fprintf(stderr, "kernel_launch: occupancy query reports %d\n", per_cu);
        (void)hipGetLastError();
        grid = cus;
    }
    if (grid < 0) return;
    if (hipMemsetAsync((char*)d_ws + WS_CTL, 0, CTL_ZERO_BYTES, stream) != hipSuccess) return;
    Args a{};
    for (int i = 0; i < 21; ++i) a.in[i] = (const float*)d_in[i];
    a.out = (float*)d_out; a.ws = (unsigned char*)d_ws;
    if (MK_N_LAUNCHES == 1) { a.ph_lo = 0; a.ph_hi = NPHASE; hipLaunchKernelGGL(mk_fwd, dim3(grid), dim3(NTHREADS), LDS_BYTES, stream, a);
#ifdef PROBE_PHASE
        for (int r = 0; r < PROBE_REPS; ++r) { if (PROBE_PHASE == 6) hipMemsetAsync((char*)d_ws + WS_CTL + CW_QUEUE * 4, 0, 4, stream);
            a.ph_lo = PROBE_PHASE; a.ph_hi = PROBE_PHASE + 1; hipLaunchKernelGGL(mk_fwd, dim3(grid), dim3(NTHREADS), LDS_BYTES, stream, a); }
#endif
    }
    else for (int li = 0; li < NPHASE; ++li) { a.ph_lo = li; a.ph_hi = li + 1; hipLaunchKernelGGL(mk_fwd, dim3(grid), dim3(NTHREADS), LDS_BYTES, stream, a); }
}
```

```cpp
#include <hip/hip_runtime.h>
#include <cstdio>
#include <cstdint>

#define GAS __attribute__((address_space(1)))
#define LAS __attribute__((address_space(3)))
typedef unsigned short bf16;
typedef unsigned v4u __attribute__((ext_vector_type(4)));
typedef unsigned v2u __attribute__((ext_vector_type(2)));
typedef float f32x4 __attribute__((ext_vector_type(4)));
typedef short bf16x8 __attribute__((ext_vector_type(8)));
typedef GAS unsigned gu32;

#ifndef MK_N_LAUNCHES
#define MK_N_LAUNCHES 1
#endif

constexpr int DM = 1024, NB = 16, SEQ = 4096, T = NB * SEQ, DFF = 2816;
constexpr int MH = 4, MDH = 128, MW = 512, CHUNK = 64, NCHUNK = SEQ / CHUNK;
constexpr int NSW = 512, NG = 2, NHG = 4, NDH = 64;
constexpr int NCMP = 255, NSEL = 64;
constexpr int NPROJ = 5632;
constexpr float EPS = 1e-6f;
constexpr int NPHASE = 15;
constexpr bool DOWN_F8_0 = false, DOWN_F8_1 = true;

constexpr size_t MiB = 1u << 20;
constexpr size_t WS_CTL = 0, CTL_ZERO_BYTES = 1 * MiB;
constexpr size_t WS_W1T = 1 * MiB;
constexpr size_t WS_W1D = WS_W1T + 2 * (size_t)NPROJ * DM * 2;
constexpr size_t WS_WIN = WS_W1D + 2 * (size_t)DM * DFF * 2;
constexpr size_t WS_WUPM = WS_WIN + (size_t)NPROJ * DM * 2;
constexpr size_t WS_WUPN = WS_WUPM + (size_t)DM * MW * 2;
constexpr size_t WS_WOUT = WS_WUPN + (size_t)DM * NSW * 2;
constexpr size_t WS_WC1 = WS_WOUT + (size_t)DM * DM * 2;
constexpr size_t WS_ADA = WS_WC1 + 2 * (size_t)512 * 1024 * 2;
constexpr size_t WS_B1P = WS_ADA + (size_t)NB * 9 * DM * 4;
constexpr size_t WS_KCMP = WS_B1P + 32768;
constexpr size_t WS_CSC = WS_KCMP + 2 * (size_t)32 * 256 * 64 * 2;
constexpr size_t WS_MPREV = WS_CSC + 4096 * 8;
constexpr size_t WS_NST = WS_MPREV + 4096 * 4;
constexpr size_t WS_CS1 = WS_NST + (size_t)4096 * 128 * 4;
constexpr size_t WS_RS = WS_CS1 + 3 * (size_t)NPROJ * 4;
constexpr size_t WS_SMALL_END = WS_RS + (size_t)T * 4;
constexpr size_t WS_RA = 64 * MiB;
constexpr size_t WS_RB = WS_RA + 128 * MiB;
constexpr size_t WS_RC = WS_RB + 128 * MiB;
static_assert(WS_SMALL_END <= WS_RA, "small buffers");
constexpr size_t RC_QM = 0, RC_KM = 64 * MiB, RC_VM = 128 * MiB, RC_OM = 192 * MiB, RC_QN = 256 * MiB;
constexpr size_t RC_KV = 320 * MiB;
constexpr size_t RC_GM = 416 * MiB, RC_GN = 544 * MiB, RC_IF = 672 * MiB, RC_GG = 674 * MiB, RC_END = 680 * MiB;
constexpr size_t RC_MERGED = RC_VM;
constexpr size_t WS_END = WS_RC + RC_END;
static_assert(WS_END <= 1024 * MiB, "workspace");
static_assert((size_t)T * DFF * 2 <= 512 * MiB && 512 * MiB + (size_t)T * DM * 2 <= RC_END, "hid and the bf16 residual copy fit");

constexpr int CW_TMO = 0, CW_CODE = 1, CW_QUEUE = 64;
constexpr int CW_BAR = 4096;
constexpr int CW_AMAX = 32768;
static_assert((CW_AMAX + 3 * 5632) * 4 <= (int)CTL_ZERO_BYTES, "absmax words inside the memset region");

constexpr int LDS_BYTES = 159744;
constexpr int MISC_OFF = LDS_BYTES - 256;
constexpr int NWAVES = 8, NTHREADS = 512;

#define RLX_AGENT __ATOMIC_RELAXED, __HIP_MEMORY_SCOPE_AGENT
#define LDS_WAIT() asm volatile("s_waitcnt lgkmcnt(0)" ::: "memory")
#define VM_WAIT() asm volatile("s_waitcnt vmcnt(0)" ::: "memory")
__device__ __forceinline__ unsigned f2bf(float f) { unsigned u = __builtin_bit_cast(unsigned, f); return (u + 0x7fffu + ((u >> 16) & 1u)) >> 16; }
__device__ __forceinline__ unsigned pk2(float lo, float hi) { return f2bf(lo) | (f2bf(hi) << 16); }
__device__ __forceinline__ float bf2f(unsigned short b) { return __builtin_bit_cast(float, (unsigned)b << 16); }
__device__ __forceinline__ float bflo(unsigned w) { return __builtin_bit_cast(float, w << 16); }
__device__ __forceinline__ float bfhi(unsigned w) { return __builtin_bit_cast(float, w & 0xffff0000u); }
__device__ __forceinline__ float sigmoidf_(float x) { return __builtin_amdgcn_rcpf(1.f + __builtin_amdgcn_exp2f(-1.4426950408889634f * x)); }
__device__ __forceinline__ float siluf_(float x) { return x * __builtin_amdgcn_rcpf(1.f + __builtin_amdgcn_exp2f(-1.4426950408889634f * x)); }
__device__ __forceinline__ void unpack8(const v4u w, float (&x)[8]) { x[0] = bflo(w.x); x[1] = bfhi(w.x); x[2] = bflo(w.y); x[3] = bfhi(w.y); x[4] = bflo(w.z); x[5] = bfhi(w.z); x[6] = bflo(w.w); x[7] = bfhi(w.w); }
__device__ __forceinline__ float wave_sum(float v) {
#pragma unroll
    for (int o = 1; o < 64; o <<= 1) v += __shfl_xor(v, o);
    return v;
}
__device__ __forceinline__ float wave_max(float v) {
#pragma unroll
    for (int o = 1; o < 64; o <<= 1) v = fmaxf(v, __shfl_xor(v, o));
    return v;
}

namespace pg8 {
#define PG8_LAS __attribute__((address_space(3)))
typedef unsigned short bf16_t;
typedef unsigned u32x4 __attribute__((ext_vector_type(4)));
constexpr int BM = 256, BK = 64, HALF = 128, HTB = HALF * BK * 2, STAGE_BYTES = 8 * HTB, NXCD = 8, WGM = 4;

__host__ __device__ __forceinline__ int lds_byte(int r, int c) { const int st = (r >> 4) * 2 + (c >> 5), rr = r & 15, cc = c & 31, ob = rr * 64 + cc * 2; return st * 1024 + (ob ^ (((ob >> 9) & 1) << 5)); }
__host__ __device__ __forceinline__ void stage_rc(int b, int& R, int& C) { const int st = b / 1024, sb = b % 1024, swz = sb ^ (((sb >> 9) & 1) << 5); R = (st >> 1) * 16 + swz / 64; C = (st & 1) * 32 + (swz % 64) / 2; }
__host__ __device__ __forceinline__ int perm32(int rho) { const int n = rho >> 4, i = rho & 15; return 8 * (i >> 2) + 4 * n + (i & 3); }

struct Unit { int pm, pn, seg; };
struct Gemm { const bf16_t* A; const bf16_t* Bt; int M, N, K; int lda, ldb, segbytes; };

struct StaticOrder {
    int nM, nN, nwg, G, c;
    __host__ __device__ void init(int M, int N, int G_, int c_) { nM = M / BM; nN = N / BM; nwg = nM * nN; G = G_; c = c_; }
    __host__ __device__ bool next(int i, Unit& u) const {
        const long L = (long)i * G + c; if (L >= nwg) return false;
        int wgid = (int)L; { const int q = nwg / NXCD, r = nwg % NXCD, xcd = wgid % NXCD, off = wgid / NXCD; wgid = (xcd < r ? xcd * (q + 1) : r * (q + 1) + (xcd - r) * q) + off; }
        const int nig = WGM * nN, gid = wgid / nig, fm = gid * WGM, gsz = (nM - fm) < WGM ? (nM - fm) : WGM;
        u.pm = fm + ((wgid % nig) % gsz); u.pn = (wgid % nig) / gsz; u.seg = 0; return true;
    }
    __device__ __forceinline__ void a_ready(const Unit&) const {}
    __device__ __forceinline__ void done(const Unit&) const {}
};
struct SegOrder : StaticOrder {
    __host__ __device__ bool next(int i, Unit& u) const { if (!StaticOrder::next(i >> 1, u)) return false; u.seg = i & 1; return true; }
};

template <class Epi, class Sched, bool ALIGN_EPI = false, bool SP2 = false, bool F8 = false, int SCALE_B = 0x7f7f7f7f, int SCALE_A = 0x7f7f7f7f, bool I8 = false>
__device__ __forceinline__ void gemm_phase(PG8_LAS unsigned char* lds, const Gemm g, const Sched& S, const Epi& E) {
    const int tid = threadIdx.x, wid = __builtin_amdgcn_readfirstlane(tid >> 6), lane = tid & 63, wr = wid >> 2, wc = wid & 3, fr = lane & 15, fq = lane >> 4;
    const int K = g.K, nt = K / BK;
    unsigned voffA[2], voffB[2];
#pragma unroll
    for (int i = 0; i < 2; ++i) { int R, C; stage_rc(tid * 16 + i * 8192, R, C); const int Rb = ((R & ~31) + perm32(R & 31));
        voffA[i] = (unsigned)(R * g.lda + C) * 2u; voffB[i] = (unsigned)(Rb * g.ldb + C) * 2u; }
    const size_t kstep = (size_t)(BK * 2);
    const size_t hstepA = (size_t)HALF * g.lda * 2, hstepB = (size_t)HALF * g.ldb * 2;
    const size_t tstepA = 2 * hstepA, tstepB = 2 * hstepB;
    const unsigned ldsw = (unsigned)wid * 1024u;
    const int aoff = lds_byte(wr * 64 + fr, fq * 8), boff = lds_byte(wc * 32 + fr, fq * 8);
#define PG8_SA(b, h) (((b) * 2 + (h)) * HTB)
#define PG8_SB(b, h) ((4 + (b) * 2 + (h)) * HTB)
#define PG8_STAGE(bufoff, gbase, voff) do { _Pragma("unroll") for (int _i = 0; _i < 2; ++_i) \
        __builtin_amdgcn_global_load_lds((const unsigned*)((const char*)(gbase) + (voff)[_i]), (PG8_LAS unsigned*)(lds + (bufoff) + ldsw + _i * 8192), 16, 0, 0); } while (0)
    typedef int v4i_ __attribute__((ext_vector_type(4))); typedef int v8i_ __attribute__((ext_vector_type(8)));
#define PG8_LDA(dst, b, h) do { _Pragma("unroll") for (int m = 0; m < 4; ++m) { if constexpr (F8) { \
        dst##8[m] = __builtin_shufflevector(*(const PG8_LAS v4i_*)(lds + PG8_SA(b, h) + aoff + m * 2048), *(const PG8_LAS v4i_*)(lds + PG8_SA(b, h) + aoff + m * 2048 + 1024), 0, 1, 2, 3, 4, 5, 6, 7); } \
        else { _Pragma("unroll") for (int k = 0; k < 2; ++k) dst[m][k] = *(const PG8_LAS bf16x8*)(lds + PG8_SA(b, h) + aoff + m * 2048 + k * 1024); } } } while (0)
#define PG8_LDB(dst, b, h) do { _Pragma("unroll") for (int n = 0; n < 2; ++n) { if constexpr (F8) { \
        dst##8[n] = __builtin_shufflevector(*(const PG8_LAS v4i_*)(lds + PG8_SB(b, h) + boff + n * 2048), *(const PG8_LAS v4i_*)(lds + PG8_SB(b, h) + boff + n * 2048 + 1024), 0, 1, 2, 3, 4, 5, 6, 7); } \
        else { _Pragma("unroll") for (int k = 0; k < 2; ++k) dst[n][k] = *(const PG8_LAS bf16x8*)(lds + PG8_SB(b, h) + boff + n * 2048 + k * 1024); } } } while (0)
#define PG8_MMA(ai, bj, At, Bt) do { __builtin_amdgcn_s_setprio(1); _Pragma("unroll") for (int m = 0; m < 4; ++m) _Pragma("unroll") for (int n = 0; n < 2; ++n) { \
        if constexpr (F8) { asm volatile("v_mfma_scale_f32_16x16x128_f8f6f4 %0, %1, %2, %0, %3, %4 op_sel_hi:[0,0,0]" : "+v"(acc[ai][bj][m][n]) : "v"(Bt##8[n]), "v"(At##8[m]), "v"(sclB), "v"(sclA)); } \
        else if constexpr (I8) { _Pragma("unroll") for (int k = 0; k < 2; ++k) acc[ai][bj][m][n] = __builtin_bit_cast(f32x4, __builtin_amdgcn_mfma_i32_16x16x64_i8(__builtin_bit_cast(v4i_, Bt[n][k]), __builtin_bit_cast(v4i_, At[m][k]), __builtin_bit_cast(v4i_, acc[ai][bj][m][n]), 0, 0, 0)); } \
        else { _Pragma("unroll") for (int k = 0; k < 2; ++k) acc[ai][bj][m][n] = __builtin_amdgcn_mfma_f32_16x16x32_bf16(Bt[n][k], At[m][k], acc[ai][bj][m][n], 0, 0, 0); } } \
        __builtin_amdgcn_s_setprio(0); } while (0)
#define PG8_WAIT_V(n) asm volatile("s_waitcnt vmcnt(" #n ")" ::: "memory")
#define PG8_WAIT_L(n) asm volatile("s_waitcnt lgkmcnt(" #n ")" ::: "memory")
#define PG8_BAR __builtin_amdgcn_s_barrier()
#define PG8_SCHED __builtin_amdgcn_sched_barrier(0)
    Unit cur, nxt; int ui = 0;
    if (!S.next(0, cur)) return;
    f32x4 acc[2][2][4][2];
#pragma unroll
    for (int a = 0; a < 2; ++a)
#pragma unroll
        for (int b = 0; b < 2; ++b)
#pragma unroll
            for (int m = 0; m < 4; ++m)
#pragma unroll
                for (int n = 0; n < 2; ++n) acc[a][b][m][n] = (f32x4){0.f, 0.f, 0.f, 0.f};
    const int sclB = SCALE_B, sclA = SCALE_A;
    bf16x8 At[4][2], B0[2][2], B1[2][2]; v8i_ At8[4], B08[2], B18[2];
    const char* cA = (const char*)g.A + (size_t)cur.pm * tstepA + (size_t)cur.seg * g.segbytes; const char* cB = (const char*)g.Bt + (size_t)cur.pn * tstepB + (size_t)cur.seg * g.segbytes;
    S.a_ready(cur);
    if constexpr (SP2) {
        PG8_STAGE(PG8_SB(0, 0), cB, voffB); PG8_STAGE(PG8_SB(0, 1), cB + hstepB, voffB); PG8_STAGE(PG8_SA(0, 0), cA, voffA); PG8_STAGE(PG8_SA(0, 1), cA + hstepA, voffA);
        if (wr == 1) PG8_BAR;
        PG8_WAIT_V(2); PG8_BAR;
        PG8_STAGE(PG8_SB(1, 0), cB + kstep, voffB); PG8_STAGE(PG8_SA(1, 0), cA + kstep, voffA); PG8_STAGE(PG8_SB(1, 1), cB + hstepB + kstep, voffB);
        PG8_WAIT_V(6); PG8_BAR;
    } else {
        PG8_STAGE(PG8_SB(0, 0), cB, voffB); PG8_STAGE(PG8_SA(0, 0), cA, voffA); PG8_STAGE(PG8_SB(0, 1), cB + hstepB, voffB); PG8_STAGE(PG8_SA(0, 1), cA + hstepA, voffA);
        if (wr == 1) PG8_BAR;
        PG8_WAIT_V(4); PG8_BAR;
        PG8_STAGE(PG8_SB(1, 0), cB + kstep, voffB); PG8_STAGE(PG8_SA(1, 0), cA + kstep, voffA); PG8_STAGE(PG8_SB(1, 1), cB + hstepB + kstep, voffB);
        PG8_WAIT_V(6); PG8_BAR;
    }
    for (;;) {
        const bool has_next = S.next(ui + 1, nxt);
        const char* nA = has_next ? (const char*)g.A + (size_t)nxt.pm * tstepA + (size_t)nxt.seg * g.segbytes : cA; const char* nB = has_next ? (const char*)g.Bt + (size_t)nxt.pn * tstepB + (size_t)nxt.seg * g.segbytes : cB;
        for (int t = 0; t < nt; t += 2) {
            const bool last = (t == nt - 2);
            const char* a1 = cA + (size_t)(t + 1) * kstep;
            const char* a2 = last ? nA : cA + (size_t)(t + 2) * kstep; const char* b2 = last ? nB : cB + (size_t)(t + 2) * kstep;
            const char* a3 = a2 + kstep; const char* b3 = b2 + kstep;
            if (last && has_next) S.a_ready(nxt);
            if constexpr (SP2) {
            PG8_LDB(B0, 0, 0); PG8_LDB(B1, 0, 1); PG8_SCHED; PG8_LDA(At, 0, 0); PG8_STAGE(PG8_SA(1, 1), a1 + hstepA, voffA);
            PG8_WAIT_V(8); PG8_WAIT_L(0); PG8_BAR; PG8_MMA(0, 0, At, B0); PG8_MMA(0, 1, At, B1); PG8_BAR; PG8_SCHED;
            PG8_LDA(At, 0, 1); PG8_STAGE(PG8_SB(0, 0), b2, voffB); PG8_STAGE(PG8_SB(0, 1), b2 + hstepB, voffB); PG8_STAGE(PG8_SA(0, 0), a2, voffA);
            PG8_WAIT_V(8); PG8_WAIT_L(0); PG8_BAR; PG8_MMA(1, 0, At, B0); PG8_MMA(1, 1, At, B1); PG8_BAR; PG8_SCHED;
            PG8_LDB(B0, 1, 0); PG8_LDB(B1, 1, 1); PG8_SCHED; PG8_LDA(At, 1, 0); PG8_STAGE(PG8_SA(0, 1), a2 + hstepA, voffA);
            PG8_WAIT_V(8); PG8_WAIT_L(0); PG8_BAR; PG8_MMA(0, 0, At, B0); PG8_MMA(0, 1, At, B1); PG8_BAR; PG8_SCHED;
            PG8_LDA(At, 1, 1); PG8_STAGE(PG8_SB(1, 0), b3, voffB); PG8_STAGE(PG8_SB(1, 1), b3 + hstepB, voffB); PG8_STAGE(PG8_SA(1, 0), a3, voffA);
            PG8_WAIT_V(8); PG8_WAIT_L(0); PG8_BAR; PG8_MMA(1, 0, At, B0); PG8_MMA(1, 1, At, B1); PG8_BAR; PG8_SCHED;
            } else {
            PG8_LDB(B0, 0, 0); PG8_SCHED; PG8_LDA(At, 0, 0); PG8_STAGE(PG8_SA(1, 1), a1 + hstepA, voffA);
            PG8_WAIT_L(8); PG8_BAR; PG8_WAIT_L(0); PG8_MMA(0, 0, At, B0); PG8_BAR; PG8_SCHED;
            PG8_LDB(B1, 0, 1); PG8_STAGE(PG8_SB(0, 0), b2, voffB);
            PG8_BAR; PG8_WAIT_L(0); PG8_MMA(0, 1, At, B1); PG8_BAR;
            PG8_LDA(At, 0, 1); PG8_STAGE(PG8_SA(0, 0), a2, voffA);
            PG8_BAR; PG8_WAIT_L(0); PG8_MMA(1, 0, At, B0); PG8_BAR; PG8_SCHED;
            PG8_STAGE(PG8_SB(0, 1), b2 + hstepB, voffB);
            PG8_WAIT_V(6); PG8_BAR; PG8_MMA(1, 1, At, B1); PG8_BAR;
            PG8_LDB(B0, 1, 0); PG8_SCHED; PG8_LDA(At, 1, 0); PG8_STAGE(PG8_SA(0, 1), a2 + hstepA, voffA);
            PG8_WAIT_L(8); PG8_BAR; PG8_WAIT_L(0); PG8_MMA(0, 0, At, B0); PG8_BAR; PG8_SCHED;
            PG8_LDB(B1, 1, 1); PG8_STAGE(PG8_SB(1, 0), b3, voffB);
            PG8_BAR; PG8_WAIT_L(0); PG8_MMA(0, 1, At, B1); PG8_BAR;
            PG8_LDA(At, 1, 1); PG8_STAGE(PG8_SA(1, 0), a3, voffA);
            PG8_BAR; PG8_WAIT_L(0); PG8_MMA(1, 0, At, B0); PG8_BAR; PG8_SCHED;
            PG8_STAGE(PG8_SB(1, 1), b3 + hstepB, voffB);
            PG8_WAIT_V(6); PG8_BAR; PG8_MMA(1, 1, At, B1); PG8_BAR;
            }
        }
        if constexpr (ALIGN_EPI) { if (wr == 0) PG8_BAR; }
        if constexpr (F8) asm volatile("s_nop 15\n\ts_nop 15" ::: "memory");
        E(acc, cur, wr, wc, fr, fq); S.done(cur);
        if (!has_next) break;
        if (!(Epi::KEEP_SEG0 && cur.seg == 0))
#pragma unroll
        for (int a = 0; a < 2; ++a)
#pragma unroll
            for (int b = 0; b < 2; ++b)
#pragma unroll
                for (int m = 0; m < 4; ++m)
#pragma unroll
                    for (int n = 0; n < 2; ++n) acc[a][b][m][n] = (f32x4){0.f, 0.f, 0.f, 0.f};
        cur = nxt; cA = nA; cB = nB; ++ui;
        if constexpr (ALIGN_EPI) { if (wr == 1) PG8_BAR; }
    }
    PG8_WAIT_V(0);
    if constexpr (!ALIGN_EPI) { if (wr == 0) PG8_BAR; }
    PG8_BAR;
#undef PG8_SA
#undef PG8_SB
#undef PG8_STAGE
#undef PG8_LDA
#undef PG8_LDB
#undef PG8_MMA
#undef PG8_WAIT_V
#undef PG8_WAIT_L
#undef PG8_BAR
#undef PG8_SCHED
}

typedef f32x4 Acc[2][2][4][2];
__device__ __forceinline__ v4u pack8(const f32x4& v0, const f32x4& v1) { v4u w; w.x = pk2(v0[0], v0[1]); w.y = pk2(v0[2], v0[3]); w.z = pk2(v1[0], v1[1]); w.w = pk2(v1[2], v1[3]); return w; }

struct EpiStore {
    static constexpr bool KEEP_SEG0 = false;
    bf16_t* O; int ldc;
    __device__ __forceinline__ void operator()(Acc& acc, const Unit& u, int wr, int wc, int fr, int fq) const {
        const int row0 = u.pm * BM + wr * 64 + fr, col0 = u.pn * BM + wc * 32 + 8 * fq;
#pragma unroll
        for (int ai = 0; ai < 2; ++ai)
#pragma unroll
            for (int m = 0; m < 4; ++m) { bf16_t* rowp = O + (size_t)(row0 + ai * HALF + m * 16) * ldc + col0;
#pragma unroll
                for (int bj = 0; bj < 2; ++bj) *(v4u*)(rowp + bj * HALF) = pack8(acc[ai][bj][m][0], acc[ai][bj][m][1]); }
    }
};
struct EpiStoreF32 {
    static constexpr bool KEEP_SEG0 = false;
    float* O; int ldc;
    __device__ __forceinline__ void operator()(Acc& acc, const Unit& u, int wr, int wc, int fr, int fq) const {
        const int row0 = u.pm * BM + wr * 64 + fr, col0 = u.pn * BM + wc * 32 + 8 * fq;
#pragma unroll
        for (int ai = 0; ai < 2; ++ai)
#pragma unroll
            for (int m = 0; m < 4; ++m) { float* rowp = O + (size_t)(row0 + ai * HALF + m * 16) * ldc + col0;
#pragma unroll
                for (int bj = 0; bj < 2; ++bj) { *(f32x4*)(rowp + bj * HALF) = acc[ai][bj][m][0]; *(f32x4*)(rowp + bj * HALF + 4) = acc[ai][bj][m][1]; } }
    }
};
__device__ __forceinline__ float f8clamp(float v) { return __builtin_amdgcn_fmed3f(v, -448.f, 448.f); }
struct EpiSwiGLU {
    static constexpr bool KEEP_SEG0 = false;
    unsigned char* O;
    __device__ __forceinline__ void operator()(Acc& acc, const Unit& u, int wr, int wc, int fr, int fq) const {
        const int row0 = u.pm * BM + wr * 64 + fr, col0 = u.pn * HALF + wc * 32 + 8 * fq;
#pragma unroll
        for (int ai = 0; ai < 2; ++ai)
#pragma unroll
            for (int m = 0; m < 4; ++m) { unsigned char* rowp = O + (size_t)(row0 + ai * HALF + m * 16) * DFF + col0;
                f32x4 r0, r1;
#pragma unroll
                for (int i = 0; i < 4; ++i) { r0[i] = f8clamp(8.f * siluf_(acc[ai][0][m][0][i]) * acc[ai][1][m][0][i]); r1[i] = f8clamp(8.f * siluf_(acc[ai][0][m][1][i]) * acc[ai][1][m][1][i]); }
                v2u w; w.x = 0u; w.y = 0u;
                w.x = __builtin_amdgcn_cvt_pk_fp8_f32(r0[0], r0[1], w.x, false); w.x = __builtin_amdgcn_cvt_pk_fp8_f32(r0[2], r0[3], w.x, true);
                w.y = __builtin_amdgcn_cvt_pk_fp8_f32(r1[0], r1[1], w.y, false); w.y = __builtin_amdgcn_cvt_pk_fp8_f32(r1[2], r1[3], w.y, true);
                *(v2u*)rowp = w; }
    }
};
template <bool OUT_F8> struct EpiSwiGLUI8 {
    static constexpr bool KEEP_SEG0 = false;
    unsigned char* O; const float* rs; const float* cs;
    __device__ __forceinline__ void operator()(Acc& acc, const Unit& u, int wr, int wc, int fr, int fq) const {
        typedef int v4i_ __attribute__((ext_vector_type(4)));
        const int row0 = u.pm * BM + wr * 64 + fr, col0 = u.pn * HALF + wc * 32 + 8 * fq, cc0 = u.pn * BM + wc * 32 + 8 * fq;
        const f32x4 cg0 = *(const f32x4*)(cs + cc0), cg1 = *(const f32x4*)(cs + cc0 + 4), cu0 = *(const f32x4*)(cs + cc0 + HALF), cu1 = *(const f32x4*)(cs + cc0 + HALF + 4);
#pragma unroll
        for (int ai = 0; ai < 2; ++ai)
#pragma unroll
            for (int m = 0; m < 4; ++m) { const int row = row0 + ai * HALF + m * 16; const float r = rs[row]; unsigned char* rowp = O + (size_t)row * DFF + col0;
                const v4i_ g0 = __builtin_bit_cast(v4i_, acc[ai][0][m][0]), g1 = __builtin_bit_cast(v4i_, acc[ai][0][m][1]), u0 = __builtin_bit_cast(v4i_, acc[ai][1][m][0]), u1 = __builtin_bit_cast(v4i_, acc[ai][1][m][1]);
                f32x4 r0, r1;
#pragma unroll
                for (int i = 0; i < 4; ++i) { r0[i] = siluf_((float)g0[i] * (r * cg0[i])) * ((float)u0[i] * (r * cu0[i])); r1[i] = siluf_((float)g1[i] * (r * cg1[i])) * ((float)u1[i] * (r * cu1[i])); }
                if (OUT_F8) { v2u w; w.x = 0u; w.y = 0u;
                    w.x = __builtin_amdgcn_cvt_pk_fp8_f32(f8clamp(8.f * r0[0]), f8clamp(8.f * r0[1]), w.x, false); w.x = __builtin_amdgcn_cvt_pk_fp8_f32(f8clamp(8.f * r0[2]), f8clamp(8.f * r0[3]), w.x, true);
                    w.y = __builtin_amdgcn_cvt_pk_fp8_f32(f8clamp(8.f * r1[0]), f8clamp(8.f * r1[1]), w.y, false); w.y = __builtin_amdgcn_cvt_pk_fp8_f32(f8clamp(8.f * r1[2]), f8clamp(8.f * r1[3]), w.y, true);
                    *(v2u*)rowp = w; }
                else *(v4u*)((bf16_t*)O + (size_t)row * DFF + col0) = pack8(r0, r1); }
    }
};
struct EpiProj {
    static constexpr bool KEEP_SEG0 = false;
    unsigned char* rc;
    const float* rs; const float* cs;
    __device__ __forceinline__ void operator()(Acc& acc, const Unit& u, int wr, int wc, int fr, int fq) const {
        if (rs) {
            typedef int v4i_ __attribute__((ext_vector_type(4)));
            const int r0_ = u.pm * BM + wr * 64 + fr, c0_ = u.pn * BM + wc * 32 + 8 * fq;
#pragma unroll
            for (int bj = 0; bj < 2; ++bj) { const f32x4 c0 = *(const f32x4*)(cs + c0_ + bj * HALF), c1 = *(const f32x4*)(cs + c0_ + bj * HALF + 4);
#pragma unroll
                for (int ai = 0; ai < 2; ++ai)
#pragma unroll
                    for (int m = 0; m < 4; ++m) { const float r = rs[r0_ + ai * HALF + m * 16]; const v4i_ i0 = __builtin_bit_cast(v4i_, acc[ai][bj][m][0]), i1 = __builtin_bit_cast(v4i_, acc[ai][bj][m][1]);
#pragma unroll
                        for (int i = 0; i < 4; ++i) { acc[ai][bj][m][0][i] = (float)i0[i] * (r * c0[i]); acc[ai][bj][m][1][i] = (float)i1[i] * (r * c1[i]); } } } }
        const int row0 = u.pm * BM + wr * 64 + fr, pn = u.pn;
        const int cw = wc * 32 + 8 * fq;
        if (pn < 10) {
            bf16_t* base = (bf16_t*)(rc + (size_t)(pn >> 1) * (64 * MiB)); const int colb = (pn & 1) * 256 + cw;
            const float sc = (pn >= 8) ? 0.125f * 1.4426950408889634f : 1.f;
#pragma unroll
            for (int ai = 0; ai < 2; ++ai)
#pragma unroll
                for (int m = 0; m < 4; ++m) { bf16_t* rowp = base + (size_t)(row0 + ai * HALF + m * 16) * 512 + colb;
#pragma unroll
                    for (int bj = 0; bj < 2; ++bj) *(v4u*)(rowp + bj * HALF) = pack8(acc[ai][bj][m][0] * sc, acc[ai][bj][m][1] * sc); }
        } else if (pn < 13) {
            const int g = cw >> 6, d = cw & 63;
#pragma unroll
            for (int bj = 0; bj < 2; ++bj) { bf16_t* base = (bf16_t*)(rc + RC_KV + (size_t)((pn - 10) * 2 + bj) * (16 * MiB));
#pragma unroll
                for (int ai = 0; ai < 2; ++ai)
#pragma unroll
                    for (int m = 0; m < 4; ++m) { const int row = row0 + ai * HALF + m * 16, b = row >> 12, s = row & 4095;
                        *(v4u*)(base + ((size_t)((b * 2 + g) * 4096 + s)) * 64 + d) = pack8(acc[ai][bj][m][0], acc[ai][bj][m][1]); } }
        } else if (pn < 21) {
            bf16_t* base = (bf16_t*)(rc + (pn < 17 ? RC_GM : RC_GN)); const int colb = ((pn - 13) & 3) * 256 + cw;
#pragma unroll
            for (int ai = 0; ai < 2; ++ai)
#pragma unroll
                for (int m = 0; m < 4; ++m) { bf16_t* rowp = base + (size_t)(row0 + ai * HALF + m * 16) * 1024 + colb;
#pragma unroll
                    for (int bj = 0; bj < 2; ++bj) { f32x4 s0, s1;
#pragma unroll
                        for (int i = 0; i < 4; ++i) { s0[i] = sigmoidf_(acc[ai][bj][m][0][i]); s1[i] = sigmoidf_(acc[ai][bj][m][1][i]); }
                        *(v4u*)(rowp + bj * HALF) = pack8(s0, s1); } }
        } else {
            if (wc == 0) {
                float* ifm = (float*)(rc + RC_IF); float* gg = (float*)(rc + RC_GG);
#pragma unroll
                for (int ai = 0; ai < 2; ++ai)
#pragma unroll
                    for (int m = 0; m < 4; ++m) { const size_t row = (size_t)(row0 + ai * HALF + m * 16);
                        float* p = (fq == 0) ? (ifm + row * 8) : (gg + row * 24 + (fq - 1) * 8);
                        *(f32x4*)p = acc[ai][0][m][0]; *(f32x4*)(p + 4) = acc[ai][0][m][1]; }
            }
        }
    }
};
struct EpiMergeFused {
    static constexpr bool KEEP_SEG0 = true;
    bf16_t* O; const bf16_t* gm; const bf16_t* gn;
    __device__ __forceinline__ void operator()(Acc& acc, const Unit& u, int wr, int wc, int fr, int fq) const {
        const int row0 = u.pm * BM + wr * 64 + fr, col0 = u.pn * BM + wc * 32 + 8 * fq;
        if (u.seg == 0) {
#pragma unroll
            for (int ai = 0; ai < 2; ++ai)
#pragma unroll
                for (int m = 0; m < 4; ++m) { const size_t off = (size_t)(row0 + ai * HALF + m * 16) * 1024 + col0;
#pragma unroll
                    for (int bj = 0; bj < 2; ++bj) { const v4u a = *(const v4u*)(gm + off + bj * HALF), b = *(const v4u*)(gn + off + bj * HALF);
                        float x[8], y[8]; unpack8(a, x); unpack8(b, y);
#pragma unroll
                        for (int i = 0; i < 4; ++i) { acc[ai][bj][m][0][i] *= x[i] * __builtin_amdgcn_rcpf(y[i]); acc[ai][bj][m][1][i] *= x[4 + i] * __builtin_amdgcn_rcpf(y[4 + i]); } } }
        } else {
#pragma unroll
            for (int ai = 0; ai < 2; ++ai)
#pragma unroll
                for (int m = 0; m < 4; ++m) { const size_t off = (size_t)(row0 + ai * HALF + m * 16) * 1024 + col0;
#pragma unroll
                    for (int bj = 0; bj < 2; ++bj) { const v4u b = *(const v4u*)(gn + off + bj * HALF); float y[8]; unpack8(b, y);
                        f32x4 r0, r1;
#pragma unroll
                        for (int i = 0; i < 4; ++i) { r0[i] = acc[ai][bj][m][0][i] * y[i]; r1[i] = acc[ai][bj][m][1][i] * y[4 + i]; }
                        *(v4u*)(O + off + bj * HALF) = pack8(r0, r1); } }
        }
    }
};
template <bool ADD> struct EpiMerge {
    static constexpr bool KEEP_SEG0 = false;
    bf16_t* O; const bf16_t* gate;
    __device__ __forceinline__ void operator()(Acc& acc, const Unit& u, int wr, int wc, int fr, int fq) const {
        const int row0 = u.pm * BM + wr * 64 + fr, col0 = u.pn * BM + wc * 32 + 8 * fq;
#pragma unroll
        for (int ai = 0; ai < 2; ++ai)
#pragma unroll
            for (int m = 0; m < 4; ++m) { const size_t off = (size_t)(row0 + ai * HALF + m * 16) * 1024 + col0;
#pragma unroll
                for (int bj = 0; bj < 2; ++bj) { const v4u gv = *(const v4u*)(gate + off + bj * HALF); v4u pv = (v4u){0u, 0u, 0u, 0u}; if (ADD) pv = *(const v4u*)(O + off + bj * HALF);
                    f32x4 r0, r1; const f32x4 a0 = acc[ai][bj][m][0], a1 = acc[ai][bj][m][1];
                    r0[0] = sigmoidf_(bflo(gv.x)) * a0[0]; r0[1] = sigmoidf_(bfhi(gv.x)) * a0[1]; r0[2] = sigmoidf_(bflo(gv.y)) * a0[2]; r0[3] = sigmoidf_(bfhi(gv.y)) * a0[3];
                    r1[0] = sigmoidf_(bflo(gv.z)) * a1[0]; r1[1] = sigmoidf_(bfhi(gv.z)) * a1[1]; r1[2] = sigmoidf_(bflo(gv.w)) * a1[2]; r1[3] = sigmoidf_(bfhi(gv.w)) * a1[3];
                    if (ADD) { r0[0] += bflo(pv.x); r0[1] += bfhi(pv.x); r0[2] += bflo(pv.y); r0[3] += bfhi(pv.y); r1[0] += bflo(pv.z); r1[1] += bfhi(pv.z); r1[2] += bflo(pv.w); r1[3] += bfhi(pv.w); }
                    *(v4u*)(O + off + bj * HALF) = pack8(r0, r1); } }
    }
};
}

#define XB_TMO      128
#define XB_XCNT(j)  (256  + 64 * (j))
#define XB_XSUB(j)  (1280 + 64 * (j))
#define XB_XGEN(j)  (2304 + 64 * (j))
#define XB_TOP      3328
#define XB_TOPGEN   3392
#define XCD_BAR_WORDS 3456
#define XB_SPIN_CAP (1u << 22)

__device__ __forceinline__ unsigned xb_ld(unsigned* p)              { return __hip_atomic_load(p, __ATOMIC_RELAXED, __HIP_MEMORY_SCOPE_AGENT); }
__device__ __forceinline__ unsigned xb_add(unsigned* p, unsigned v) { return __hip_atomic_fetch_add(p, v, __ATOMIC_RELAXED, __HIP_MEMORY_SCOPE_AGENT); }
__device__ __forceinline__ unsigned xb_xcc_id() { return (unsigned)__builtin_amdgcn_s_getreg((3 << 11) | 20) & 0xFu; }
#define XB_SPIN(cond, bar) do { unsigned _sp = 0; while (cond) { __builtin_amdgcn_s_sleep(1); \
    if ((++_sp & 255u) == 0u) { if (xb_ld(&(bar)[XB_TMO])) break; if (_sp > XB_SPIN_CAP) { atomicAdd(&(bar)[XB_TMO], 1u); break; } } } } while (0)

struct XcdBarrier { unsigned* bar; unsigned x; volatile LAS unsigned* st; };

__device__ __forceinline__ XcdBarrier xcd_barrier_post(unsigned* bar, volatile LAS unsigned* st) {
    XcdBarrier b; b.bar = bar; b.x = xb_xcc_id(); b.st = st;
    if (threadIdx.x == 0) (void)xb_add(&bar[XB_XCNT(b.x)], 1u);
    return b;
}
__device__ __forceinline__ void xcd_barrier_complete(unsigned* bar, unsigned x, unsigned& nloc, unsigned& nx) {
    const unsigned G = gridDim.x * gridDim.y * gridDim.z;
    unsigned sum, cnt, mine, sp = 0u;
    for (;;) {
        sum = 0u; cnt = 0u; mine = 0u;
#pragma unroll
        for (unsigned j = 0; j < 16; ++j) { const unsigned c = xb_ld(&bar[XB_XCNT(j)]); sum += c; cnt += (c > 0u) ? 1u : 0u; mine = (j == x) ? c : mine; }
        if (sum == G) break;
        __builtin_amdgcn_s_sleep(1);
        if ((++sp & 255u) == 0u) { if (xb_ld(&bar[XB_TMO])) break; if (sp > XB_SPIN_CAP) { atomicAdd(&bar[XB_TMO], 1u); break; } }
    }
    nloc = mine > 0u ? mine : 1u; nx = cnt > 0u ? cnt : 1u;
}
__device__ __forceinline__ void xcd_barrier(const XcdBarrier& b) {
    asm volatile("s_waitcnt vmcnt(0)" ::: "memory");
    __syncthreads();
    if (threadIdx.x == 0) {
        unsigned* bar = b.bar;
        __builtin_amdgcn_s_waitcnt(0);
        unsigned nloc = b.st[0], nx = b.st[1];
        if (nloc == 0u) { xcd_barrier_complete(bar, b.x, nloc, nx); b.st[0] = nloc; b.st[1] = nx; }
        const unsigned old = xb_add(&bar[XB_XSUB(b.x)], 1u);
        const unsigned gen = old / nloc;
        if (old + 1u == (gen + 1u) * nloc) {
            __builtin_amdgcn_fence(__ATOMIC_RELEASE, "agent");
            asm volatile("s_waitcnt vmcnt(0)" ::: "memory");
            const unsigned og = xb_add(&bar[XB_TOP], 1u);
            const unsigned tg = og / nx;
            if (og + 1u == (tg + 1u) * nx) xb_add(&bar[XB_TOPGEN], 1u);
            else XB_SPIN(xb_ld(&bar[XB_TOPGEN]) == tg, bar);
            __builtin_amdgcn_fence(__ATOMIC_ACQUIRE, "agent");
            xb_add(&bar[XB_XGEN(b.x)], 1u);
            asm volatile("s_waitcnt vmcnt(0)" ::: "memory");
        } else {
            XB_SPIN(xb_ld(&bar[XB_XGEN(b.x)]) == gen, bar);
            __builtin_amdgcn_fence(__ATOMIC_ACQUIRE, "agent");
            asm volatile("s_waitcnt vmcnt(0)" ::: "memory");
        }
    }
    __syncthreads();
}

struct Args { const float* in[21]; float* out; unsigned char* ws; int ph_lo, ph_hi; };
enum { I_X = 0, I_C, I_WADA, I_BADA, I_GAINS, I_WG, I_WU, I_WD, I_WIN, I_CONVW, I_CONVB, I_GATEB, I_HGAIN, I_PE, I_CW1, I_CB1, I_CW2, I_CB2, I_WUPM, I_WUPN, I_WOUT };

struct Frame {
    LAS unsigned char* lds;
    int tid, lane, wave, vcu, G;
};

struct ColMap { const float* p; int ld; };
template <int KIND> __device__ __forceinline__ ColMap colmap(const Args& a, int layer, int n) {
    ColMap r; r.p = nullptr; r.ld = 0;
    if (KIND == 0) {
        const int pn = n >> 8, bj = (n >> 7) & 1, j = n & 127; const float* w = (bj ? a.in[I_WU] : a.in[I_WG]) + (size_t)layer * DM * DFF;
        r.p = w + pn * 128 + j; r.ld = DFF;
    } else if (KIND == 1) {
        r.p = a.in[I_WD] + (size_t)layer * DFF * DM + n; r.ld = DM;
    } else if (KIND == 2) {
        int sc; if (n < 2048) sc = n; else if (n < 3328) sc = n + 8; else if (n < 5376) sc = n + 32; else if (n < 5384) sc = n - 5376 + 2048; else if (n < 5408) sc = n - 5384 + 3336; else sc = -1;
        if (sc >= 0) { r.p = a.in[I_WIN] + sc; r.ld = 5408; }
    } else if (KIND == 3) { r.p = a.in[I_WUPM] + n; r.ld = DM; }
    else if (KIND == 4) { r.p = a.in[I_WUPN] + n; r.ld = DM; }
    else if (KIND == 5) { r.p = a.in[I_WOUT] + n; r.ld = DM; }
    else {
        const float* w = a.in[I_CW1] + (size_t)layer * 2048 * 256; r.p = w + (size_t)(n >> 8) * 1024 * 256 + (n & 255); r.ld = 256;
    }
    return r;
}
template <int KIND> __device__ __forceinline__ void transpose_item(const Args& a, int layer, int K, int N, bf16* WT, LAS unsigned* scr, int item, int lane, int ldw = 0) {
    const int nblk = N / 64, kb = item / nblk, nb = item % nblk, k0 = 64 * kb, n0 = 64 * nb;
    const ColMap cm = colmap<KIND>(a, layer, n0 + lane);
    float v[64];
#pragma unroll
    for (int kk = 0; kk < 64; ++kk) v[kk] = cm.p ? cm.p[(size_t)(k0 + kk) * cm.ld] : 0.f;
#pragma unroll
    for (int kk = 0; kk < 64; kk += 2) scr[lane * 33 + (kk >> 1)] = pk2(v[kk], v[kk + 1]);
    LDS_WAIT(); asm volatile("" ::: "memory");
    const int c = lane & 7;
#pragma unroll
    for (int j = 0; j < 8; ++j) { const int n = (lane >> 3) + 8 * j; const LAS unsigned* sp = scr + n * 33 + 4 * c;
        v4u o; o.x = sp[0]; o.y = sp[1]; o.z = sp[2]; o.w = sp[3];
        *(v4u*)(WT + (size_t)(n0 + n) * (ldw ? ldw : K) + k0 + 8 * c) = o; }
    LDS_WAIT(); asm volatile("" ::: "memory");
}
template <int KIND> __device__ __forceinline__ void amax_item(const Args& a, int layer, int N, unsigned* amax, int item, int lane) {
    const int nblk = N / 64, kb = item / nblk, nb = item % nblk, k0 = 64 * kb, n0 = 64 * nb;
    const ColMap cm = colmap<KIND>(a, layer, n0 + lane);
    float v[64], m = 0.f;
#pragma unroll
    for (int kk = 0; kk < 64; ++kk) v[kk] = cm.p ? cm.p[(size_t)(k0 + kk) * cm.ld] : 0.f;
#pragma unroll
    for (int kk = 0; kk < 64; ++kk) m = fmaxf(m, fabsf(v[kk]));
    atomicMax(amax + n0 + lane, __float_as_uint(m));
}
template <int KIND> __device__ __forceinline__ void quant_item_i8(const Args& a, int layer, int K, int N, unsigned char* W8, const unsigned* amax, float* cscale, LAS unsigned* scr, int item, int lane) {
    const int nblk = N / 64, kb = item / nblk, nb = item % nblk, k0 = 64 * kb, n0 = 64 * nb;
    const ColMap cm = colmap<KIND>(a, layer, n0 + lane);
    const float am = __uint_as_float(amax[n0 + lane]), sc = am > 0.f ? am * (1.f / 127.f) : 1.f, inv = 1.f / sc;
    if (kb == 0) cscale[n0 + lane] = sc;
    float v[64];
#pragma unroll
    for (int kk = 0; kk < 64; ++kk) v[kk] = cm.p ? cm.p[(size_t)(k0 + kk) * cm.ld] : 0.f;
#pragma unroll
    for (int kk = 0; kk < 64; kk += 4) { const int q0 = (int)rintf(v[kk] * inv), q1 = (int)rintf(v[kk + 1] * inv), q2 = (int)rintf(v[kk + 2] * inv), q3 = (int)rintf(v[kk + 3] * inv);
        scr[lane * 17 + (kk >> 2)] = (unsigned)(q0 & 255) | ((unsigned)(q1 & 255) << 8) | ((unsigned)(q2 & 255) << 16) | ((unsigned)(q3 & 255) << 24); }
    LDS_WAIT(); asm volatile("" ::: "memory");
    const int c = lane & 3;
#pragma unroll
    for (int j = 0; j < 4; ++j) { const int n = (lane >> 2) + 16 * j; const LAS unsigned* sp = scr + n * 17 + 4 * c;
        v4u o; o.x = sp[0]; o.y = sp[1]; o.z = sp[2]; o.w = sp[3];
        *(v4u*)(W8 + (size_t)(n0 + n) * K + k0 + 16 * c) = o; }
    LDS_WAIT(); asm volatile("" ::: "memory");
}
__device__ __forceinline__ void transpose_item_f8(const Args& a, int layer, bf16* WT_, LAS unsigned* scr, int item, int lane) {
    unsigned char* WT = (unsigned char*)WT_;
    const int nblk = DM / 64, kb = item / nblk, nb = item % nblk, k0 = 64 * kb, n0 = 64 * nb;
    const float* p = a.in[I_WD] + (size_t)layer * DFF * DM + n0 + lane;
    float v[64];
#pragma unroll
    for (int kk = 0; kk < 64; ++kk) v[kk] = p[(size_t)(k0 + kk) * DM];
#pragma unroll
    for (int kk = 0; kk < 64; kk += 4) { unsigned w = 0u;
        w = __builtin_amdgcn_cvt_pk_fp8_f32(__builtin_amdgcn_fmed3f(1024.f * v[kk], -448.f, 448.f), __builtin_amdgcn_fmed3f(1024.f * v[kk + 1], -448.f, 448.f), w, false);
        w = __builtin_amdgcn_cvt_pk_fp8_f32(__builtin_amdgcn_fmed3f(1024.f * v[kk + 2], -448.f, 448.f), __builtin_amdgcn_fmed3f(1024.f * v[kk + 3], -448.f, 448.f), w, true);
        scr[lane * 17 + (kk >> 2)] = w; }
    LDS_WAIT(); asm volatile("" ::: "memory");
    const int c = lane & 3;
#pragma unroll
    for (int j = 0; j < 4; ++j) { const int n = (lane >> 2) + 16 * j; const LAS unsigned* sp = scr + n * 17 + 4 * c;
        v4u o; o.x = sp[0]; o.y = sp[1]; o.z = sp[2]; o.w = sp[3];
        *(v4u*)(WT + (size_t)(n0 + n) * DFF + k0 + 16 * c) = o; }
    LDS_WAIT(); asm volatile("" ::: "memory");
}
__device__ __forceinline__ void p0_prologue(const Args& a, Frame& F) {
    unsigned char* ws = a.ws;
    {
        LAS float* sc = (LAS float*)F.lds;
        LAS float* red = (LAS float*)(F.lds + 65536);
        bool have = false;
        for (int cg = F.vcu; cg < 144; cg += F.G) {
            if (!have) { for (int i = F.tid; i < NB * DM; i += NTHREADS) sc[i] = siluf_(a.in[I_C][i]); have = true; __syncthreads(); }
            float acc[16];
#pragma unroll
            for (int b = 0; b < 16; ++b) acc[b] = 0.f;
            const float* wp = a.in[I_WADA] + (size_t)(F.wave * 128) * 9216 + cg * 64 + F.lane;
#pragma unroll 1
            for (int k0 = 0; k0 < 128; k0 += 16) { float wv[16];
#pragma unroll
                for (int i = 0; i < 16; ++i) wv[i] = wp[(size_t)(k0 + i) * 9216];
#pragma unroll
                for (int i = 0; i < 16; ++i)
#pragma unroll
                    for (int b = 0; b < 16; ++b) acc[b] += sc[b * 1024 + F.wave * 128 + k0 + i] * wv[i]; }
#pragma unroll
            for (int b = 0; b < 16; ++b) red[(F.wave * 16 + b) * 64 + F.lane] = acc[b];
            __syncthreads();
            for (int i = F.tid; i < 16 * 64; i += NTHREADS) { const int b = i >> 6, l = i & 63; float s = 0.f;
#pragma unroll
                for (int w = 0; w < 8; ++w) s += red[(w * 16 + b) * 64 + l];
                ((float*)(ws + WS_ADA))[b * 9216 + cg * 64 + l] = s + a.in[I_BADA][cg * 64 + l]; }
            __syncthreads();
        }
        __syncthreads();
    }
    { const int slot = F.vcu - (F.G - 32);
      if (slot >= 0) { const int kv = slot >> 4, part = slot & 15, c = F.tid & 255, half = F.tid >> 8;
        const float* w1 = a.in[I_CW1] + (size_t)kv * 2048 * 256 + (size_t)(part * 128 + half * 64) * 256 + c; const float* pe = a.in[I_PE] + (size_t)kv * 2048 + part * 128 + half * 64;
        float sacc = 0.f;
#pragma unroll 1
        for (int r0 = 0; r0 < 64; r0 += 16) { float wv[16];
#pragma unroll
            for (int i = 0; i < 16; ++i) wv[i] = w1[(size_t)(r0 + i) * 256];
#pragma unroll
            for (int i = 0; i < 16; ++i) sacc += pe[r0 + i] * wv[i]; }
        LAS float* red = (LAS float*)(F.lds + 98304);
        __syncthreads();
        if (half) red[c] = sacc;
        __syncthreads();
        if (!half) ((float*)(ws + WS_B1P))[(kv * 16 + part) * 256 + c] = sacc + red[c];
        __syncthreads(); } }
    LAS unsigned* scr = (LAS unsigned*)(F.lds + F.wave * 16384);
    const int gw = F.vcu * NWAVES + F.wave, NGW = F.G * NWAVES;
    constexpr int I_GU = (DM / 64) * (NPROJ / 64), I_DN = (DFF / 64) * (DM / 64), I_IN = (DM / 64) * (NPROJ / 64), I_UP = (512 / 64) * (DM / 64), I_OUT = (DM / 64) * (DM / 64), I_C1 = (1024 / 64) * (512 / 64);
    constexpr int I_Q = (DM / 64) * (NPROJ / 64);
    constexpr int NITEMS = 2 * I_Q + 2 * I_DN + I_IN + 2 * I_UP + I_OUT + 2 * I_C1;
    for (int it = gw; it < NITEMS; it += NGW) {
        int r = it;
        if (r < I_Q) { amax_item<0>(a, 0, NPROJ, (unsigned*)(ws + WS_CTL) + CW_AMAX, r, F.lane); continue; } r -= I_Q;
        if (r < I_Q) { amax_item<0>(a, 1, NPROJ, (unsigned*)(ws + WS_CTL) + CW_AMAX + NPROJ, r, F.lane); continue; } r -= I_Q;
        if (r < I_DN) { if (DOWN_F8_0) transpose_item_f8(a, 0, (bf16*)(ws + WS_W1D), scr, r, F.lane); else transpose_item<1>(a, 0, DFF, DM, (bf16*)(ws + WS_W1D), scr, r, F.lane); continue; } r -= I_DN;
        if (r < I_DN) { if (DOWN_F8_1) transpose_item_f8(a, 1, (bf16*)(ws + WS_W1D) + (size_t)DM * DFF, scr, r, F.lane); else transpose_item<1>(a, 1, DFF, DM, (bf16*)(ws + WS_W1D) + (size_t)DM * DFF, scr, r, F.lane); continue; } r -= I_DN;
        if (r < I_IN) { amax_item<2>(a, 0, NPROJ, (unsigned*)(ws + WS_CTL) + CW_AMAX + 2 * NPROJ, r, F.lane); continue; } r -= I_IN;
        if (r < I_UP) { transpose_item<3>(a, 0, 512, DM, (bf16*)(ws + WS_WUPM), scr, r, F.lane, 1024); continue; } r -= I_UP;
        if (r < I_UP) { transpose_item<4>(a, 0, 512, DM, (bf16*)(ws + WS_WUPM) + 512, scr, r, F.lane, 1024); continue; } r -= I_UP;
        if (r < I_OUT) { transpose_item<5>(a, 0, DM, DM, (bf16*)(ws + WS_WOUT), scr, r, F.lane); continue; } r -= I_OUT;
        if (r < I_C1) { transpose_item<6>(a, 0, 1024, 512, (bf16*)(ws + WS_WC1), scr, r, F.lane); continue; } r -= I_C1;
        transpose_item<6>(a, 1, 1024, 512, (bf16*)(ws + WS_WC1) + (size_t)512 * 1024, scr, r, F.lane);
    }
}

template <int MODE, bool RES_BF = false, bool OUT_BF = false, bool U_I8 = false> __device__ __forceinline__ void thin_phase(const Args& a, Frame& F, const void* res_, const bf16* f, void* out_, bf16* u, int s_post, int s_pre, float rw) {
    const float* res = (const float*)res_; const bf16* resb = (const bf16*)res_; float* out = (float*)out_; bf16* outb = (bf16*)out_;
    constexpr int R = 4;
    const float* ada = (const float*)(a.ws + WS_ADA); const float* gains = a.in[I_GAINS];
    const int gw = F.vcu * NWAVES + F.wave, NGW = F.G * NWAVES;
    for (int row0 = gw * R; row0 < T; row0 += NGW * R) {
        const int b = row0 >> 12;
        f32x4 h[R][4]; v2u fw[R][4];
#pragma unroll
        for (int r = 0; r < R; ++r)
#pragma unroll
            for (int j = 0; j < 4; ++j) { if (RES_BF) { const v2u w = *(const v2u*)(resb + (size_t)(row0 + r) * DM + 256 * j + 4 * F.lane); h[r][j] = (f32x4){bflo(w.x), bfhi(w.x), bflo(w.y), bfhi(w.y)}; }
                else h[r][j] = *(const f32x4*)(res + (size_t)(row0 + r) * DM + 256 * j + 4 * F.lane);
                if (MODE != 0) fw[r][j] = *(const v2u*)(f + (size_t)(row0 + r) * DM + 256 * j + 4 * F.lane); }
        if (MODE != 0) {
            const float* gp = gains + (2 * s_post + 1) * DM; const float* gt = ada + (size_t)b * 9216 + (s_post * 3 + 2) * DM;
            f32x4 g4[4], t4[4];
#pragma unroll
            for (int j = 0; j < 4; ++j) { g4[j] = *(const f32x4*)(gp + 256 * j + 4 * F.lane); t4[j] = *(const f32x4*)(gt + 256 * j + 4 * F.lane) * rw; }
#pragma unroll
            for (int r = 0; r < R; ++r) { f32x4 fv[4]; float ss = 0.f;
#pragma unroll
                for (int j = 0; j < 4; ++j) { const v2u w = fw[r][j]; fv[j] = (f32x4){bflo(w.x), bfhi(w.x), bflo(w.y), bfhi(w.y)};
                    ss += fv[j][0] * fv[j][0] + fv[j][1] * fv[j][1] + fv[j][2] * fv[j][2] + fv[j][3] * fv[j][3]; }
                const float rstd = rsqrtf(wave_sum(ss) * (1.f / DM) + EPS);
#pragma unroll
                for (int j = 0; j < 4; ++j) { h[r][j] = h[r][j] + t4[j] * (fv[j] * rstd * g4[j]);
                    if (OUT_BF) { v2u w; w.x = pk2(h[r][j][0], h[r][j][1]); w.y = pk2(h[r][j][2], h[r][j][3]); *(v2u*)(outb + (size_t)(row0 + r) * DM + 256 * j + 4 * F.lane) = w; }
                    else *(f32x4*)(out + (size_t)(row0 + r) * DM + 256 * j + 4 * F.lane) = h[r][j]; } }
        }
        if (MODE != 2) {
            const float* gp = gains + (2 * s_pre) * DM; const float* sh = ada + (size_t)b * 9216 + (s_pre * 3 + 0) * DM; const float* sc = sh + DM;
            f32x4 g4[4], s4[4], c4[4];
#pragma unroll
            for (int j = 0; j < 4; ++j) { g4[j] = *(const f32x4*)(gp + 256 * j + 4 * F.lane); s4[j] = *(const f32x4*)(sh + 256 * j + 4 * F.lane); c4[j] = 1.f + *(const f32x4*)(sc + 256 * j + 4 * F.lane); }
#pragma unroll
            for (int r = 0; r < R; ++r) { float ss = 0.f;
#pragma unroll
                for (int j = 0; j < 4; ++j) ss += h[r][j][0] * h[r][j][0] + h[r][j][1] * h[r][j][1] + h[r][j][2] * h[r][j][2] + h[r][j][3] * h[r][j][3];
                const float rstd = rsqrtf(wave_sum(ss) * (1.f / DM) + EPS);
                if (U_I8) { f32x4 y[4]; float am = 0.f;
#pragma unroll
                    for (int j = 0; j < 4; ++j) { y[j] = (h[r][j] * rstd * g4[j]) * c4[j] + s4[j]; am = fmaxf(am, fmaxf(fmaxf(fabsf(y[j][0]), fabsf(y[j][1])), fmaxf(fabsf(y[j][2]), fabsf(y[j][3])))); }
                    am = wave_max(am); const float sc_ = am > 0.f ? am * (1.f / 127.f) : 1.f, inv = 1.f / sc_;
                    if (F.lane == 0) ((float*)(a.ws + WS_RS))[row0 + r] = sc_;
#pragma unroll
                    for (int j = 0; j < 4; ++j) { const int q0 = (int)rintf(y[j][0] * inv), q1 = (int)rintf(y[j][1] * inv), q2 = (int)rintf(y[j][2] * inv), q3 = (int)rintf(y[j][3] * inv);
                        *(unsigned*)((unsigned char*)u + (size_t)(row0 + r) * DM + 256 * j + 4 * F.lane) = (unsigned)(q0 & 255) | ((unsigned)(q1 & 255) << 8) | ((unsigned)(q2 & 255) << 16) | ((unsigned)(q3 & 255) << 24); } }
                else
#pragma unroll
                for (int j = 0; j < 4; ++j) { const f32x4 y = (h[r][j] * rstd * g4[j]) * c4[j] + s4[j];
                    v2u w; w.x = pk2(y[0], y[1]); w.y = pk2(y[2], y[3]);
                    *(v2u*)(u + (size_t)(row0 + r) * DM + 256 * j + 4 * F.lane) = w; } }
        }
    }
}

constexpr int MQ_OFF = 0, MK_OFF = 64 * 129 * 4, MV_OFF = 2 * 64 * 129 * 4, MS_OFF = 3 * 64 * 129 * 4, MCT_OFF = MS_OFF + 64 * 65 * 4, MVEC_OFF = MCT_OFF + 128 * 130 * 2;
static_assert(MVEC_OFF + 8 * 256 <= MISC_OFF, "mlstm lds");
template <bool WANTQ> __device__ __forceinline__ void mlstm_load_chunk(const Args& a, Frame& F, int b, int h, int c) {
    unsigned char* rc = a.ws + WS_RC;
    const bf16* qm = (const bf16*)(rc + RC_QM); const bf16* km = (const bf16*)(rc + RC_KM); const bf16* vm = (const bf16*)(rc + RC_VM); const float* ifm = (const float*)(rc + RC_IF);
    LAS float* Qs = (LAS float*)(F.lds + MQ_OFF); LAS float* Ks = (LAS float*)(F.lds + MK_OFF); LAS float* Vs = (LAS float*)(F.lds + MV_OFF);
    LAS float* bcum = (LAS float*)(F.lds + MVEC_OFF); LAS float* ig = bcum + 64;
    const int t0 = c * CHUNK; const size_t row0 = (size_t)b * SEQ + t0;
    if (F.tid < 64) { const float* g = ifm + (row0 + F.tid) * 8; const float fp = g[4 + h] + a.in[I_GATEB][4 + h];
        ig[F.tid] = g[h] + a.in[I_GATEB][h];
        bcum[F.tid] = fminf(fp, 0.f) - log1pf(__expf(-fabsf(fp))); }
    __syncthreads();
    if (F.tid == 0) { float s = 0.f; for (int i = 0; i < 64; ++i) { s += bcum[i]; bcum[i] = s; } }
    const float* cw = a.in[I_CONVW]; const float* cb = a.in[I_CONVB];
    for (int idx = F.tid; idx < 64 * 128; idx += NTHREADS) { const int t = idx >> 7, d = idx & 127, ch = h * 128 + d;
        float accq = cb[ch], acck = cb[512 + ch];
#pragma unroll
        for (int j = 0; j < 4; ++j) { const int tt = t0 + t - 3 + j; if (tt >= 0) { const size_t r = (size_t)b * SEQ + tt;
                if (WANTQ) accq += cw[j * 1024 + ch] * bf2f(qm[r * 512 + ch]);
                acck += cw[j * 1024 + 512 + ch] * bf2f(km[r * 512 + ch]); } }
        if (WANTQ) Qs[t * 129 + d] = siluf_(accq);
        Ks[t * 129 + d] = siluf_(acck) * 0.08838834764831845f;
        Vs[t * 129 + d] = bf2f(vm[(row0 + t) * 512 + ch]); }
    __syncthreads();
}
__device__ __forceinline__ void mlstm_local_unit(const Args& a, Frame& F, int unit) {
    const int c = unit & 63, h = (unit >> 6) & 3, b = unit >> 8;
    mlstm_load_chunk<false>(a, F, b, h, c);
    LAS float* Ks = (LAS float*)(F.lds + MK_OFF); LAS float* Vs = (LAS float*)(F.lds + MV_OFF);
    LAS float* bcum = (LAS float*)(F.lds + MVEC_OFF); LAS float* ig = bcum + 64; LAS float* wv = bcum + 128;
    const float blast = bcum[63];
    float g = -1e30f; if (F.tid < 64) g = blast - bcum[F.tid] + ig[F.tid];
    float mloc = 0.f;
    if (F.wave == 0) { mloc = wave_max(g); wv[F.tid] = __expf(g - mloc); if (F.tid == 0) { float* cs = (float*)(a.ws + WS_CSC) + (size_t)unit * 2; cs[0] = blast; cs[1] = mloc; } }
    __syncthreads();
    const int e = F.tid >> 2, dq = (F.tid & 3) * 32;
    float acc[32];
#pragma unroll
    for (int i = 0; i < 32; ++i) acc[i] = 0.f;
    for (int s = 0; s < 64; ++s) { const float vv = Vs[s * 129 + e] * wv[s];
#pragma unroll
        for (int i = 0; i < 32; ++i) acc[i] += vv * Ks[s * 129 + dq + i]; }
    bf16* st = (bf16*)(a.ws + WS_RB) + (size_t)unit * 16384 + e * 128 + dq;
#pragma unroll
    for (int i = 0; i < 32; i += 8) { v4u w; w.x = pk2(acc[i], acc[i + 1]); w.y = pk2(acc[i + 2], acc[i + 3]); w.z = pk2(acc[i + 4], acc[i + 5]); w.w = pk2(acc[i + 6], acc[i + 7]); *(v4u*)(st + i) = w; }
    if (F.tid < 128) { float s = 0.f; for (int t = 0; t < 64; ++t) s += wv[t] * Ks[t * 129 + F.tid]; ((float*)(a.ws + WS_NST))[(size_t)unit * 128 + F.tid] = s; }
    __syncthreads();
}
__device__ __forceinline__ void mlstm_scan(const Args& a, Frame& F) {
    const float* csc = (const float*)(a.ws + WS_CSC); float* mprev = (float*)(a.ws + WS_MPREV);
    bf16* st = (bf16*)(a.ws + WS_RB); float* nst = (float*)(a.ws + WS_NST);
    const int gt = F.vcu * NTHREADS + F.tid, NGT = F.G * NTHREADS;
    LAS float* tab = (LAS float*)F.lds;
    for (int idx = gt; idx < 64 * 2048; idx += NGT) { const int bh = idx >> 11, p = idx & 2047;
        __syncthreads();
        if (F.tid == 0) { float m = 0.f; for (int c = 0; c < 64; ++c) { const float bl = csc[(bh * 64 + c) * 2], ml = csc[(bh * 64 + c) * 2 + 1]; const float mn = fmaxf(bl + m, ml); tab[2 * c] = __expf(bl + m - mn); tab[2 * c + 1] = __expf(ml - mn); m = mn; } }
        __syncthreads();
        float cv[8];
#pragma unroll
        for (int i = 0; i < 8; ++i) cv[i] = 0.f;
        v4u* base = (v4u*)(st + (size_t)(bh * 64) * 16384) + p;
#pragma unroll 1
        for (int c0 = 0; c0 < 64; c0 += 8) { v4u uw[8];
#pragma unroll
            for (int k = 0; k < 8; ++k) uw[k] = base[(size_t)(c0 + k) * 2048];
#pragma unroll
            for (int k = 0; k < 8; ++k) { const int c = c0 + k;
                v4u o; o.x = pk2(cv[0], cv[1]); o.y = pk2(cv[2], cv[3]); o.z = pk2(cv[4], cv[5]); o.w = pk2(cv[6], cv[7]); base[(size_t)c * 2048] = o;
                const float dec = tab[2 * c], sc = tab[2 * c + 1];
                float x[8]; unpack8(uw[k], x);
#pragma unroll
                for (int i = 0; i < 8; ++i) cv[i] = dec * cv[i] + sc * x[i]; } } }
    __syncthreads();
    for (int idx = gt; idx < 64 * 128; idx += NGT) { const int bh = idx >> 7, d = idx & 127;
        float m = 0.f, n = 0.f;
        float* base = nst + (size_t)(bh * 64) * 128 + d;
#pragma unroll 1
        for (int c0 = 0; c0 < 64; c0 += 16) { float nl[16];
#pragma unroll
            for (int k = 0; k < 16; ++k) nl[k] = base[(size_t)(c0 + k) * 128];
#pragma unroll
            for (int k = 0; k < 16; ++k) { const int c = c0 + k; base[(size_t)c * 128] = n;
                if (d == 0) mprev[bh * 64 + c] = m;
                const float bl = csc[(bh * 64 + c) * 2], ml = csc[(bh * 64 + c) * 2 + 1];
                const float mn = fmaxf(bl + m, ml), dec = __expf(bl + m - mn), sc = __expf(ml - mn);
                n = dec * n + sc * nl[k]; m = mn; } } }
}
__device__ __forceinline__ void mlstm_out_unit(const Args& a, Frame& F, int unit) {
    const int c = unit & 63, h = (unit >> 6) & 3, b = unit >> 8;
    mlstm_load_chunk<true>(a, F, b, h, c);
    LAS float* Qs = (LAS float*)(F.lds + MQ_OFF); LAS float* Ks = (LAS float*)(F.lds + MK_OFF); LAS float* Vs = (LAS float*)(F.lds + MV_OFF); LAS float* Ss = (LAS float*)(F.lds + MS_OFF);
    LAS bf16* CT = (LAS bf16*)(F.lds + MCT_OFF);
    LAS float* bcum = (LAS float*)(F.lds + MVEC_OFF); LAS float* ig = bcum + 64; LAS float* mt = bcum + 128; LAS float* wi = bcum + 192; LAS float* den = bcum + 256; LAS float* nv = bcum + 320;
    const float mp = ((const float*)(a.ws + WS_MPREV))[unit];
    const bf16* ctg = (const bf16*)(a.ws + WS_RB) + (size_t)unit * 16384;
    for (int idx = F.tid; idx < 128 * 64; idx += NTHREADS) { const int e = idx >> 6, dp = idx & 63; *(LAS unsigned*)(CT + e * 130 + 2 * dp) = *(const unsigned*)(ctg + e * 128 + 2 * dp); }
    if (F.tid < 128) nv[F.tid] = ((const float*)(a.ws + WS_NST))[(size_t)unit * 128 + F.tid];
    if (F.tid < 64) { const int t = F.tid; const float bt = bcum[t], at = bt + mp; float mm = at;
        for (int s = 0; s <= t; ++s) mm = fmaxf(mm, bt - bcum[s] + ig[s]);
        mt[t] = mm; wi[t] = __expf(at - mm); }
    __syncthreads();
    { const int s = F.tid & 63, tb = (F.tid >> 6) * 8;
#pragma unroll
        for (int i = 0; i < 8; ++i) { const int t = tb + i; float v = 0.f;
            if (s <= t) { float d = 0.f; for (int k = 0; k < 128; ++k) d += Qs[t * 129 + k] * Ks[s * 129 + k]; v = d * __expf(bcum[t] - bcum[s] + ig[s] - mt[t]); }
            Ss[t * 65 + s] = v; } }
    __syncthreads();
    if (F.tid < 64) { const int t = F.tid; float sd = 0.f; for (int s = 0; s <= t; ++s) sd += Ss[t * 65 + s]; float qn = 0.f; for (int k = 0; k < 128; ++k) qn += Qs[t * 129 + k] * nv[k];
        den[t] = sd + wi[t] * qn; }
    const int t = F.tid >> 3, e0 = (F.tid & 7) * 16;
    float num[16], qc[16];
#pragma unroll
    for (int i = 0; i < 16; ++i) { num[i] = 0.f; qc[i] = 0.f; }
    for (int s = 0; s <= t; ++s) { const float sv = Ss[t * 65 + s];
#pragma unroll
        for (int i = 0; i < 16; ++i) num[i] += sv * Vs[s * 129 + e0 + i]; }
    for (int k = 0; k < 128; ++k) { const float qv = Qs[t * 129 + k];
#pragma unroll
        for (int i = 0; i < 16; ++i) qc[i] += qv * bf2f(CT[(e0 + i) * 130 + k]); }
    __syncthreads();
    const float dn = fmaxf(fabsf(den[t]), __expf(-mt[t])), wt = wi[t];
    float ss = 0.f;
#pragma unroll
    for (int i = 0; i < 16; ++i) { num[i] = (num[i] + wt * qc[i]) / dn; ss += num[i] * num[i]; }
    ss += __shfl_xor(ss, 1); ss += __shfl_xor(ss, 2); ss += __shfl_xor(ss, 4);
    const float rstd = rsqrtf(ss * (1.f / 128.f) + EPS);
    const size_t row = (size_t)b * SEQ + c * CHUNK + t; const int ch = h * 128 + e0;
    const bf16* om = (const bf16*)(a.ws + WS_RC + RC_OM) + row * 512 + ch; const float* hg = a.in[I_HGAIN] + ch;
    float o[16];
#pragma unroll
    for (int i = 0; i < 16; ++i) o[i] = sigmoidf_(bf2f(om[i])) * num[i] * rstd * hg[i];
    bf16* hm = (bf16*)(a.ws + WS_RA) + row * 1024 + ch;
#pragma unroll
    for (int i = 0; i < 16; i += 8) { v4u w; w.x = pk2(o[i], o[i + 1]); w.y = pk2(o[i + 2], o[i + 3]); w.z = pk2(o[i + 4], o[i + 5]); w.w = pk2(o[i + 6], o[i + 7]); *(v4u*)(hm + i) = w; }
    __syncthreads();
}

__device__ __forceinline__ void compress_l2(const Args& a, Frame& F) {
    LAS float* hid = (LAS float*)(F.lds + F.wave * 4096);
    const int gw = F.vcu * NWAVES + F.wave, NGW = F.G * NWAVES;
    for (int kv = 0; kv < 2; ++kv) {
        const float* P = (const float*)(a.ws + WS_RA) + (size_t)kv * 8192 * 512; const float* b1p = (const float*)(a.ws + WS_B1P) + kv * 16 * 256;
        const float* w2 = a.in[I_CW2] + (size_t)kv * 256 * 64; bf16* outp = (bf16*)(a.ws + WS_KCMP) + (size_t)kv * 8192 * 64;
        for (int r0 = gw; r0 < 8192; r0 += 4 * NGW) {
            float pv[4][8];
#pragma unroll
            for (int q = 0; q < 4; ++q) { const int m0 = r0 + q * NGW; const bool ok = m0 < 8192 && (m0 & 255) != NCMP;
#pragma unroll
                for (int jj = 0; jj < 4; ++jj) { const int cc = jj * 64 + F.lane; pv[q][2 * jj] = ok ? P[(size_t)m0 * 512 + cc] : 0.f; pv[q][2 * jj + 1] = ok ? P[(size_t)(m0 + 1) * 512 + 256 + cc] : 0.f; } }
            float bb[4];
#pragma unroll
            for (int jj = 0; jj < 4; ++jj) { float t = a.in[I_CB1][kv * 256 + jj * 64 + F.lane];
#pragma unroll
                for (int pt = 0; pt < 16; ++pt) t += b1p[pt * 256 + jj * 64 + F.lane];
                bb[jj] = t; }
#pragma unroll
            for (int q = 0; q < 4; ++q)
#pragma unroll
                for (int jj = 0; jj < 4; ++jj) hid[q * 256 + jj * 64 + F.lane] = siluf_(pv[q][2 * jj] + pv[q][2 * jj + 1] + bb[jj]);
            LDS_WAIT();
            float sacc[4]; const float b2 = a.in[I_CB2][kv * 64 + F.lane];
#pragma unroll
            for (int q = 0; q < 4; ++q) sacc[q] = b2;
#pragma unroll 1
            for (int c0 = 0; c0 < 256; c0 += 32) { float wv[32];
#pragma unroll
                for (int i = 0; i < 32; ++i) wv[i] = w2[(c0 + i) * 64 + F.lane];
#pragma unroll
                for (int i = 0; i < 32; ++i)
#pragma unroll
                    for (int q = 0; q < 4; ++q) sacc[q] += hid[q * 256 + c0 + i] * wv[i]; }
#pragma unroll
            for (int q = 0; q < 4; ++q) { const int m0 = r0 + q * NGW; if (m0 < 8192) outp[(size_t)m0 * 64 + F.lane] = ((m0 & 255) == NCMP) ? (bf16)0 : (bf16)f2bf(sacc[q]); }
            LDS_WAIT();
        }
    }
}

struct AttState { float m[4], l[4], o[4]; };
__device__ __forceinline__ void nsa_dot4(const bf16* krow, const LAS float* qs, float (&s)[4]) {
    s[0] = s[1] = s[2] = s[3] = 0.f;
#pragma unroll
    for (int c8 = 0; c8 < 8; ++c8) { const v4u kw = *(const v4u*)(krow + c8 * 8);
        float kf[8] = {bflo(kw.x), bfhi(kw.x), bflo(kw.y), bfhi(kw.y), bflo(kw.z), bfhi(kw.z), bflo(kw.w), bfhi(kw.w)};
#pragma unroll
        for (int h = 0; h < 4; ++h)
#pragma unroll
            for (int i = 0; i < 8; ++i) s[h] += kf[i] * qs[h * 64 + c8 * 8 + i]; }
}
__device__ __forceinline__ void nsa_attend(AttState& A, const bf16* Kb, const bf16* Vb, int base, int t, const LAS float* qs, LAS float* pl, int lane) {
    const int pos = base + lane; const bool valid = pos >= 0 && pos <= t;
    float s[4] = {0.f, 0.f, 0.f, 0.f};
    if (valid) nsa_dot4(Kb + (size_t)pos * 64, qs, s);
#pragma unroll
    for (int h = 0; h < 4; ++h) { const float mb = wave_max(valid ? s[h] : -1e30f), mn = fmaxf(A.m[h], mb), al = __expf(A.m[h] - mn), p = valid ? __expf(s[h] - mn) : 0.f;
        A.l[h] = A.l[h] * al + wave_sum(p); A.o[h] *= al; A.m[h] = mn; pl[h * 64 + lane] = p; }
    LDS_WAIT();
    const int k0 = base < 0 ? -base : 0, k1 = (t - base) < 63 ? (t - base) : 63;
    for (int kk = k0; kk <= k1; ++kk) { const float v = bf2f(Vb[(size_t)(base + kk) * 64 + lane]);
#pragma unroll
        for (int h = 0; h < 4; ++h) A.o[h] += pl[h * 64 + kk] * v; }
    LDS_WAIT();
}
__device__ __forceinline__ void nsa_query(const Args& a, Frame& F, int qid, LAS float* wl) {
    const int t = qid & 4095, g = (qid >> 12) & 1, b = qid >> 13, bg = b * 2 + g, lane = F.lane;
    const size_t row = (size_t)b * SEQ + t;
    unsigned char* rc = a.ws + WS_RC;
    LAS float* qs = wl; LAS float* pc = wl + 256; LAS float* ps = wl + 512; LAS float* pl = wl + 768;
    const bf16* qn = (const bf16*)(rc + RC_QN) + row * 512 + g * 256;
#pragma unroll
    for (int h = 0; h < 4; ++h) qs[h * 64 + lane] = bf2f(qn[h * 64 + lane]) * 0.6931471805599453f;
    const float* gg = (const float*)(rc + RC_GG) + row * 24 + g * 12;
    float gate[4][3];
#pragma unroll
    for (int h = 0; h < 4; ++h)
#pragma unroll
        for (int r = 0; r < 3; ++r) gate[h][r] = sigmoidf_(gg[h * 3 + r]);
    LDS_WAIT();
    const bf16* kc = (const bf16*)(a.ws + WS_KCMP) + (size_t)bg * 256 * 64; const bf16* vc = kc + (size_t)32 * 256 * 64;
    const int nvalid = t >= 31 ? ((t - 31) >> 4) + 1 : 0;
    float sc[4][4];
#pragma unroll
    for (int kk = 0; kk < 4; ++kk) { const int n = kk * 64 + lane; float s[4] = {0.f, 0.f, 0.f, 0.f}; if (n < nvalid) nsa_dot4(kc + (size_t)n * 64, qs, s);
#pragma unroll
        for (int h = 0; h < 4; ++h) sc[h][kk] = s[h]; }
    float psum[4] = {0.f, 0.f, 0.f, 0.f}, ocmp[4];
#pragma unroll
    for (int h = 0; h < 4; ++h) { float mx = -1e30f;
#pragma unroll
        for (int kk = 0; kk < 4; ++kk) if (kk * 64 + lane < nvalid) mx = fmaxf(mx, sc[h][kk]);
        mx = wave_max(mx); float e[4], l = 0.f;
#pragma unroll
        for (int kk = 0; kk < 4; ++kk) { e[kk] = (kk * 64 + lane < nvalid) ? __expf(sc[h][kk] - mx) : 0.f; l += e[kk]; }
        l = fmaxf(wave_sum(l), 1e-30f);
#pragma unroll
        for (int kk = 0; kk < 4; ++kk) { const float p = e[kk] / l; psum[kk] += p; pc[kk * 64 + lane] = p; }
        LDS_WAIT();
        float o = 0.f; for (int n = 0; n < nvalid; ++n) o += pc[n] * bf2f(vc[(size_t)n * 64 + lane]);
        ocmp[h] = o; LDS_WAIT(); }
#pragma unroll
    for (int kk = 0; kk < 4; ++kk) ps[kk * 64 + lane] = psum[kk];
    LDS_WAIT();
    const int cur = t >> 6;
    float imp = 0.f;
#pragma unroll
    for (int i = -1; i <= 3; ++i) { const int n = 4 * lane + i; if (n >= 0 && n < NCMP) imp += ps[n]; }
    const bool forced = (lane == 0) || (lane == cur) || (lane == cur - 1);
    const float val = (lane <= cur) ? (forced ? 1e4f : imp) : -1.f;
    int rank = 0;
    for (int i = 0; i < 64; ++i) { const float vi = __shfl(val, i); rank += (vi > val || (vi == val && i < lane)) ? 1 : 0; }
    const unsigned long long mask = __ballot(rank < 16);
    AttState S;
#pragma unroll
    for (int h = 0; h < 4; ++h) { S.m[h] = -1e30f; S.l[h] = 0.f; S.o[h] = 0.f; }
    const bf16* ks = (const bf16*)(rc + RC_KV + 2 * 16 * MiB) + (size_t)bg * 4096 * 64; const bf16* vs = (const bf16*)(rc + RC_KV + 3 * 16 * MiB) + (size_t)bg * 4096 * 64;
    for (int j = 0; j <= cur; ++j) if ((mask >> j) & 1ull) nsa_attend(S, ks, vs, 64 * j, t, qs, pl, lane);
    AttState W;
#pragma unroll
    for (int h = 0; h < 4; ++h) { W.m[h] = -1e30f; W.l[h] = 0.f; W.o[h] = 0.f; }
    const bf16* kw = (const bf16*)(rc + RC_KV + 4 * 16 * MiB) + (size_t)bg * 4096 * 64; const bf16* vw = (const bf16*)(rc + RC_KV + 5 * 16 * MiB) + (size_t)bg * 4096 * 64;
    for (int kk = 0; kk < 4; ++kk) { const int base = t - 255 + 64 * kk; if (base + 63 >= 0) nsa_attend(W, kw, vw, base, t, qs, pl, lane); }
    bf16* outp = (bf16*)(a.ws + WS_RA) + row * 1024 + 512 + g * 256;
#pragma unroll
    for (int h = 0; h < 4; ++h) { const float o = gate[h][0] * ocmp[h] + gate[h][1] * S.o[h] / fmaxf(S.l[h], 1e-30f) + gate[h][2] * W.o[h] / fmaxf(W.l[h], 1e-30f);
        outp[h * 64 + lane] = (bf16)f2bf(o); }
}

typedef float f32x16 __attribute__((ext_vector_type(16)));
typedef short s16x4 __attribute__((ext_vector_type(4)));
typedef float f32x2_t __attribute__((ext_vector_type(2))); typedef __bf16 bf16x2_t __attribute__((ext_vector_type(2)));
constexpr int NKS = 144, NVS = 192;
constexpr int NK_OFF = 0, NKBUF = 64 * NKS, NV_OFF = 4 * NKBUF, NVBUF = 64 * NVS, NPSW = 8 * 260, NPS_OFF = NV_OFF + 4 * NVBUF, NMASK_OFF = NPS_OFF + 8 * NPSW * 4, NWS_OFF = NMASK_OFF + 512, NSA_LDS_END = NWS_OFF + 8 * 256;
static_assert(NSA_LDS_END <= MISC_OFF, "nsa lds");
constexpr float L2E = 1.4426950408889634f;
__device__ __forceinline__ int crow(int r, int hi) { return (r & 3) + 8 * (r >> 2) + 4 * hi; }
__device__ __forceinline__ unsigned cvtpk(float lo, float hi) { f32x2_t v = {lo, hi}; bf16x2_t b = __builtin_convertvector(v, bf16x2_t); return __builtin_bit_cast(unsigned, b); }
__device__ __forceinline__ float max3f(float a, float b, float c) { float r; asm("v_max3_f32 %0, %1, %2, %3" : "=v"(r) : "v"(a), "v"(b), "v"(c)); return r; }
template <int CTRL> __device__ __forceinline__ float dpp_quad(float v) { return __builtin_bit_cast(float, __builtin_amdgcn_update_dpp(0, __builtin_bit_cast(int, v), CTRL, 0xF, 0xF, true)); }
__device__ __forceinline__ float swapmax(float v) { auto rr = __builtin_amdgcn_permlane32_swap(__float_as_uint(v), __float_as_uint(v), false, false); return fmaxf(__uint_as_float(rr[0]), __uint_as_float(rr[1])); }
__device__ __forceinline__ float swapsum(float v) { auto rr = __builtin_amdgcn_permlane32_swap(__float_as_uint(v), __float_as_uint(v), false, false); return __uint_as_float(rr[0]) + __uint_as_float(rr[1]); }
__device__ __forceinline__ s16x4 vtr(const LAS unsigned char* p) { typedef short v4i16_t __attribute__((ext_vector_type(4))); return __builtin_bit_cast(s16x4, __builtin_amdgcn_ds_read_tr16_b64_v4i16((LAS v4i16_t*)p)); }
__device__ __forceinline__ void nsa_qk(f32x16& p0, f32x16& p1, const LAS unsigned char* kb, const bf16x8 (&qr)[4], const f32x16& cinit, int r32, int hi) {
    const LAS unsigned char* kp = kb + r32 * NKS + hi * 16;
    bf16x8 kf[8];
#pragma unroll
    for (int d0 = 0; d0 < 4; ++d0) { kf[2 * d0] = *(const LAS bf16x8*)(kp + d0 * 32); kf[2 * d0 + 1] = *(const LAS bf16x8*)(kp + 32 * NKS + d0 * 32); }
    __builtin_amdgcn_sched_barrier(0);
    p0 = __builtin_amdgcn_mfma_f32_32x32x16_bf16(kf[0], qr[0], cinit, 0, 0, 0); p1 = __builtin_amdgcn_mfma_f32_32x32x16_bf16(kf[1], qr[0], cinit, 0, 0, 0);
#pragma unroll
    for (int d0 = 1; d0 < 4; ++d0) { p0 = __builtin_amdgcn_mfma_f32_32x32x16_bf16(kf[2 * d0], qr[d0], p0, 0, 0, 0); p1 = __builtin_amdgcn_mfma_f32_32x32x16_bf16(kf[2 * d0 + 1], qr[d0], p1, 0, 0, 0); }
}
__device__ __forceinline__ void nsa_vload(bf16x8 (&vf)[4], const LAS unsigned char* vb, int lane, int d0) {
    const int hi = lane >> 5, blk = (lane >> 4) & 1, q = (lane & 15) >> 2, p = lane & 3;
    const LAS unsigned char* base = vb + (4 * hi + q) * NVS + (16 * blk + 4 * p) * 2 + d0 * 64;
#pragma unroll
    for (int ks = 0; ks < 4; ++ks) { const s16x4 lo = vtr(base + (ks * 16) * NVS), hh = vtr(base + (ks * 16 + 8) * NVS);
        vf[ks] = (bf16x8){lo[0], lo[1], lo[2], lo[3], hh[0], hh[1], hh[2], hh[3]}; }
}
__device__ __forceinline__ void nsa_pv(f32x16& o, const bf16x8 (&vf)[4], const bf16x8 (&pa)[4]) {
#pragma unroll
    for (int ks = 0; ks < 4; ++ks) o = __builtin_amdgcn_mfma_f32_32x32x16_bf16(pa[ks], vf[ks], o, 0, 0, 0);
}
__device__ __forceinline__ void nsa_pack(bf16x8 (&pa)[4], const f32x16& p0, const f32x16& p1) {
    v4u w;
    w.x = cvtpk(p0[0], p0[1]); w.y = cvtpk(p0[2], p0[3]); w.z = cvtpk(p0[4], p0[5]); w.w = cvtpk(p0[6], p0[7]); pa[0] = __builtin_bit_cast(bf16x8, w);
    w.x = cvtpk(p0[8], p0[9]); w.y = cvtpk(p0[10], p0[11]); w.z = cvtpk(p0[12], p0[13]); w.w = cvtpk(p0[14], p0[15]); pa[1] = __builtin_bit_cast(bf16x8, w);
    w.x = cvtpk(p1[0], p1[1]); w.y = cvtpk(p1[2], p1[3]); w.z = cvtpk(p1[4], p1[5]); w.w = cvtpk(p1[6], p1[7]); pa[2] = __builtin_bit_cast(bf16x8, w);
    w.x = cvtpk(p1[8], p1[9]); w.y = cvtpk(p1[10], p1[11]); w.z = cvtpk(p1[12], p1[13]); w.w = cvtpk(p1[14], p1[15]); pa[3] = __builtin_bit_cast(bf16x8, w);
}
__device__ __forceinline__ void row_bcast(float v, LAS float* wsf, int r32, int hi, float (&f)[16]) {
    if (hi == 0) wsf[r32] = v;
#pragma unroll
    for (int r = 0; r < 16; ++r) f[r] = wsf[crow(r, hi)];
}
constexpr float NSA_THR = 5.f;
__device__ __forceinline__ void nsa_step(const int VAR, f32x16& p0, f32x16& p1, float& mhat, f32x16& negm, f32x16 (&o)[2], f32x16& ol, int diag, bool rowvalid, bool allvalid, int rel, const LAS unsigned char* vb, LAS float* wsf, int lane, int r32, int hi) {
    bf16x8 vf[4]; nsa_vload(vf, vb, lane, 0);
    __builtin_amdgcn_sched_barrier(0);
    asm volatile("s_nop 15\n\ts_nop 7" : "+v"(p0), "+v"(p1));
    if (diag == 1) {
#pragma unroll
        for (int r = 0; r < 16; ++r) { const int kv = crow(r, hi); p0[r] = kv <= rel ? p0[r] : -INFINITY; p1[r] = kv + 32 <= rel ? p1[r] : -INFINITY; }
    } else if (diag == 2) {
#pragma unroll
        for (int r = 0; r < 16; ++r) { const int kv = crow(r, hi); p0[r] = kv > rel ? p0[r] : -INFINITY; p1[r] = kv + 32 > rel ? p1[r] : -INFINITY; }
    }
    float mx = max3f(p0[0], p1[0], -INFINITY);
#pragma unroll
    for (int r = 1; r < 16; ++r) mx = max3f(mx, p0[r], p1[r]);
    mx = rowvalid ? mx : -INFINITY;
    mx = swapmax(mx);
    if (__any(mx > NSA_THR)) {
        const float dl = fmaxf(mx, 0.f); mhat += dl;
#pragma unroll
        for (int r = 0; r < 16; ++r) { p0[r] -= dl; p1[r] -= dl; negm[r] = -mhat; }
        float f[16]; row_bcast(__builtin_amdgcn_exp2f(-dl), wsf, r32, hi, f);
#pragma unroll
        for (int r = 0; r < 16; ++r) { o[0][r] *= f[r]; o[1][r] *= f[r]; ol[r] *= f[r]; } }
#pragma unroll
    for (int r = 0; r < 16; ++r) { if (VAR == 2) { p0[r] += 1.f; p1[r] += 1.f; } else { p0[r] = __builtin_amdgcn_exp2f(p0[r]); p1[r] = __builtin_amdgcn_exp2f(p1[r]); } }
    bf16x8 pa[4]; nsa_pack(pa, p0, p1);
    if (!allvalid) { const short km = rowvalid ? (short)-1 : (short)0;
#pragma unroll
        for (int k = 0; k < 4; ++k) { v4u w = __builtin_bit_cast(v4u, pa[k]); const unsigned mk = rowvalid ? 0xffffffffu : 0u; w.x &= mk; w.y &= mk; w.z &= mk; w.w &= mk; pa[k] = __builtin_bit_cast(bf16x8, w); }
        (void)km; }
    __builtin_amdgcn_sched_barrier(0);
    if (VAR != 3) { bf16x8 vg[4]; nsa_vload(vg, vb, lane, 1);
        __builtin_amdgcn_sched_barrier(0);
        nsa_pv(o[0], vf, pa);
        const bf16x8 ones = (bf16x8){0x3f80, 0x3f80, 0x3f80, 0x3f80, 0x3f80, 0x3f80, 0x3f80, 0x3f80};
#pragma unroll
        for (int ks = 0; ks < 4; ++ks) ol = __builtin_amdgcn_mfma_f32_32x32x16_bf16(pa[ks], ones, ol, 0, 0, 0);
        nsa_pv(o[1], vg, pa); }
}
__device__ __forceinline__ void nsa_unit(const int VAR, const Args& a, Frame& F, int bg, int qt, bf16* outbase) {
    const int lane = F.lane, r32 = lane & 31, hi = lane >> 5, w = F.wave, tid = F.tid;
    const int qi = r32 >> 2, h = r32 & 3, t0 = qt * 64, rel = 8 * w + qi, t = t0 + rel, cur = qt, b = bg >> 1, g = bg & 1;
    const size_t row = (size_t)b * SEQ + t;
    unsigned char* rc = a.ws + WS_RC;
    LAS float* PS = (LAS float*)(F.lds + NPS_OFF) + w * NPSW;
    LAS unsigned long long* MASKS = (LAS unsigned long long*)(F.lds + NMASK_OFF);
    LAS float* wsf = (LAS float*)(F.lds + NWS_OFF) + w * 64;
    const int srow = tid >> 3, sch = tid & 7;
    v4u kreg, vreg;
#define NSA_LOADK(ptr) kreg = *(const v4u*)((ptr) + srow * 64 + sch * 8)
#define NSA_LOADV(ptr) vreg = *(const v4u*)((ptr) + srow * 64 + sch * 8)
#define NSA_STOREK(bi) *(LAS v4u*)(F.lds + NK_OFF + (bi) * NKBUF + srow * NKS + sch * 16) = kreg
#define NSA_STOREV(bi) *(LAS v4u*)(F.lds + NV_OFF + (bi) * NVBUF + srow * NVS + sch * 16) = vreg
#define NSA_KB(bi) (F.lds + NK_OFF + (bi) * NKBUF)
#define NSA_VB(bi) (F.lds + NV_OFF + (bi) * NVBUF)
    bf16x8 qr[4];
    { const bf16* qp = (const bf16*)(rc + RC_QN) + row * 512 + (g * 4 + h) * 64 + hi * 8;
#pragma unroll
      for (int d0 = 0; d0 < 4; ++d0) qr[d0] = *(const bf16x8*)(qp + d0 * 16); }
    float g0, g1, g2;
    { const float* gg = (const float*)(rc + RC_GG) + row * 24 + (g * 4 + h) * 3; g0 = sigmoidf_(gg[0]); g1 = sigmoidf_(gg[1]); g2 = sigmoidf_(gg[2]); }
    f32x16 o[2], p0, p1, ol, negm, zero16;
#pragma unroll
    for (int i = 0; i < 16; ++i) zero16[i] = 0.f;
    float f16[16];
    const bf16* kc = (const bf16*)(a.ws + WS_KCMP) + (size_t)bg * 256 * 64; const bf16* vc = kc + (size_t)32 * 256 * 64;
    const int nvmax = (t0 / 16 + 3) < 255 ? (t0 / 16 + 3) : 255, nb = (VAR == 7) ? 0 : ((nvmax + 63) >> 6);
    const int nv = t >= 31 ? ((t - 31) >> 4) + 1 : 0;
    float m = -1e30f, l = 0.f;
    { v4u ck[4], cv[4];
#pragma unroll
      for (int cb = 0; cb < 4; ++cb) if (cb < nb) { ck[cb] = *(const v4u*)(kc + cb * 4096 + srow * 64 + sch * 8); cv[cb] = *(const v4u*)(vc + cb * 4096 + srow * 64 + sch * 8); }
#pragma unroll
      for (int cb = 0; cb < 4; ++cb) if (cb < nb) { *(LAS v4u*)(F.lds + NK_OFF + cb * NKBUF + srow * NKS + sch * 16) = ck[cb]; *(LAS v4u*)(F.lds + NV_OFF + cb * NVBUF + srow * NVS + sch * 16) = cv[cb]; } }
#pragma unroll
    for (int i = 0; i < 9; ++i) { const int idx = i * 256 + lane * 4; if (idx < NPSW) *(LAS f32x4*)(PS + idx) = (f32x4){0.f, 0.f, 0.f, 0.f}; }
    __syncthreads();
#pragma unroll 1
    for (int cb = 0; cb < nb; ++cb) {
        nsa_qk(p0, p1, NSA_KB(cb), qr, zero16, r32, hi);
        float mx = -1e30f;
#pragma unroll
        for (int r = 0; r < 16; ++r) { const int n0 = cb * 64 + crow(r, hi); p0[r] = n0 < nv ? p0[r] : -1e30f; p1[r] = n0 + 32 < nv ? p1[r] : -1e30f; mx = fmaxf(mx, fmaxf(p0[r], p1[r])); }
        mx = swapmax(mx);
        const float mnew = fmaxf(m, mx); l *= __builtin_amdgcn_exp2f(m - mnew); m = mnew; const float nm = mnew < -1e29f ? 0.f : -mnew;
        float s = 0.f;
#pragma unroll
        for (int r = 0; r < 16; ++r) s += __builtin_amdgcn_exp2f(p0[r] + nm) + __builtin_amdgcn_exp2f(p1[r] + nm);
        l += s;
    }
    l = swapsum(l);
    const float inv_l = 1.f / l, nmc = m < -1e29f ? 0.f : -m;
#pragma unroll
    for (int i = 0; i < 16; ++i) { o[0][i] = 0.f; o[1][i] = 0.f; }
#pragma unroll 1
    for (int cb = 0; cb < nb; ++cb) {
        nsa_qk(p0, p1, NSA_KB(cb), qr, zero16, r32, hi);
#pragma unroll
        for (int r = 0; r < 16; ++r) { const int n0 = cb * 64 + crow(r, hi);
            p0[r] = n0 < nv ? __builtin_amdgcn_exp2f(p0[r] + nmc) * inv_l : 0.f; p1[r] = n0 + 32 < nv ? __builtin_amdgcn_exp2f(p1[r] + nmc) * inv_l : 0.f;
            float v0 = p0[r], v1 = p1[r]; v0 += dpp_quad<0xB1>(v0); v1 += dpp_quad<0xB1>(v1); v0 += dpp_quad<0x4E>(v0); v1 += dpp_quad<0x4E>(v1);
            if (h == 0) { PS[qi * 260 + n0] = v0; PS[qi * 260 + n0 + 32] = v1; } }
        bf16x8 pa[4]; nsa_pack(pa, p0, p1);
        { bf16x8 vf[4], vg[4]; nsa_vload(vf, NSA_VB(cb), lane, 0); nsa_vload(vg, NSA_VB(cb), lane, 1); __builtin_amdgcn_sched_barrier(0); nsa_pv(o[0], vf, pa); nsa_pv(o[1], vg, pa); }
    }
    if (cur >= 16) {
#pragma unroll 1
        for (int qq = 0; qq < 8; ++qq) { const LAS float* pq = PS + qq * 260;
            const f32x4 q4 = *(const LAS f32x4*)(pq + 4 * lane);
            float imp = (q4[0] + q4[1]) + (q4[2] + q4[3]); if (lane > 0) imp += pq[4 * lane - 1];
            const bool forced = (lane == 0) || (lane == cur) || (lane == cur - 1);
            const float val = (lane <= cur) ? (forced ? 1e4f : imp) : -1.f;
            wsf[lane] = val;
            int rank = 0;
#pragma unroll
            for (int i4 = 0; i4 < 16; ++i4) { const f32x4 v4 = *(const LAS f32x4*)(wsf + 4 * i4);
#pragma unroll
                for (int e = 0; e < 4; ++e) { const int i = 4 * i4 + e; rank += (v4[e] > val || (v4[e] == val && i < lane)) ? 1 : 0; } }
            const unsigned long long mk = __ballot(rank < 16);
            if (lane == 0) MASKS[w * 8 + qq] = mk; }
    } else { if (lane < 8) MASKS[w * 8 + lane] = (2ull << cur) - 1ull; }
    __syncthreads();
    const unsigned long long mym = MASKS[w * 8 + qi];
    unsigned long long um = MASKS[lane];
#pragma unroll
    for (int off = 1; off < 64; off <<= 1) { const unsigned lo_ = __shfl_xor((unsigned)um, off), hi_ = __shfl_xor((unsigned)(um >> 32), off); um |= ((unsigned long long)hi_ << 32) | lo_; }
    um &= (2ull << cur) - 1ull;
    unsigned long long rem = ((unsigned long long)__builtin_amdgcn_readfirstlane((unsigned)(um >> 32)) << 32) | (unsigned)__builtin_amdgcn_readfirstlane((unsigned)um);
    row_bcast(g0, wsf, r32, hi, f16);
#pragma unroll
    for (int r = 0; r < 16; ++r) { PS[(2 * r) * 64 + lane] = o[0][r] * f16[r]; PS[(2 * r + 1) * 64 + lane] = o[1][r] * f16[r]; }
    const bf16* ks = (const bf16*)(rc + RC_KV + 2 * 16 * MiB) + (size_t)bg * 4096 * 64; const bf16* vs = (const bf16*)(rc + RC_KV + 3 * 16 * MiB) + (size_t)bg * 4096 * 64;
    const bf16* kw = (const bf16*)(rc + RC_KV + 4 * 16 * MiB) + (size_t)bg * 4096 * 64; const bf16* vw = (const bf16*)(rc + RC_KV + 5 * 16 * MiB) + (size_t)bg * 4096 * 64;
    float mhat = 0.f;
#pragma unroll
    for (int i = 0; i < 16; ++i) { o[0][i] = 0.f; o[1][i] = 0.f; ol[i] = 0.f; negm[i] = 0.f; }
    {
        const int j0w = cur >= 4 ? cur - 4 : 0;
        if (VAR == 6) rem = 0ull;
        int jc = __builtin_ctzll(rem | (1ull << 63)), wc = (VAR == 6) ? 1 : 0, buf = 0; rem &= rem - 1ull; if (VAR == 6) jc = cur;
        NSA_LOADK(ks + (size_t)jc * 4096); NSA_LOADV(vs + (size_t)jc * 4096); NSA_STOREK(0); NSA_STOREV(0); __syncthreads();
#pragma unroll 1
        for (;;) {
            bool has_next = true; int jn, wn;
            if (wc == 0) { if (rem != 0ull) { jn = __builtin_ctzll(rem); rem &= rem - 1ull; wn = 0; } else { jn = j0w; wn = 1; } }
            else { jn = jc + 1; wn = 1; has_next = jc < cur; }
            if (has_next && VAR != 1) { const bf16* kp = wn ? kw : ks; const bf16* vp = wn ? vw : vs; NSA_LOADK(kp + (size_t)jn * 4096); NSA_LOADV(vp + (size_t)jn * 4096); }
            const bool rv = wc ? true : (((mym >> jc) & 1ull) != 0ull);
            const int diag = (jc == cur) ? 1 : ((wc && jc == cur - 4) ? 2 : 0);
            if (__any(rv)) {
                nsa_qk(p0, p1, NSA_KB(buf), qr, negm, r32, hi);
                nsa_step(VAR, p0, p1, mhat, negm, o, ol, diag, rv, __all(rv), rel, NSA_VB(buf), wsf, lane, r32, hi); }
            if (has_next && VAR != 1) { NSA_STOREK(buf ^ 1); NSA_STOREV(buf ^ 1); }
            if (VAR != 4) __syncthreads();
            if (has_next && wn != wc) {
                row_bcast(g1, wsf, r32, hi, f16);
#pragma unroll
                for (int r = 0; r < 16; ++r) { const float fc = f16[r] * __builtin_amdgcn_rcpf(ol[r]); PS[(2 * r) * 64 + lane] += o[0][r] * fc; PS[(2 * r + 1) * 64 + lane] += o[1][r] * fc; o[0][r] = 0.f; o[1][r] = 0.f; ol[r] = 0.f; negm[r] = 0.f; }
                mhat = 0.f;
            }
            if (!has_next) break;
            jc = jn; wc = wn; buf ^= 1;
        }
    }
    row_bcast(g2, wsf, r32, hi, f16);
#pragma unroll
    for (int r = 0; r < 16; ++r) f16[r] *= __builtin_amdgcn_rcpf(ol[r]);
    bf16* outb = outbase + ((size_t)b * SEQ + t0 + 8 * w) * 1024 + 512 + g * 256 + r32;
    if (VAR == 0 || mhat == 12345.678f)
#pragma unroll
    for (int r = 0; r < 16; ++r) { const int rr = crow(r, hi), qo = rr >> 2, ho = rr & 3;
        outb[(size_t)qo * 1024 + ho * 64] = (bf16)f2bf(PS[(2 * r) * 64 + lane] + o[0][r] * f16[r]); outb[(size_t)qo * 1024 + ho * 64 + 32] = (bf16)f2bf(PS[(2 * r + 1) * 64 + lane] + o[1][r] * f16[r]); }
#undef NSA_LOADK
#undef NSA_LOADV
#undef NSA_STOREK
#undef NSA_STOREV
#undef NSA_KB
#undef NSA_VB
}

constexpr int ML_QS = 272, ML_VS = 320;
constexpr int ML_Q_OFF = 0, ML_K_OFF = 64 * ML_QS, ML_V_OFF = 2 * 64 * ML_QS, ML_CT_OFF = ML_V_OFF + 64 * ML_VS, ML_HS_OFF = ML_CT_OFF + 128 * ML_QS, ML_VEC_OFF = ML_HS_OFF + 128 * 65 * 4, ML_END = ML_VEC_OFF + 4096;
static_assert(ML_END <= MISC_OFF && 2 * 67 * 256 <= 128 * ML_QS, "mlstm mfma lds");
__device__ __forceinline__ void conv8(const LAS bf16* raw, int s, int c8, const float* cw, const float* cb, float (&out)[8]) {
    const f32x4 b0 = *(const f32x4*)(cb + c8 * 8), b1 = *(const f32x4*)(cb + c8 * 8 + 4);
    float acc[8] = {b0[0], b0[1], b0[2], b0[3], b1[0], b1[1], b1[2], b1[3]};
#pragma unroll
    for (int j = 0; j < 4; ++j) { float x[8]; unpack8(*(const LAS v4u*)(raw + (s + j) * 128 + c8 * 8), x);
        const f32x4 w0 = *(const f32x4*)(cw + j * 1024 + c8 * 8), w1 = *(const f32x4*)(cw + j * 1024 + c8 * 8 + 4);
        acc[0] += w0[0] * x[0]; acc[1] += w0[1] * x[1]; acc[2] += w0[2] * x[2]; acc[3] += w0[3] * x[3]; acc[4] += w1[0] * x[4]; acc[5] += w1[1] * x[5]; acc[6] += w1[2] * x[6]; acc[7] += w1[3] * x[7]; }
#pragma unroll
    for (int i = 0; i < 8; ++i) out[i] = siluf_(acc[i]);
}
__device__ __forceinline__ void mlstm_gates(const Args& a, Frame& F, int h, size_t row0, LAS float* bcum, LAS float* ig) {
    if (F.wave == 0) { const float* g = (const float*)(a.ws + WS_RC + RC_IF) + (row0 + F.lane) * 8; const float fp = g[4 + h] + a.in[I_GATEB][4 + h];
        ig[F.lane] = g[h] + a.in[I_GATEB][h];
        float v = fminf(fp, 0.f) - log1pf(__expf(-fabsf(fp)));
#pragma unroll
        for (int off = 1; off < 64; off <<= 1) { const float u = __shfl_up(v, off); if (F.lane >= off) v += u; }
        bcum[F.lane] = v; }
}
__device__ __forceinline__ void mlstm_stage_raw(Frame& F, const bf16* src, int b, int h, int t0, LAS bf16* raw) {
    for (int idx = F.tid; idx < 67 * 16; idx += NTHREADS) { const int rr = idx >> 4, c8 = idx & 15, tt = t0 - 3 + rr;
        v4u v = (v4u){0u, 0u, 0u, 0u}; if (tt >= 0) v = *(const v4u*)(src + ((size_t)b * SEQ + tt) * 512 + h * 128 + c8 * 8);
        *(LAS v4u*)(raw + rr * 128 + c8 * 8) = v; }
}
__device__ __forceinline__ void conv8r(const v4u (&tap)[4], int c8, const float* cw, const float* cb, float (&out)[8]) {
    const f32x4 b0 = *(const f32x4*)(cb + c8 * 8), b1 = *(const f32x4*)(cb + c8 * 8 + 4);
    float acc[8] = {b0[0], b0[1], b0[2], b0[3], b1[0], b1[1], b1[2], b1[3]};
#pragma unroll
    for (int j = 0; j < 4; ++j) { float x[8]; unpack8(tap[j], x);
        const f32x4 w0 = *(const f32x4*)(cw + j * 1024 + c8 * 8), w1 = *(const f32x4*)(cw + j * 1024 + c8 * 8 + 4);
        acc[0] += w0[0] * x[0]; acc[1] += w0[1] * x[1]; acc[2] += w0[2] * x[2]; acc[3] += w0[3] * x[3]; acc[4] += w1[0] * x[4]; acc[5] += w1[1] * x[5]; acc[6] += w1[2] * x[6]; acc[7] += w1[3] * x[7]; }
#pragma unroll
    for (int i = 0; i < 8; ++i) out[i] = siluf_(acc[i]);
}
__device__ __forceinline__ void load_taps(v4u (&tap)[4], const bf16* src, int b, int h, int t0, int s, int c8) {
#pragma unroll
    for (int j = 0; j < 4; ++j) { const int tt = t0 + s - 3 + j; tap[j] = (v4u){0u, 0u, 0u, 0u}; if (tt >= 0) tap[j] = *(const v4u*)(src + ((size_t)b * SEQ + tt) * 512 + h * 128 + c8 * 8); }
}
__device__ __forceinline__ void mlstm_gates_lane(const Args& a, int h, size_t row0, int lane, float& igv, float& bc) {
    const float* g = (const float*)(a.ws + WS_RC + RC_IF) + (row0 + lane) * 8; const float fp = g[4 + h] + a.in[I_GATEB][4 + h];
    igv = g[h] + a.in[I_GATEB][h];
    float v = fminf(fp, 0.f) - log1pf(__expf(-fabsf(fp)));
#pragma unroll
    for (int off = 1; off < 64; off <<= 1) { const float u = __shfl_up(v, off); if (lane >= off) v += u; }
    bc = v;
}
__device__ __forceinline__ void mlstm_local_mfma(const Args& a, Frame& F, int unit) {
    const int c = unit & 63, h = (unit >> 6) & 3, b = unit >> 8, t0 = c * CHUNK, lane = F.lane, w = F.wave, hi = lane >> 5, r32 = lane & 31;
    const size_t row0 = (size_t)b * SEQ + t0;
    unsigned char* rc = a.ws + WS_RC;
    LAS unsigned char* LK = F.lds; LAS unsigned char* LV = F.lds + 64 * ML_VS;
    v4u tk[2][4], vv[2];
#pragma unroll
    for (int u = 0; u < 2; ++u) { const int it = F.tid + u * NTHREADS, s = it >> 4, c8 = it & 15;
        load_taps(tk[u], (const bf16*)(rc + RC_KM), b, h, t0, s, c8);
        vv[u] = *(const v4u*)((const bf16*)(rc + RC_VM) + (row0 + s) * 512 + h * 128 + c8 * 8); }
    float igv, bc; mlstm_gates_lane(a, h, row0, lane, igv, bc);
    const float blast = __shfl(bc, 63), gv = blast - bc + igv, mloc = wave_max(gv), wvv = __expf(gv - mloc);
    if (F.tid == 0) { float* cs = (float*)(a.ws + WS_CSC) + (size_t)unit * 2; cs[0] = blast; cs[1] = mloc; }
    __syncthreads();
    { const float* cw = a.in[I_CONVW] + 512 + h * 128; const float* cb = a.in[I_CONVB] + 512 + h * 128;
#pragma unroll
      for (int u = 0; u < 2; ++u) { const int it = F.tid + u * NTHREADS, s = it >> 4, c8 = it & 15; float k8[8]; conv8r(tk[u], c8, cw, cb, k8);
          const float sc = 0.08838834764831845f * __shfl(wvv, s & 63);
          v4u o; o.x = pk2(k8[0] * sc, k8[1] * sc); o.y = pk2(k8[2] * sc, k8[3] * sc); o.z = pk2(k8[4] * sc, k8[5] * sc); o.w = pk2(k8[6] * sc, k8[7] * sc);
          *(LAS v4u*)(LK + s * ML_VS + c8 * 16) = o; *(LAS v4u*)(LV + s * ML_VS + c8 * 16) = vv[u]; } }
    __syncthreads();
    if (F.tid < 128) { float sacc = 0.f; for (int s = 0; s < 64; ++s) sacc += bf2f(*(const LAS bf16*)(LK + s * ML_VS + F.tid * 2)); ((float*)(a.ws + WS_NST))[(size_t)unit * 128 + F.tid] = sacc; }
    const int et = w >> 1, dt0 = (w & 1) * 2, blk = (lane >> 4) & 1, q = (lane & 15) >> 2, p = lane & 3;
    f32x16 acc[2];
#pragma unroll
    for (int i = 0; i < 16; ++i) { acc[0][i] = 0.f; acc[1][i] = 0.f; }
    const LAS unsigned char* abase = LV + (8 * hi + q) * ML_VS + (et * 32 + 16 * blk + 4 * p) * 2;
    const LAS unsigned char* bbase = LK + (8 * hi + q) * ML_VS + (dt0 * 32 + 16 * blk + 4 * p) * 2;
#pragma unroll
    for (int ks = 0; ks < 4; ++ks) { const s16x4 a0 = vtr(abase + ks * 16 * ML_VS), a1 = vtr(abase + (ks * 16 + 4) * ML_VS);
        const bf16x8 af = (bf16x8){a0[0], a0[1], a0[2], a0[3], a1[0], a1[1], a1[2], a1[3]};
#pragma unroll
        for (int n = 0; n < 2; ++n) { const s16x4 b0 = vtr(bbase + ks * 16 * ML_VS + n * 64), b1 = vtr(bbase + (ks * 16 + 4) * ML_VS + n * 64);
            const bf16x8 bfr = (bf16x8){b0[0], b0[1], b0[2], b0[3], b1[0], b1[1], b1[2], b1[3]};
            acc[n] = __builtin_amdgcn_mfma_f32_32x32x16_bf16(af, bfr, acc[n], 0, 0, 0); } }
    bf16* st = (bf16*)(a.ws + WS_RB) + (size_t)unit * 16384;
#pragma unroll
    for (int n = 0; n < 2; ++n)
#pragma unroll
        for (int r = 0; r < 16; ++r) st[(et * 32 + crow(r, hi)) * 128 + (dt0 + n) * 32 + r32] = (bf16)f2bf(acc[n][r]);
}
__device__ __forceinline__ void mlstm_out_mfma(const Args& a, Frame& F, int unit) {
    const int c = unit & 63, h = (unit >> 6) & 3, b = unit >> 8, t0 = c * CHUNK, lane = F.lane, w = F.wave, hi = lane >> 5, r32 = lane & 31;
    const size_t row0 = (size_t)b * SEQ + t0;
    unsigned char* rc = a.ws + WS_RC;
    LAS unsigned char* QB = F.lds + ML_Q_OFF; LAS unsigned char* KB = F.lds + ML_K_OFF; LAS unsigned char* VB = F.lds + ML_V_OFF;
    LAS float* HS = (LAS float*)(F.lds + ML_HS_OFF);
    LAS float* bcum = (LAS float*)(F.lds + ML_VEC_OFF); LAS float* ig = bcum + 64; LAS float* nv = bcum + 192; LAS float* ssq = bcum + 320;
    v4u tq[2][4], tk[2][4], vv[2];
#pragma unroll
    for (int u = 0; u < 2; ++u) { const int it = F.tid + u * NTHREADS, s = it >> 4, c8 = it & 15;
        load_taps(tq[u], (const bf16*)(rc + RC_QM), b, h, t0, s, c8); load_taps(tk[u], (const bf16*)(rc + RC_KM), b, h, t0, s, c8);
        vv[u] = *(const v4u*)((const bf16*)(rc + RC_VM) + (row0 + s) * 512 + h * 128 + c8 * 8); }
    const bf16* ctg = (const bf16*)(a.ws + WS_RB) + (size_t)unit * 16384;
    const int te = F.tid >> 3, e0 = (F.tid & 7) * 16;
    float nvr = 0.f; if (F.tid < 128) nvr = ((const float*)(a.ws + WS_NST))[(size_t)unit * 128 + F.tid];
    const float mp = ((const float*)(a.ws + WS_MPREV))[unit];
    float igv = 0.f, bc = 0.f; if (w == 0) mlstm_gates_lane(a, h, row0, lane, igv, bc);
    __syncthreads();
    if (w == 0) { ig[lane] = igv - bc; bcum[lane] = bc; }
    if (F.tid < 128) nv[F.tid] = nvr;
    { const float* cwq = a.in[I_CONVW] + h * 128; const float* cbq = a.in[I_CONVB] + h * 128;
#pragma unroll
      for (int u = 0; u < 2; ++u) { const int it = F.tid + u * NTHREADS, s = it >> 4, c8 = it & 15; float x8[8];
          conv8r(tq[u], c8, cwq, cbq, x8);
          v4u o; o.x = pk2(x8[0], x8[1]); o.y = pk2(x8[2], x8[3]); o.z = pk2(x8[4], x8[5]); o.w = pk2(x8[6], x8[7]);
          *(LAS v4u*)(QB + s * ML_QS + c8 * 16) = o;
          conv8r(tk[u], c8, cwq + 512, cbq + 512, x8); const float sc = 0.08838834764831845f;
          o.x = pk2(x8[0] * sc, x8[1] * sc); o.y = pk2(x8[2] * sc, x8[3] * sc); o.z = pk2(x8[4] * sc, x8[5] * sc); o.w = pk2(x8[6] * sc, x8[7] * sc);
          *(LAS v4u*)(KB + s * ML_QS + c8 * 16) = o;
          *(LAS v4u*)(VB + s * ML_VS + c8 * 16) = vv[u]; } }
    __syncthreads();
    const int et = w & 3, tt = w >> 2, t = tt * 32 + r32, blk = (lane >> 4) & 1, q = (lane & 15) >> 2, p = lane & 3;
    bf16x8 cf[8];
#pragma unroll
    for (int d0 = 0; d0 < 8; ++d0) cf[d0] = *(const bf16x8*)(ctg + (et * 32 + r32) * 128 + d0 * 16 + hi * 8);
    v4u omr[2]; { const bf16* om = (const bf16*)(rc + RC_OM) + (row0 + te) * 512 + h * 128 + e0; omr[0] = *(const v4u*)om; omr[1] = *(const v4u*)(om + 8); }
    bf16x8 qf[8];
#pragma unroll
    for (int d0 = 0; d0 < 8; ++d0) qf[d0] = *(const LAS bf16x8*)(QB + t * ML_QS + d0 * 32 + hi * 16);
    float qn = 0.f;
#pragma unroll
    for (int d0 = 0; d0 < 8; ++d0) { float x[8]; unpack8(__builtin_bit_cast(v4u, qf[d0]), x); const f32x4 n0 = *(const LAS f32x4*)(nv + d0 * 16 + hi * 8), n1 = *(const LAS f32x4*)(nv + d0 * 16 + hi * 8 + 4);
        qn += x[0] * n0[0] + x[1] * n0[1] + x[2] * n0[2] + x[3] * n0[3] + x[4] * n1[0] + x[5] * n1[1] + x[6] * n1[2] + x[7] * n1[3]; }
    qn = swapsum(qn);
    f32x16 p0, p1;
#pragma unroll
    for (int i = 0; i < 16; ++i) { p0[i] = 0.f; p1[i] = 0.f; }
#pragma unroll
    for (int hf = 0; hf < 2; ++hf) { bf16x8 kf[8];
#pragma unroll
        for (int dd = 0; dd < 4; ++dd) { const int d0 = hf * 4 + dd; kf[2 * dd] = *(const LAS bf16x8*)(KB + r32 * ML_QS + d0 * 32 + hi * 16); kf[2 * dd + 1] = *(const LAS bf16x8*)(KB + (32 + r32) * ML_QS + d0 * 32 + hi * 16); }
        __builtin_amdgcn_sched_barrier(0);
#pragma unroll
        for (int dd = 0; dd < 4; ++dd) { const int d0 = hf * 4 + dd; p0 = __builtin_amdgcn_mfma_f32_32x32x16_bf16(kf[2 * dd], qf[d0], p0, 0, 0, 0); p1 = __builtin_amdgcn_mfma_f32_32x32x16_bf16(kf[2 * dd + 1], qf[d0], p1, 0, 0, 0); } }
    const float bt = bcum[t], at = bt + mp;
    float mt = at;
#pragma unroll
    for (int r = 0; r < 16; ++r) { const int s0 = crow(r, hi), s1 = s0 + 32; const float a0 = ig[s0], a1 = ig[s1];
        if (s0 <= t) mt = fmaxf(mt, bt + a0); if (s1 <= t) mt = fmaxf(mt, bt + a1); }
    mt = swapmax(mt);
    float sden = 0.f;
#pragma unroll
    for (int r = 0; r < 16; ++r) { const int s0 = crow(r, hi), s1 = s0 + 32; const float a0 = ig[s0], a1 = ig[s1];
        p0[r] = s0 <= t ? p0[r] * __expf(bt + a0 - mt) : 0.f; p1[r] = s1 <= t ? p1[r] * __expf(bt + a1 - mt) : 0.f; sden += p0[r] + p1[r]; }
    sden = swapsum(sden);
    const float wi = __expf(at - mt), den = sden + wi * qn, dn = fmaxf(fabsf(den), __expf(-mt));
    bf16x8 pa[4]; nsa_pack(pa, p0, p1);
    f32x16 acc, acc2;
#pragma unroll
    for (int i = 0; i < 16; ++i) { acc[i] = 0.f; acc2[i] = 0.f; }
    { const LAS unsigned char* vbase = VB + (4 * hi + q) * ML_VS + (et * 32 + 16 * blk + 4 * p) * 2;
#pragma unroll
      for (int ks = 0; ks < 4; ++ks) { const s16x4 a0 = vtr(vbase + ks * 16 * ML_VS), a1 = vtr(vbase + (ks * 16 + 8) * ML_VS);
          const bf16x8 af = (bf16x8){a0[0], a0[1], a0[2], a0[3], a1[0], a1[1], a1[2], a1[3]};
          acc = __builtin_amdgcn_mfma_f32_32x32x16_bf16(af, pa[ks], acc, 0, 0, 0); } }
#pragma unroll
    for (int d0 = 0; d0 < 8; ++d0) acc2 = __builtin_amdgcn_mfma_f32_32x32x16_bf16(cf[d0], qf[d0], acc2, 0, 0, 0);
    float ss = 0.f; const float rdn = 1.f / dn;
#pragma unroll
    for (int r = 0; r < 16; ++r) { const float hv = (acc[r] + wi * acc2[r]) * rdn; ss += hv * hv; HS[(et * 32 + crow(r, hi)) * 65 + t] = hv; }
    ss = swapsum(ss);
    if (hi == 0) ssq[et * 64 + t] = ss;
    __syncthreads();
    { const float rstd = rsqrtf((ssq[te] + ssq[64 + te] + ssq[128 + te] + ssq[192 + te]) * (1.f / 128.f) + EPS);
      const size_t row = row0 + te; const int ch = h * 128 + e0;
      const float* hg = a.in[I_HGAIN] + ch;
      float o[16], og[16]; unpack8(omr[0], *(float(*)[8])&og[0]); unpack8(omr[1], *(float(*)[8])&og[8]);
#pragma unroll
      for (int i = 0; i < 16; ++i) o[i] = sigmoidf_(og[i]) * HS[(e0 + i) * 65 + te] * rstd * hg[i];
      bf16* hm = (bf16*)(a.ws + WS_RA) + row * 1024 + ch;
#pragma unroll
      for (int i = 0; i < 16; i += 8) { v4u wv4; wv4.x = pk2(o[i], o[i + 1]); wv4.y = pk2(o[i + 2], o[i + 3]); wv4.z = pk2(o[i + 4], o[i + 5]); wv4.w = pk2(o[i + 6], o[i + 7]); *(v4u*)(hm + i) = wv4; } }
}

__global__ void __launch_bounds__(NTHREADS, 2) mk_fwd(Args args) {
    extern __shared__ __attribute__((aligned(16))) unsigned char lds[];
    Frame F;
    F.lds = (LAS unsigned char*)lds;
    F.tid = threadIdx.x; F.lane = F.tid & 63; F.wave = __builtin_amdgcn_readfirstlane(F.tid >> 6);
    F.G = gridDim.x; { const int bx = blockIdx.x; F.vcu = (F.G % 8 == 0) ? (bx % 8) * (F.G / 8) + bx / 8 : bx; }
    volatile LAS unsigned* MISC = (volatile LAS unsigned*)(F.lds + MISC_OFF);
    if (F.tid < 64) MISC[F.tid] = 0u;
    __syncthreads();
    unsigned char* ws = args.ws;
    gu32* ctl = (gu32*)(ws + WS_CTL);
    XcdBarrier bar; bar.bar = (unsigned*)ctl + CW_BAR; bar.x = 0; bar.st = nullptr;
    if (MK_N_LAUNCHES == 1) bar = xcd_barrier_post((unsigned*)ctl + CW_BAR, MISC + 8);
    const int lo = args.ph_lo, hi = args.ph_hi;
#define IN(k) (lo <= (k) && (k) < hi)
#define SEAM(k) do { if (IN(k) && IN((k) + 1)) xcd_barrier(bar); } while (0)
    bf16* U = (bf16*)(ws + WS_RA); bf16* Fb = (bf16*)(ws + WS_RB); bf16* HID = (bf16*)(ws + WS_RC);
    PG8_LAS unsigned char* ring = (PG8_LAS unsigned char*)lds;

    if (IN(0)) { p0_prologue(args, F); } SEAM(0);
    if (IN(1)) { thin_phase<0, false, false, true>(args, F, args.in[I_X], nullptr, nullptr, U, 0, 0, 0.f);
        { LAS unsigned* scr = (LAS unsigned*)(F.lds + F.wave * 16384); const int gw = F.vcu * NWAVES + F.wave, NGW = F.G * NWAVES; constexpr int I_Q = (DM / 64) * (NPROJ / 64);
          const unsigned* am = (const unsigned*)(ws + WS_CTL) + CW_AMAX;
          for (int it = gw; it < 3 * I_Q; it += NGW) { const int layer = it / I_Q, r = it - layer * I_Q;
              if (layer < 2) quant_item_i8<0>(args, layer, DM, NPROJ, (unsigned char*)(ws + WS_W1T) + (size_t)layer * NPROJ * DM, am + layer * NPROJ, (float*)(ws + WS_CS1) + layer * NPROJ, scr, r, F.lane);
              else quant_item_i8<2>(args, 0, DM, NPROJ, (unsigned char*)(ws + WS_WIN), am + 2 * NPROJ, (float*)(ws + WS_CS1) + 2 * NPROJ, scr, r, F.lane); } }
    } SEAM(1);
    if (IN(2)) { pg8::Gemm g{U, (const bf16*)(ws + WS_W1T), T, NPROJ, DM / 2, DM / 2, DM / 2, 0}; pg8::StaticOrder S; S.init(T, NPROJ, F.G, (int)blockIdx.x);
        pg8::EpiSwiGLUI8<DOWN_F8_0> E{(unsigned char*)HID, (const float*)(ws + WS_RS), (const float*)(ws + WS_CS1)}; pg8::gemm_phase<pg8::EpiSwiGLUI8<DOWN_F8_0>, pg8::StaticOrder, true, true, false, 0x7f7f7f7f, 0x7f7f7f7f, true>(ring, g, S, E); } SEAM(2);
    if (IN(3)) { pg8::StaticOrder S; S.init(T, DM, F.G, (int)blockIdx.x); pg8::EpiStore E{Fb, DM}; const bf16* wd = (const bf16*)(ws + WS_W1D);
        if constexpr (DOWN_F8_0) { pg8::Gemm g{HID, wd, T, DM, DFF / 2, DFF / 2, DFF / 2, 0}; pg8::gemm_phase<pg8::EpiStore, pg8::StaticOrder, true, true, true, 0x75757575, 0x7c7c7c7c>(ring, g, S, E); }
        else { pg8::Gemm g{HID, wd, T, DM, DFF, DFF, DFF, 0}; pg8::gemm_phase<pg8::EpiStore, pg8::StaticOrder, true, true>(ring, g, S, E); } } SEAM(3);
    if (IN(4)) { thin_phase<1, false, true, true>(args, F, args.in[I_X], Fb, args.out, U, 0, 1, 0.5f); } SEAM(4);
    if (IN(5)) { pg8::Gemm g{U, (const bf16*)(ws + WS_WIN), T, NPROJ, DM / 2, DM / 2, DM / 2, 0}; pg8::StaticOrder S; S.init(T, NPROJ, F.G, (int)blockIdx.x);
        pg8::EpiProj E{ws + WS_RC, (const float*)(ws + WS_RS), (const float*)(ws + WS_CS1) + 2 * NPROJ}; pg8::gemm_phase<pg8::EpiProj, pg8::StaticOrder, true, true, false, 0x7f7f7f7f, 0x7f7f7f7f, true>(ring, g, S, E); } SEAM(5);
    if (IN(6)) {
        const int bx = (int)blockIdx.x;
        if (bx < 128) { const int kv = bx >> 6; pg8::Gemm g{(const bf16*)(ws + WS_RC + RC_KV + (size_t)kv * 16 * MiB), (const bf16*)(ws + WS_WC1) + (size_t)kv * 512 * 1024, 8192, 512, 1024, 1024, 1024, 0};
            pg8::StaticOrder S; S.init(8192, 512, 64, bx & 63);
            pg8::EpiStoreF32 E{(float*)(ws + WS_RA) + (size_t)kv * 8192 * 512, 512}; pg8::gemm_phase<pg8::EpiStoreF32, pg8::StaticOrder, false, true>(ring, g, S, E); }
        __syncthreads();
#ifdef MLSTM_REF
        for (;;) { if (F.tid == 0) MISC[16] = atomicAdd((unsigned*)ctl + CW_QUEUE, 1u); __syncthreads(); const unsigned unit = MISC[16]; __syncthreads(); if (unit >= 4096u) break; mlstm_local_unit(args, F, (int)unit); }
#else
        { unsigned ticket = 0u; if (F.tid == 0) ticket = atomicAdd((unsigned*)ctl + CW_QUEUE, 1u);
          for (;;) { unsigned nxt = 0u;
              if (F.tid == 0) { MISC[16] = ticket; nxt = atomicAdd((unsigned*)ctl + CW_QUEUE, 1u); }
              __syncthreads(); const unsigned unit = MISC[16]; __syncthreads(); if (unit >= 4096u) break;
              mlstm_local_mfma(args, F, (int)unit); ticket = nxt; } }
#endif
    } SEAM(6);
    if (IN(7)) {
#ifdef PROBE_P7_PART
        if (!(hi - lo == 1 && PROBE_P7_PART == 2)) mlstm_scan(args, F);
        if (!(hi - lo == 1 && PROBE_P7_PART == 1)) compress_l2(args, F);
#else
        mlstm_scan(args, F); compress_l2(args, F);
#endif
    } SEAM(7);
    if (IN(8)) {
#ifdef MLSTM_REF
        for (int unit = F.vcu; unit < 4096; unit += F.G) mlstm_out_unit(args, F, unit);
#else
#ifdef PROBE_P8_PART
        if (!(hi - lo == 1 && PROBE_P8_PART == 2))
#endif
        for (int unit = F.vcu; unit < 4096; unit += F.G) mlstm_out_mfma(args, F, unit);
#endif
        __syncthreads();
#ifdef NSA_DEBUG
        xcd_barrier(bar);
        for (int pidx = F.vcu; pidx < 1024; pidx += F.G) { const int bg = pidx >> 5, i = pidx & 31; nsa_unit(0, args, F, bg, 63 - i, (bf16*)(ws + WS_RC + RC_QM)); nsa_unit(0, args, F, bg, i, (bf16*)(ws + WS_RC + RC_QM)); }
        __syncthreads();
        { LAS float* wl = (LAS float*)(F.lds + F.wave * 4096); const int gw = F.vcu * NWAVES + F.wave, NGW = F.G * NWAVES;
          for (int q = gw; q < NB * NG * SEQ; q += NGW) nsa_query(args, F, q, wl); }
        xcd_barrier(bar);
        { const bf16* A = (const bf16*)(ws + WS_RA + 64 * MiB); const bf16* B = (const bf16*)(ws + WS_RC + RC_QM); float sd = 0.f, sa = 0.f;
          for (size_t i = (size_t)F.vcu * NTHREADS + F.tid; i < (size_t)T * 512; i += (size_t)F.G * NTHREADS) { const float x = bf2f(A[i]), y = bf2f(B[i]); sd += (x - y) * (x - y); sa += x * x; }
          sd = wave_sum(sd); sa = wave_sum(sa);
          if (F.lane == 0) { atomicAdd((float*)ctl + 80, sd); atomicAdd((float*)ctl + 81, sa); } }
#else
#ifdef PROBE_P8_PART
        if (!(hi - lo == 1 && PROBE_P8_PART == 1))
#endif
#ifdef PROBE_NSA_VAR
        { const int var = (hi - lo == 1) ? PROBE_NSA_VAR : 0;
        for (int pidx = F.vcu; pidx < 1024; pidx += F.G) { const int bg = pidx >> 5, i = pidx & 31; nsa_unit(var, args, F, bg, 63 - i, (bf16*)(ws + WS_RA)); nsa_unit(var, args, F, bg, i, (bf16*)(ws + WS_RA)); } }
#else
        for (int pidx = F.vcu; pidx < 1024; pidx += F.G) { const int bg = pidx >> 5, i = pidx & 31; nsa_unit(0, args, F, bg, 63 - i, (bf16*)(ws + WS_RA)); nsa_unit(0, args, F, bg, i, (bf16*)(ws + WS_RA)); }
#endif
#endif
    } SEAM(8);
    if (IN(9)) { pg8::Gemm g{(const bf16*)(ws + WS_RA), (const bf16*)(ws + WS_WUPM), T, DM, 512, 1024, 1024, 1024}; pg8::SegOrder S; S.init(T, DM, F.G, (int)blockIdx.x);
        pg8::EpiMergeFused E{(bf16*)(ws + WS_RC + RC_MERGED), (const bf16*)(ws + WS_RC + RC_GM), (const bf16*)(ws + WS_RC + RC_GN)};
        pg8::gemm_phase<pg8::EpiMergeFused, pg8::SegOrder, true, true>(ring, g, S, E); } SEAM(9);
    if (IN(10)) { pg8::Gemm g{(const bf16*)(ws + WS_RC + RC_MERGED), (const bf16*)(ws + WS_WOUT), T, DM, DM, DM, DM, 0}; pg8::StaticOrder S; S.init(T, DM, F.G, (int)blockIdx.x);
        pg8::EpiStore E{Fb, DM}; pg8::gemm_phase<pg8::EpiStore, pg8::StaticOrder, true, true>(ring, g, S, E); } SEAM(10);
    if (IN(11)) { thin_phase<1, true, true, true>(args, F, args.out, Fb, ws + WS_RC + 512 * MiB, U, 1, 2, 1.0f); } SEAM(11);
    if (IN(12)) { pg8::Gemm g{U, (const bf16*)(ws + WS_W1T + (size_t)NPROJ * DM), T, NPROJ, DM / 2, DM / 2, DM / 2, 0}; pg8::StaticOrder S; S.init(T, NPROJ, F.G, (int)blockIdx.x);
        pg8::EpiSwiGLUI8<DOWN_F8_1> E{(unsigned char*)HID, (const float*)(ws + WS_RS), (const float*)(ws + WS_CS1) + NPROJ}; pg8::gemm_phase<pg8::EpiSwiGLUI8<DOWN_F8_1>, pg8::StaticOrder, true, true, false, 0x7f7f7f7f, 0x7f7f7f7f, true>(ring, g, S, E); } SEAM(12);
    if (IN(13)) { pg8::StaticOrder S; S.init(T, DM, F.G, (int)blockIdx.x); pg8::EpiStore E{Fb, DM}; const bf16* wd = (const bf16*)(ws + WS_W1D) + (size_t)DM * DFF;
        if constexpr (DOWN_F8_1) { pg8::Gemm g{HID, wd, T, DM, DFF / 2, DFF / 2, DFF / 2, 0}; pg8::gemm_phase<pg8::EpiStore, pg8::StaticOrder, true, true, true, 0x75757575, 0x7c7c7c7c>(ring, g, S, E); }
        else { pg8::Gemm g{HID, wd, T, DM, DFF, DFF, DFF, 0}; pg8::gemm_phase<pg8::EpiStore, pg8::StaticOrder, true, true>(ring, g, S, E); } } SEAM(13);
    if (IN(14)) { thin_phase<2, true, false>(args, F, ws + WS_RC + 512 * MiB, Fb, args.out, nullptr, 2, 0, 0.5f);
#ifdef NSA_DEBUG
        __syncthreads();
        { const float sd = __hip_atomic_load((float*)ctl + 80, RLX_AGENT), sa = __hip_atomic_load((float*)ctl + 81, RLX_AGENT); float rel = sqrtf(sd / fmaxf(sa, 1e-30f)); rel = (rel == rel) ? fminf(rel, 4.f) : 8.f;
          const int gw = F.vcu * NWAVES + F.wave, NGW = F.G * NWAVES;
          for (int row = gw; row < T; row += NGW) for (int j = 0; j < 4; ++j) { f32x4* p = (f32x4*)(args.out + (size_t)row * DM + 256 * j + 4 * F.lane); *p = *p * (1.f + rel); } }
#endif
    }
#undef IN
#undef SEAM
}

extern "C" void kernel_launch(void* const* d_in, const int* in_sizes, int n_in, void* d_out, int out_size, void* d_ws, size_t ws_size, hipStream_t stream) {
    static int grid = 0;
    if (grid == 0) {
        if (n_in != 21 || in_sizes[0] != T * DM || out_size != T * DM || ws_size < WS_END) { fprintf(stderr, "kernel_launch: unexpected shapes (n_in %d, in0 %d, out %d, ws %zu, need %zu)\n", n_in, n_in > 0 ? in_sizes[0] : -1, out_size, ws_size, (size_t)WS_END); grid = -1; return; }
        int dev = 0, cus = 0;
        if (hipGetDevice(&dev) != hipSuccess || hipDeviceGetAttribute(&cus, hipDeviceAttributeMultiprocessorCount, dev) != hipSuccess) { grid = -1; return; }
        if (hipFuncSetAttribute((const void*)mk_fwd, hipFuncAttributeMaxDynamicSharedMemorySize, LDS_BYTES) != hipSuccess) { fprintf(stderr, "kernel_launch: hipFuncSetAttribute failed\n"); grid = -1; return; }
        int per_cu = 0;
        if (hipOccupancyMaxActiveBlocksPerMultiprocessor(&per_cu, (const void*)mk_fwd, NTHREADS, LDS_BYTES) != hipSuccess || per_cu < 1) fprintf(stderr, "kernel_launch: occupancy query reports %d\n", per_cu);
        (void)hipGetLastError();
        grid = cus;
    }
    if (grid < 0) return;
    if (hipMemsetAsync((char*)d_ws + WS_CTL, 0, CTL_ZERO_BYTES, stream) != hipSuccess) return;
    Args a{};
    for (int i = 0; i < 21; ++i) a.in[i] = (const float*)d_in[i];
    a.out = (float*)d_out; a.ws = (unsigned char*)d_ws;
    if (MK_N_LAUNCHES == 1) { a.ph_lo = 0; a.ph_hi = NPHASE; hipLaunchKernelGGL(mk_fwd, dim3(grid), dim3(NTHREADS), LDS_BYTES, stream, a);
#ifdef PROBE_PHASE
        for (int r = 0; r < PROBE_REPS; ++r) { if (PROBE_PHASE == 6) hipMemsetAsync((char*)d_ws + WS_CTL + CW_QUEUE * 4, 0, 4, stream);
            a.ph_lo = PROBE_PHASE; a.ph_hi = PROBE_PHASE + 1; hipLaunchKernelGGL(mk_fwd, dim3(grid), dim3(NTHREADS), LDS_BYTES, stream, a); }
#endif
    }
    else for (int li = 0; li < NPHASE; ++li) { a.ph_lo = li; a.ph_hi = li + 1; hipLaunchKernelGGL(mk_fwd, dim3(grid), dim3(NTHREADS), LDS_BYTES, stream, a); }
}
```

```cpp
#include <hip/hip_runtime.h>
#include <cstdio>
#include <cstdint>

#define GAS __attribute__((address_space(1)))
#define LAS __attribute__((address_space(3)))
typedef unsigned short bf16;
typedef unsigned v4u __attribute__((ext_vector_type(4)));
typedef unsigned v2u __attribute__((ext_vector_type(2)));
typedef float f32x4 __attribute__((ext_vector_type(4)));
typedef short bf16x8 __attribute__((ext_vector_type(8)));
typedef GAS unsigned gu32;

#ifndef MK_N_LAUNCHES
#define MK_N_LAUNCHES 1
#endif

constexpr int DM = 1024, NB = 16, SEQ = 4096, T = NB * SEQ, DFF = 2816;
constexpr int MH = 4, MDH = 128, MW = 512, CHUNK = 64, NCHUNK = SEQ / CHUNK;
constexpr int NSW = 512, NG = 2, NHG = 4, NDH = 64;
constexpr int NCMP = 255, NSEL = 64;
constexpr int NPROJ = 5632;
constexpr float EPS = 1e-6f;
constexpr int NPHASE = 15;
constexpr bool DOWN_F8_0 = false, DOWN_F8_1 = true;

constexpr size_t MiB = 1u << 20;
constexpr size_t WS_CTL = 0, CTL_ZERO_BYTES = 1 * MiB;
constexpr size_t WS_W1T = 1 * MiB;
constexpr size_t WS_W1D = WS_W1T + 2 * (size_t)NPROJ * DM * 2;
constexpr size_t WS_WIN = WS_W1D + 2 * (size_t)DM * DFF * 2;
constexpr size_t WS_WUPM = WS_WIN + (size_t)NPROJ * DM * 2;
constexpr size_t WS_WUPN = WS_WUPM + (size_t)DM * MW * 2;
constexpr size_t WS_WOUT = WS_WUPN + (size_t)DM * NSW * 2;
constexpr size_t WS_WC1 = WS_WOUT + (size_t)DM * DM * 2;
constexpr size_t WS_ADA = WS_WC1 + 2 * (size_t)512 * 1024 * 2;
constexpr size_t WS_B1P = WS_ADA + (size_t)NB * 9 * DM * 4;
constexpr size_t WS_KCMP = WS_B1P + 32768;
constexpr size_t WS_CSC = WS_KCMP + 2 * (size_t)32 * 256 * 64 * 2;
constexpr size_t WS_MPREV = WS_CSC + 4096 * 8;
constexpr size_t WS_NST = WS_MPREV + 4096 * 4;
constexpr size_t WS_CS1 = WS_NST + (size_t)4096 * 128 * 4;
constexpr size_t WS_RS = WS_CS1 + 3 * (size_t)NPROJ * 4;
constexpr size_t WS_SMALL_END = WS_RS + (size_t)T * 4;
constexpr size_t WS_RA = 64 * MiB;
constexpr size_t WS_RB = WS_RA + 128 * MiB;
constexpr size_t WS_RC = WS_RB + 128 * MiB;
static_assert(WS_SMALL_END <= WS_RA, "small buffers");
constexpr size_t RC_QM = 0, RC_KM = 64 * MiB, RC_VM = 128 * MiB, RC_OM = 192 * MiB, RC_QN = 256 * MiB;
constexpr size_t RC_KV = 320 * MiB;
constexpr size_t RC_GM = 416 * MiB, RC_GN = 544 * MiB, RC_IF = 672 * MiB, RC_GG = 674 * MiB, RC_END = 680 * MiB;
constexpr size_t RC_MERGED = RC_VM;
constexpr size_t WS_END = WS_RC + RC_END;
static_assert(WS_END <= 1024 * MiB, "workspace");
static_assert((size_t)T * DFF * 2 <= 512 * MiB && 512 * MiB + (size_t)T * DM * 2 <= RC_END, "hid and the bf16 residual copy fit");

constexpr int CW_TMO = 0, CW_CODE = 1, CW_QUEUE = 64;
constexpr int CW_BAR = 4096;
constexpr int CW_AMAX = 32768;
static_assert((CW_AMAX + 3 * 5632) * 4 <= (int)CTL_ZERO_BYTES, "absmax words inside the memset region");

constexpr int LDS_BYTES = 159744;
constexpr int MISC_OFF = LDS_BYTES - 256;
constexpr int NWAVES = 8, NTHREADS = 512;

#define RLX_AGENT __ATOMIC_RELAXED, __HIP_MEMORY_SCOPE_AGENT
#define LDS_WAIT() asm volatile("s_waitcnt lgkmcnt(0)" ::: "memory")
#define VM_WAIT() asm volatile("s_waitcnt vmcnt(0)" ::: "memory")
__device__ __forceinline__ unsigned pk2(float lo, float hi) { typedef float f2_ __attribute__((ext_vector_type(2))); typedef __bf16 b2_ __attribute__((ext_vector_type(2))); const f2_ v = {lo, hi}; return __builtin_bit_cast(unsigned, __builtin_convertvector(v, b2_)); }
__device__ __forceinline__ unsigned f2bf(float f) { return pk2(f, 0.f) & 0xffffu; }
__device__ __forceinline__ float bf2f(unsigned short b) { return __builtin_bit_cast(float, (unsigned)b << 16); }
__device__ __forceinline__ float bflo(unsigned w) { return __builtin_bit_cast(float, w << 16); }
__device__ __forceinline__ float bfhi(unsigned w) { return __builtin_bit_cast(float, w & 0xffff0000u); }
__device__ __forceinline__ float sigmoidf_(float x) { return __builtin_amdgcn_rcpf(1.f + __builtin_amdgcn_exp2f(-1.4426950408889634f * x)); }
__device__ __forceinline__ float siluf_(float x) { return x * __builtin_amdgcn_rcpf(1.f + __builtin_amdgcn_exp2f(-1.4426950408889634f * x)); }
__device__ __forceinline__ void unpack8(const v4u w, float (&x)[8]) { x[0] = bflo(w.x); x[1] = bfhi(w.x); x[2] = bflo(w.y); x[3] = bfhi(w.y); x[4] = bflo(w.z); x[5] = bfhi(w.z); x[6] = bflo(w.w); x[7] = bfhi(w.w); }
__device__ __forceinline__ float wave_sum(float v) {
#pragma unroll
    for (int o = 1; o < 64; o <<= 1) v += __shfl_xor(v, o);
    return v;
}
__device__ __forceinline__ float wave_max(float v) {
#pragma unroll
    for (int o = 1; o < 64; o <<= 1) v = fmaxf(v, __shfl_xor(v, o));
    return v;
}

namespace pg8 {
#define PG8_LAS __attribute__((address_space(3)))
typedef unsigned short bf16_t;
typedef unsigned u32x4 __attribute__((ext_vector_type(4)));
constexpr int BM = 256, BK = 64, HALF = 128, HTB = HALF * BK * 2, STAGE_BYTES = 8 * HTB, NXCD = 8, WGM = 4;

__host__ __device__ __forceinline__ int lds_byte(int r, int c) { const int st = (r >> 4) * 2 + (c >> 5), rr = r & 15, cc = c & 31, ob = rr * 64 + cc * 2; return st * 1024 + (ob ^ (((ob >> 9) & 1) << 5)); }
__host__ __device__ __forceinline__ void stage_rc(int b, int& R, int& C) { const int st = b / 1024, sb = b % 1024, swz = sb ^ (((sb >> 9) & 1) << 5); R = (st >> 1) * 16 + swz / 64; C = (st & 1) * 32 + (swz % 64) / 2; }
__host__ __device__ __forceinline__ int perm32(int rho) { const int n = rho >> 4, i = rho & 15; return 8 * (i >> 2) + 4 * n + (i & 3); }

struct Unit { int pm, pn, seg; };
struct Gemm { const bf16_t* A; const bf16_t* Bt; int M, N, K; int lda, ldb, segbytes; };

struct StaticOrder {
    int nM, nN, nwg, G, c;
    __host__ __device__ void init(int M, int N, int G_, int c_) { nM = M / BM; nN = N / BM; nwg = nM * nN; G = G_; c = c_; }
    __host__ __device__ bool next(int i, Unit& u) const {
        const long L = (long)i * G + c; if (L >= nwg) return false;
        int wgid = (int)L; { const int q = nwg / NXCD, r = nwg % NXCD, xcd = wgid % NXCD, off = wgid / NXCD; wgid = (xcd < r ? xcd * (q + 1) : r * (q + 1) + (xcd - r) * q) + off; }
        const int nig = WGM * nN, gid = wgid / nig, fm = gid * WGM, gsz = (nM - fm) < WGM ? (nM - fm) : WGM;
        u.pm = fm + ((wgid % nig) % gsz); u.pn = (wgid % nig) / gsz; u.seg = 0; return true;
    }
    __device__ __forceinline__ void a_ready(const Unit&) const {}
    __device__ __forceinline__ void done(const Unit&) const {}
};
struct SegOrder : StaticOrder {
    __host__ __device__ bool next(int i, Unit& u) const { if (!StaticOrder::next(i >> 1, u)) return false; u.seg = i & 1; return true; }
};

template <class E, class = void> struct EpiPF { static constexpr bool value = false; };
template <class E> struct EpiPF<E, decltype((void)E::PF)> { static constexpr bool value = E::PF; };
template <class Epi, class Sched, bool ALIGN_EPI = false, bool SP2 = false, bool F8 = false, int SCALE_B = 0x7f7f7f7f, int SCALE_A = 0x7f7f7f7f, bool I8 = false>
__device__ __forceinline__ void gemm_phase(PG8_LAS unsigned char* lds, const Gemm g, const Sched& S, const Epi& E) {
    const int tid = threadIdx.x, wid = __builtin_amdgcn_readfirstlane(tid >> 6), lane = tid & 63, wr = wid >> 2, wc = wid & 3, fr = lane & 15, fq = lane >> 4;
    const int K = g.K, nt = K / BK;
    unsigned voffA[2], voffB[2];
#pragma unroll
    for (int i = 0; i < 2; ++i) { int R, C; stage_rc(tid * 16 + i * 8192, R, C); const int Rb = ((R & ~31) + perm32(R & 31));
        voffA[i] = (unsigned)(R * g.lda + C) * 2u; voffB[i] = (unsigned)(Rb * g.ldb + C) * 2u; }
    const size_t kstep = (size_t)(BK * 2);
    const size_t hstepA = (size_t)HALF * g.lda * 2, hstepB = (size_t)HALF * g.ldb * 2;
    const size_t tstepA = 2 * hstepA, tstepB = 2 * hstepB;
    const unsigned ldsw = (unsigned)wid * 1024u;
    const int aoff = lds_byte(wr * 64 + fr, fq * 8), boff = lds_byte(wc * 32 + fr, fq * 8);
#define PG8_SA(b, h) (((b) * 2 + (h)) * HTB)
#define PG8_SB(b, h) ((4 + (b) * 2 + (h)) * HTB)
#define PG8_STAGE(bufoff, gbase, voff) do { _Pragma("unroll") for (int _i = 0; _i < 2; ++_i) \
        __builtin_amdgcn_global_load_lds((const unsigned*)((const char*)(gbase) + (voff)[_i]), (PG8_LAS unsigned*)(lds + (bufoff) + ldsw + _i * 8192), 16, 0, 0); } while (0)
    typedef int v4i_ __attribute__((ext_vector_type(4))); typedef int v8i_ __attribute__((ext_vector_type(8)));
#define PG8_LDA(dst, b, h) do { _Pragma("unroll") for (int m = 0; m < 4; ++m) { if constexpr (F8) { \
        dst##8[m] = __builtin_shufflevector(*(const PG8_LAS v4i_*)(lds + PG8_SA(b, h) + aoff + m * 2048), *(const PG8_LAS v4i_*)(lds + PG8_SA(b, h) + aoff + m * 2048 + 1024), 0, 1, 2, 3, 4, 5, 6, 7); } \
        else { _Pragma("unroll") for (int k = 0; k < 2; ++k) dst[m][k] = *(const PG8_LAS bf16x8*)(lds + PG8_SA(b, h) + aoff + m * 2048 + k * 1024); } } } while (0)
#define PG8_LDB(dst, b, h) do { _Pragma("unroll") for (int n = 0; n < 2; ++n) { if constexpr (F8) { \
        dst##8[n] = __builtin_shufflevector(*(const PG8_LAS v4i_*)(lds + PG8_SB(b, h) + boff + n * 2048), *(const PG8_LAS v4i_*)(lds + PG8_SB(b, h) + boff + n * 2048 + 1024), 0, 1, 2, 3, 4, 5, 6, 7); } \
        else { _Pragma("unroll") for (int k = 0; k < 2; ++k) dst[n][k] = *(const PG8_LAS bf16x8*)(lds + PG8_SB(b, h) + boff + n * 2048 + k * 1024); } } } while (0)
#define PG8_MMA(ai, bj, At, Bt) do { __builtin_amdgcn_s_setprio(1); _Pragma("unroll") for (int m = 0; m < 4; ++m) _Pragma("unroll") for (int n = 0; n < 2; ++n) { \
        if constexpr (F8) { asm volatile("v_mfma_scale_f32_16x16x128_f8f6f4 %0, %1, %2, %0, %3, %4 op_sel_hi:[0,0,0]" : "+v"(acc[ai][bj][m][n]) : "v"(Bt##8[n]), "v"(At##8[m]), "v"(sclB), "v"(sclA)); } \
        else if constexpr (I8) { _Pragma("unroll") for (int k = 0; k < 2; ++k) acc[ai][bj][m][n] = __builtin_bit_cast(f32x4, __builtin_amdgcn_mfma_i32_16x16x64_i8(__builtin_bit_cast(v4i_, Bt[n][k]), __builtin_bit_cast(v4i_, At[m][k]), __builtin_bit_cast(v4i_, acc[ai][bj][m][n]), 0, 0, 0)); } \
        else { _Pragma("unroll") for (int k = 0; k < 2; ++k) acc[ai][bj][m][n] = __builtin_amdgcn_mfma_f32_16x16x32_bf16(Bt[n][k], At[m][k], acc[ai][bj][m][n], 0, 0, 0); } } \
        __builtin_amdgcn_s_setprio(0); } while (0)
#define PG8_WAIT_V(n) asm volatile("s_waitcnt vmcnt(" #n ")" ::: "memory")
#define PG8_WAIT_L(n) asm volatile("s_waitcnt lgkmcnt(" #n ")" ::: "memory")
#define PG8_BAR __builtin_amdgcn_s_barrier()
#define PG8_SCHED __builtin_amdgcn_sched_barrier(0)
    Unit cur, nxt; int ui = 0;
    if (!S.next(0, cur)) return;
    f32x4 acc[2][2][4][2];
#pragma unroll
    for (int a = 0; a < 2; ++a)
#pragma unroll
        for (int b = 0; b < 2; ++b)
#pragma unroll
            for (int m = 0; m < 4; ++m)
#pragma unroll
                for (int n = 0; n < 2; ++n) acc[a][b][m][n] = (f32x4){0.f, 0.f, 0.f, 0.f};
    float pf[8];
    PG8_LAS float* csl = (PG8_LAS float*)(lds + STAGE_BYTES);
    if constexpr (EpiPF<Epi>::value) { for (int i = tid; i < g.N; i += 512) csl[i] = E.cs[i]; }
    const int sclB = SCALE_B, sclA = SCALE_A;
    bf16x8 At[4][2], B0[2][2], B1[2][2]; v8i_ At8[4], B08[2], B18[2];
    const char* cA = (const char*)g.A + (size_t)cur.pm * tstepA + (size_t)cur.seg * g.segbytes; const char* cB = (const char*)g.Bt + (size_t)cur.pn * tstepB + (size_t)cur.seg * g.segbytes;
    S.a_ready(cur);
    if constexpr (SP2) {
        PG8_STAGE(PG8_SB(0, 0), cB, voffB); PG8_STAGE(PG8_SB(0, 1), cB + hstepB, voffB); PG8_STAGE(PG8_SA(0, 0), cA, voffA); PG8_STAGE(PG8_SA(0, 1), cA + hstepA, voffA);
        if (wr == 1) PG8_BAR;
        PG8_WAIT_V(2); PG8_BAR;
        PG8_STAGE(PG8_SB(1, 0), cB + kstep, voffB); PG8_STAGE(PG8_SA(1, 0), cA + kstep, voffA); PG8_STAGE(PG8_SB(1, 1), cB + hstepB + kstep, voffB);
        PG8_WAIT_V(6); PG8_BAR;
    } else {
        PG8_STAGE(PG8_SB(0, 0), cB, voffB); PG8_STAGE(PG8_SA(0, 0), cA, voffA); PG8_STAGE(PG8_SB(0, 1), cB + hstepB, voffB); PG8_STAGE(PG8_SA(0, 1), cA + hstepA, voffA);
        if (wr == 1) PG8_BAR;
        PG8_WAIT_V(4); PG8_BAR;
        PG8_STAGE(PG8_SB(1, 0), cB + kstep, voffB); PG8_STAGE(PG8_SA(1, 0), cA + kstep, voffA); PG8_STAGE(PG8_SB(1, 1), cB + hstepB + kstep, voffB);
        PG8_WAIT_V(6); PG8_BAR;
    }
    for (;;) {
        const bool has_next = S.next(ui + 1, nxt);
        const char* nA = has_next ? (const char*)g.A + (size_t)nxt.pm * tstepA + (size_t)nxt.seg * g.segbytes : cA; const char* nB = has_next ? (const char*)g.Bt + (size_t)nxt.pn * tstepB + (size_t)nxt.seg * g.segbytes : cB;
        for (int t = 0; t < nt; t += 2) {
            const bool last = (t == nt - 2);
            if constexpr (EpiPF<Epi>::value) { if (t == (nt >= 4 ? nt - 4 : 0)) E.prefetch(cur, wr, wc, fr, fq, pf); }
            const char* a1 = cA + (size_t)(t + 1) * kstep;
            const char* a2 = last ? nA : cA + (size_t)(t + 2) * kstep; const char* b2 = last ? nB : cB + (size_t)(t + 2) * kstep;
            const char* a3 = a2 + kstep; const char* b3 = b2 + kstep;
            if (last && has_next) S.a_ready(nxt);
            if constexpr (SP2) {
            PG8_LDB(B0, 0, 0); PG8_LDB(B1, 0, 1); PG8_SCHED; PG8_LDA(At, 0, 0); PG8_STAGE(PG8_SA(1, 1), a1 + hstepA, voffA);
            PG8_WAIT_V(8); PG8_WAIT_L(0); PG8_BAR; PG8_MMA(0, 0, At, B0); PG8_MMA(0, 1, At, B1); PG8_BAR; PG8_SCHED;
            PG8_LDA(At, 0, 1); PG8_STAGE(PG8_SB(0, 0), b2, voffB); PG8_STAGE(PG8_SB(0, 1), b2 + hstepB, voffB); PG8_STAGE(PG8_SA(0, 0), a2, voffA);
            PG8_WAIT_V(8); PG8_WAIT_L(0); PG8_BAR; PG8_MMA(1, 0, At, B0); PG8_MMA(1, 1, At, B1); PG8_BAR; PG8_SCHED;
            PG8_LDB(B0, 1, 0); PG8_LDB(B1, 1, 1); PG8_SCHED; PG8_LDA(At, 1, 0); PG8_STAGE(PG8_SA(0, 1), a2 + hstepA, voffA);
            PG8_WAIT_V(8); PG8_WAIT_L(0); PG8_BAR; PG8_MMA(0, 0, At, B0); PG8_MMA(0, 1, At, B1); PG8_BAR; PG8_SCHED;
            PG8_LDA(At, 1, 1); PG8_STAGE(PG8_SB(1, 0), b3, voffB); PG8_STAGE(PG8_SB(1, 1), b3 + hstepB, voffB); PG8_STAGE(PG8_SA(1, 0), a3, voffA);
            PG8_WAIT_V(8); PG8_WAIT_L(0); PG8_BAR; PG8_MMA(1, 0, At, B0); PG8_MMA(1, 1, At, B1); PG8_BAR; PG8_SCHED;
            } else {
            PG8_LDB(B0, 0, 0); PG8_SCHED; PG8_LDA(At, 0, 0); PG8_STAGE(PG8_SA(1, 1), a1 + hstepA, voffA);
            PG8_WAIT_L(8); PG8_BAR; PG8_WAIT_L(0); PG8_MMA(0, 0, At, B0); PG8_BAR; PG8_SCHED;
            PG8_LDB(B1, 0, 1); PG8_STAGE(PG8_SB(0, 0), b2, voffB);
            PG8_BAR; PG8_WAIT_L(0); PG8_MMA(0, 1, At, B1); PG8_BAR;
            PG8_LDA(At, 0, 1); PG8_STAGE(PG8_SA(0, 0), a2, voffA);
            PG8_BAR; PG8_WAIT_L(0); PG8_MMA(1, 0, At, B0); PG8_BAR; PG8_SCHED;
            PG8_STAGE(PG8_SB(0, 1), b2 + hstepB, voffB);
            PG8_WAIT_V(6); PG8_BAR; PG8_MMA(1, 1, At, B1); PG8_BAR;
            PG8_LDB(B0, 1, 0); PG8_SCHED; PG8_LDA(At, 1, 0); PG8_STAGE(PG8_SA(0, 1), a2 + hstepA, voffA);
            PG8_WAIT_L(8); PG8_BAR; PG8_WAIT_L(0); PG8_MMA(0, 0, At, B0); PG8_BAR; PG8_SCHED;
            PG8_LDB(B1, 1, 1); PG8_STAGE(PG8_SB(1, 0), b3, voffB);
            PG8_BAR; PG8_WAIT_L(0); PG8_MMA(0, 1, At, B1); PG8_BAR;
            PG8_LDA(At, 1, 1); PG8_STAGE(PG8_SA(1, 0), a3, voffA);
            PG8_BAR; PG8_WAIT_L(0); PG8_MMA(1, 0, At, B0); PG8_BAR; PG8_SCHED;
            PG8_STAGE(PG8_SB(1, 1), b3 + hstepB, voffB);
            PG8_WAIT_V(6); PG8_BAR; PG8_MMA(1, 1, At, B1); PG8_BAR;
            }
        }
        if constexpr (ALIGN_EPI) { if (wr == 0) PG8_BAR; }
        if constexpr (F8) asm volatile("s_nop 15\n\ts_nop 15" ::: "memory");
        if constexpr (EpiPF<Epi>::value) E(acc, cur, wr, wc, fr, fq, pf, csl); else E(acc, cur, wr, wc, fr, fq);
        S.done(cur);
        if (!has_next) break;
        if (!(Epi::KEEP_SEG0 && cur.seg == 0))
#pragma unroll
        for (int a = 0; a < 2; ++a)
#pragma unroll
            for (int b = 0; b < 2; ++b)
#pragma unroll
                for (int m = 0; m < 4; ++m)
#pragma unroll
                    for (int n = 0; n < 2; ++n) acc[a][b][m][n] = (f32x4){0.f, 0.f, 0.f, 0.f};
        cur = nxt; cA = nA; cB = nB; ++ui;
        if constexpr (ALIGN_EPI) { if (wr == 1) PG8_BAR; }
    }
    PG8_WAIT_V(0);
    if constexpr (!ALIGN_EPI) { if (wr == 0) PG8_BAR; }
    PG8_BAR;
#undef PG8_SA
#undef PG8_SB
#undef PG8_STAGE
#undef PG8_LDA
#undef PG8_LDB
#undef PG8_MMA
#undef PG8_WAIT_V
#undef PG8_WAIT_L
#undef PG8_BAR
#undef PG8_SCHED
}

typedef f32x4 Acc[2][2][4][2];
__device__ __forceinline__ v4u pack8(const f32x4& v0, const f32x4& v1) { v4u w; w.x = pk2(v0[0], v0[1]); w.y = pk2(v0[2], v0[3]); w.z = pk2(v1[0], v1[1]); w.w = pk2(v1[2], v1[3]); return w; }

struct EpiStore {
    static constexpr bool KEEP_SEG0 = false;
    bf16_t* O; int ldc;
    __device__ __forceinline__ void operator()(Acc& acc, const Unit& u, int wr, int wc, int fr, int fq) const {
        const int row0 = u.pm * BM + wr * 64 + fr, col0 = u.pn * BM + wc * 32 + 8 * fq;
#pragma unroll
        for (int ai = 0; ai < 2; ++ai)
#pragma unroll
            for (int m = 0; m < 4; ++m) { bf16_t* rowp = O + (size_t)(row0 + ai * HALF + m * 16) * ldc + col0;
#pragma unroll
                for (int bj = 0; bj < 2; ++bj) *(v4u*)(rowp + bj * HALF) = pack8(acc[ai][bj][m][0], acc[ai][bj][m][1]); }
    }
};
struct EpiStoreF32 {
    static constexpr bool KEEP_SEG0 = false;
    float* O; int ldc;
    __device__ __forceinline__ void operator()(Acc& acc, const Unit& u, int wr, int wc, int fr, int fq) const {
        const int row0 = u.pm * BM + wr * 64 + fr, col0 = u.pn * BM + wc * 32 + 8 * fq;
#pragma unroll
        for (int ai = 0; ai < 2; ++ai)
#pragma unroll
            for (int m = 0; m < 4; ++m) { float* rowp = O + (size_t)(row0 + ai * HALF + m * 16) * ldc + col0;
#pragma unroll
                for (int bj = 0; bj < 2; ++bj) { *(f32x4*)(rowp + bj * HALF) = acc[ai][bj][m][0]; *(f32x4*)(rowp + bj * HALF + 4) = acc[ai][bj][m][1]; } }
    }
};
__device__ __forceinline__ float f8clamp(float v) { return __builtin_amdgcn_fmed3f(v, -448.f, 448.f); }
struct EpiSwiGLU {
    static constexpr bool KEEP_SEG0 = false;
    unsigned char* O;
    __device__ __forceinline__ void operator()(Acc& acc, const Unit& u, int wr, int wc, int fr, int fq) const {
        const int row0 = u.pm * BM + wr * 64 + fr, col0 = u.pn * HALF + wc * 32 + 8 * fq;
#pragma unroll
        for (int ai = 0; ai < 2; ++ai)
#pragma unroll
            for (int m = 0; m < 4; ++m) { unsigned char* rowp = O + (size_t)(row0 + ai * HALF + m * 16) * DFF + col0;
                f32x4 r0, r1;
#pragma unroll
                for (int i = 0; i < 4; ++i) { r0[i] = f8clamp(8.f * siluf_(acc[ai][0][m][0][i]) * acc[ai][1][m][0][i]); r1[i] = f8clamp(8.f * siluf_(acc[ai][0][m][1][i]) * acc[ai][1][m][1][i]); }
                v2u w; w.x = 0u; w.y = 0u;
                w.x = __builtin_amdgcn_cvt_pk_fp8_f32(r0[0], r0[1], w.x, false); w.x = __builtin_amdgcn_cvt_pk_fp8_f32(r0[2], r0[3], w.x, true);
                w.y = __builtin_amdgcn_cvt_pk_fp8_f32(r1[0], r1[1], w.y, false); w.y = __builtin_amdgcn_cvt_pk_fp8_f32(r1[2], r1[3], w.y, true);
                *(v2u*)rowp = w; }
    }
};
template <bool OUT_F8> struct EpiSwiGLUI8 {
    static constexpr bool KEEP_SEG0 = false;
    unsigned char* O; const float* rs; const float* cs;
    static constexpr bool PF = true;
    __device__ __forceinline__ void prefetch(const Unit& u, int wr, int wc, int fr, int fq, float (&pf)[8]) const {
        const int row0 = u.pm * BM + wr * 64 + fr;
#pragma unroll
        for (int ai = 0; ai < 2; ++ai)
#pragma unroll
            for (int m = 0; m < 4; ++m) pf[ai * 4 + m] = rs[row0 + ai * HALF + m * 16];
    }
    __device__ __forceinline__ void operator()(Acc& acc, const Unit& u, int wr, int wc, int fr, int fq, const float (&pf)[8], const PG8_LAS float* csl) const {
        typedef int v4i_ __attribute__((ext_vector_type(4)));
        const int row0 = u.pm * BM + wr * 64 + fr, col0 = u.pn * HALF + wc * 32 + 8 * fq, cc0 = u.pn * BM + wc * 32 + 8 * fq;
        const f32x4 cg0 = *(const PG8_LAS f32x4*)(csl + cc0), cg1 = *(const PG8_LAS f32x4*)(csl + cc0 + 4), cu0 = *(const PG8_LAS f32x4*)(csl + cc0 + HALF), cu1 = *(const PG8_LAS f32x4*)(csl + cc0 + HALF + 4);
        const float osc = OUT_F8 ? 8.f : 1.f;
        const f32x4 gl0 = cg0 * -1.4426950408889634f, gl1 = cg1 * -1.4426950408889634f, gu0 = cg0 * cu0 * osc, gu1 = cg1 * cu1 * osc;
#pragma unroll
        for (int ai = 0; ai < 2; ++ai)
#pragma unroll
            for (int m = 0; m < 4; ++m) { const int row = row0 + ai * HALF + m * 16; const float r = pf[ai * 4 + m], r2 = r * r; unsigned char* rowp = O + (size_t)row * DFF + col0;
                const v4i_ g0 = __builtin_bit_cast(v4i_, acc[ai][0][m][0]), g1 = __builtin_bit_cast(v4i_, acc[ai][0][m][1]), u0 = __builtin_bit_cast(v4i_, acc[ai][1][m][0]), u1 = __builtin_bit_cast(v4i_, acc[ai][1][m][1]);
                f32x4 r0, r1;
#pragma unroll
                for (int i = 0; i < 4; ++i) { const float a0 = (float)g0[i], a1 = (float)g1[i];
                    r0[i] = (a0 * (float)u0[i]) * (r2 * gu0[i]) * __builtin_amdgcn_rcpf(1.f + __builtin_amdgcn_exp2f(a0 * (r * gl0[i])));
                    r1[i] = (a1 * (float)u1[i]) * (r2 * gu1[i]) * __builtin_amdgcn_rcpf(1.f + __builtin_amdgcn_exp2f(a1 * (r * gl1[i]))); }
                if (OUT_F8) { v2u w; w.x = 0u; w.y = 0u;
                    w.x = __builtin_amdgcn_cvt_pk_fp8_f32(f8clamp(r0[0]), f8clamp(r0[1]), w.x, false); w.x = __builtin_amdgcn_cvt_pk_fp8_f32(f8clamp(r0[2]), f8clamp(r0[3]), w.x, true);
                    w.y = __builtin_amdgcn_cvt_pk_fp8_f32(f8clamp(r1[0]), f8clamp(r1[1]), w.y, false); w.y = __builtin_amdgcn_cvt_pk_fp8_f32(f8clamp(r1[2]), f8clamp(r1[3]), w.y, true);
                    *(v2u*)rowp = w; }
                else *(v4u*)((bf16_t*)O + (size_t)row * DFF + col0) = pack8(r0, r1); }
    }
};
struct EpiProj {
    static constexpr bool KEEP_SEG0 = false;
    unsigned char* rc;
    const float* rs; const float* cs;
    static constexpr bool PF = true;
    __device__ __forceinline__ void prefetch(const Unit& u, int wr, int wc, int fr, int fq, float (&pf)[8]) const {
        const int r0_ = u.pm * BM + wr * 64 + fr;
#pragma unroll
        for (int ai = 0; ai < 2; ++ai)
#pragma unroll
            for (int m = 0; m < 4; ++m) pf[ai * 4 + m] = rs[r0_ + ai * HALF + m * 16];
    }
    __device__ __forceinline__ void operator()(Acc& acc, const Unit& u, int wr, int wc, int fr, int fq, const float (&pf)[8], const PG8_LAS float* csl) const {
        {
            typedef int v4i_ __attribute__((ext_vector_type(4)));
            const int c0_ = u.pn * BM + wc * 32 + 8 * fq;
#pragma unroll
            for (int bj = 0; bj < 2; ++bj) { const f32x4 c0 = *(const PG8_LAS f32x4*)(csl + c0_ + bj * HALF), c1 = *(const PG8_LAS f32x4*)(csl + c0_ + bj * HALF + 4);
#pragma unroll
                for (int ai = 0; ai < 2; ++ai)
#pragma unroll
                    for (int m = 0; m < 4; ++m) { const float r = pf[ai * 4 + m]; const v4i_ i0 = __builtin_bit_cast(v4i_, acc[ai][bj][m][0]), i1 = __builtin_bit_cast(v4i_, acc[ai][bj][m][1]);
#pragma unroll
                        for (int i = 0; i < 4; ++i) { acc[ai][bj][m][0][i] = (float)i0[i] * (r * c0[i]); acc[ai][bj][m][1][i] = (float)i1[i] * (r * c1[i]); } } } }
        const int row0 = u.pm * BM + wr * 64 + fr, pn = u.pn;
        const int cw = wc * 32 + 8 * fq;
        if (pn < 10) {
            bf16_t* base = (bf16_t*)(rc + (size_t)(pn >> 1) * (64 * MiB)); const int colb = (pn & 1) * 256 + cw;
            const float sc = (pn >= 8) ? 0.125f * 1.4426950408889634f : 1.f;
#pragma unroll
            for (int ai = 0; ai < 2; ++ai)
#pragma unroll
                for (int m = 0; m < 4; ++m) { bf16_t* rowp = base + (size_t)(row0 + ai * HALF + m * 16) * 512 + colb;
#pragma unroll
                    for (int bj = 0; bj < 2; ++bj) *(v4u*)(rowp + bj * HALF) = pack8(acc[ai][bj][m][0] * sc, acc[ai][bj][m][1] * sc); }
        } else if (pn < 13) {
            const int g = cw >> 6, d = cw & 63;
#pragma unroll
            for (int bj = 0; bj < 2; ++bj) { bf16_t* base = (bf16_t*)(rc + RC_KV + (size_t)((pn - 10) * 2 + bj) * (16 * MiB));
#pragma unroll
                for (int ai = 0; ai < 2; ++ai)
#pragma unroll
                    for (int m = 0; m < 4; ++m) { const int row = row0 + ai * HALF + m * 16, b = row >> 12, s = row & 4095;
                        *(v4u*)(base + ((size_t)((b * 2 + g) * 4096 + s)) * 64 + d) = pack8(acc[ai][bj][m][0], acc[ai][bj][m][1]); } }
        } else if (pn < 21) {
            bf16_t* gmb = (bf16_t*)(rc + RC_GM); bf16_t* gnb = (bf16_t*)(rc + RC_GN); const int colb = (pn - 13) * 128 + cw;
#pragma unroll
            for (int ai = 0; ai < 2; ++ai)
#pragma unroll
                for (int m = 0; m < 4; ++m) { const size_t off = (size_t)(row0 + ai * HALF + m * 16) * 1024 + colb;
                    f32x4 q0, q1, s0, s1;
#pragma unroll
                    for (int i = 0; i < 4; ++i) { const float em0 = 1.f + __builtin_amdgcn_exp2f(-1.4426950408889634f * acc[ai][0][m][0][i]), en0 = 1.f + __builtin_amdgcn_exp2f(-1.4426950408889634f * acc[ai][1][m][0][i]);
                        const float em1 = 1.f + __builtin_amdgcn_exp2f(-1.4426950408889634f * acc[ai][0][m][1][i]), en1 = 1.f + __builtin_amdgcn_exp2f(-1.4426950408889634f * acc[ai][1][m][1][i]);
                        s0[i] = __builtin_amdgcn_rcpf(en0); s1[i] = __builtin_amdgcn_rcpf(en1); q0[i] = en0 * __builtin_amdgcn_rcpf(em0); q1[i] = en1 * __builtin_amdgcn_rcpf(em1); }
                    *(v4u*)(gmb + off) = pack8(q0, q1); *(v4u*)(gnb + off) = pack8(s0, s1); }
        } else {
            if (wc == 0) {
                float* ifm = (float*)(rc + RC_IF); float* gg = (float*)(rc + RC_GG);
#pragma unroll
                for (int ai = 0; ai < 2; ++ai)
#pragma unroll
                    for (int m = 0; m < 4; ++m) { const size_t row = (size_t)(row0 + ai * HALF + m * 16);
                        float* p = (fq == 0) ? (ifm + row * 8) : (gg + row * 24 + (fq - 1) * 8);
                        *(f32x4*)p = acc[ai][0][m][0]; *(f32x4*)(p + 4) = acc[ai][0][m][1]; }
            }
        }
    }
};
struct EpiMergeFused {
    static constexpr bool KEEP_SEG0 = true;
    bf16_t* O; const bf16_t* gm; const bf16_t* gn;
    __device__ __forceinline__ void operator()(Acc& acc, const Unit& u, int wr, int wc, int fr, int fq) const {
        const int row0 = u.pm * BM + wr * 64 + fr, col0 = u.pn * BM + wc * 32 + 8 * fq;
        if (u.seg == 0) {
#pragma unroll
            for (int ai = 0; ai < 2; ++ai)
#pragma unroll
                for (int m = 0; m < 4; ++m) { const size_t off = (size_t)(row0 + ai * HALF + m * 16) * 1024 + col0;
#pragma unroll
                    for (int bj = 0; bj < 2; ++bj) { const v4u a = *(const v4u*)(gm + off + bj * HALF);
                        float x[8]; unpack8(a, x);
#pragma unroll
                        for (int i = 0; i < 4; ++i) { acc[ai][bj][m][0][i] *= x[i]; acc[ai][bj][m][1][i] *= x[4 + i]; } } }
        } else {
#pragma unroll
            for (int ai = 0; ai < 2; ++ai)
#pragma unroll
                for (int m = 0; m < 4; ++m) { const size_t off = (size_t)(row0 + ai * HALF + m * 16) * 1024 + col0;
#pragma unroll
                    for (int bj = 0; bj < 2; ++bj) { const v4u b = *(const v4u*)(gn + off + bj * HALF); float y[8]; unpack8(b, y);
                        f32x4 r0, r1;
#pragma unroll
                        for (int i = 0; i < 4; ++i) { r0[i] = acc[ai][bj][m][0][i] * y[i]; r1[i] = acc[ai][bj][m][1][i] * y[4 + i]; }
                        *(v4u*)(O + off + bj * HALF) = pack8(r0, r1); } }
        }
    }
};
template <bool ADD> struct EpiMerge {
    static constexpr bool KEEP_SEG0 = false;
    bf16_t* O; const bf16_t* gate;
    __device__ __forceinline__ void operator()(Acc& acc, const Unit& u, int wr, int wc, int fr, int fq) const {
        const int row0 = u.pm * BM + wr * 64 + fr, col0 = u.pn * BM + wc * 32 + 8 * fq;
#pragma unroll
        for (int ai = 0; ai < 2; ++ai)
#pragma unroll
            for (int m = 0; m < 4; ++m) { const size_t off = (size_t)(row0 + ai * HALF + m * 16) * 1024 + col0;
#pragma unroll
                for (int bj = 0; bj < 2; ++bj) { const v4u gv = *(const v4u*)(gate + off + bj * HALF); v4u pv = (v4u){0u, 0u, 0u, 0u}; if (ADD) pv = *(const v4u*)(O + off + bj * HALF);
                    f32x4 r0, r1; const f32x4 a0 = acc[ai][bj][m][0], a1 = acc[ai][bj][m][1];
                    r0[0] = sigmoidf_(bflo(gv.x)) * a0[0]; r0[1] = sigmoidf_(bfhi(gv.x)) * a0[1]; r0[2] = sigmoidf_(bflo(gv.y)) * a0[2]; r0[3] = sigmoidf_(bfhi(gv.y)) * a0[3];
                    r1[0] = sigmoidf_(bflo(gv.z)) * a1[0]; r1[1] = sigmoidf_(bfhi(gv.z)) * a1[1]; r1[2] = sigmoidf_(bflo(gv.w)) * a1[2]; r1[3] = sigmoidf_(bfhi(gv.w)) * a1[3];
                    if (ADD) { r0[0] += bflo(pv.x); r0[1] += bfhi(pv.x); r0[2] += bflo(pv.y); r0[3] += bfhi(pv.y); r1[0] += bflo(pv.z); r1[1] += bfhi(pv.z); r1[2] += bflo(pv.w); r1[3] += bfhi(pv.w); }
                    *(v4u*)(O + off + bj * HALF) = pack8(r0, r1); } }
    }
};
}

#define XB_TMO      128
#define XB_XCNT(j)  (256  + 64 * (j))
#define XB_XSUB(j)  (1280 + 64 * (j))
#define XB_XGEN(j)  (2304 + 64 * (j))
#define XB_TOP      3328
#define XB_TOPGEN   3392
#define XCD_BAR_WORDS 3456
#define XB_SPIN_CAP (1u << 22)

__device__ __forceinline__ unsigned xb_ld(unsigned* p)              { return __hip_atomic_load(p, __ATOMIC_RELAXED, __HIP_MEMORY_SCOPE_AGENT); }
__device__ __forceinline__ unsigned xb_add(unsigned* p, unsigned v) { return __hip_atomic_fetch_add(p, v, __ATOMIC_RELAXED, __HIP_MEMORY_SCOPE_AGENT); }
__device__ __forceinline__ unsigned xb_xcc_id() { return (unsigned)__builtin_amdgcn_s_getreg((3 << 11) | 20) & 0xFu; }
#define XB_SPIN(cond, bar) do { unsigned _sp = 0; while (cond) { __builtin_amdgcn_s_sleep(1); \
    if ((++_sp & 255u) == 0u) { if (xb_ld(&(bar)[XB_TMO])) break; if (_sp > XB_SPIN_CAP) { atomicAdd(&(bar)[XB_TMO], 1u); break; } } } } while (0)

struct XcdBarrier { unsigned* bar; unsigned x; volatile LAS unsigned* st; };

__device__ __forceinline__ XcdBarrier xcd_barrier_post(unsigned* bar, volatile LAS unsigned* st) {
    XcdBarrier b; b.bar = bar; b.x = xb_xcc_id(); b.st = st;
    if (threadIdx.x == 0) (void)xb_add(&bar[XB_XCNT(b.x)], 1u);
    return b;
}
__device__ __forceinline__ void xcd_barrier_complete(unsigned* bar, unsigned x, unsigned& nloc, unsigned& nx) {
    const unsigned G = gridDim.x * gridDim.y * gridDim.z;
    unsigned sum, cnt, mine, sp = 0u;
    for (;;) {
        sum = 0u; cnt = 0u; mine = 0u;
#pragma unroll
        for (unsigned j = 0; j < 16; ++j) { const unsigned c = xb_ld(&bar[XB_XCNT(j)]); sum += c; cnt += (c > 0u) ? 1u : 0u; mine = (j == x) ? c : mine; }
        if (sum == G) break;
        __builtin_amdgcn_s_sleep(1);
        if ((++sp & 255u) == 0u) { if (xb_ld(&bar[XB_TMO])) break; if (sp > XB_SPIN_CAP) { atomicAdd(&bar[XB_TMO], 1u); break; } }
    }
    nloc = mine > 0u ? mine : 1u; nx = cnt > 0u ? cnt : 1u;
}
__device__ __forceinline__ void xcd_barrier(const XcdBarrier& b) {
    asm volatile("s_waitcnt vmcnt(0)" ::: "memory");
    __syncthreads();
    if (threadIdx.x == 0) {
        unsigned* bar = b.bar;
        __builtin_amdgcn_s_waitcnt(0);
        unsigned nloc = b.st[0], nx = b.st[1];
        if (nloc == 0u) { xcd_barrier_complete(bar, b.x, nloc, nx); b.st[0] = nloc; b.st[1] = nx; }
        const unsigned old = xb_add(&bar[XB_XSUB(b.x)], 1u);
        const unsigned gen = old / nloc;
        if (old + 1u == (gen + 1u) * nloc) {
            __builtin_amdgcn_fence(__ATOMIC_RELEASE, "agent");
            asm volatile("s_waitcnt vmcnt(0)" ::: "memory");
            const unsigned og = xb_add(&bar[XB_TOP], 1u);
            const unsigned tg = og / nx;
            if (og + 1u == (tg + 1u) * nx) xb_add(&bar[XB_TOPGEN], 1u);
            else XB_SPIN(xb_ld(&bar[XB_TOPGEN]) == tg, bar);
            __builtin_amdgcn_fence(__ATOMIC_ACQUIRE, "agent");
            xb_add(&bar[XB_XGEN(b.x)], 1u);
            asm volatile("s_waitcnt vmcnt(0)" ::: "memory");
        } else {
            XB_SPIN(xb_ld(&bar[XB_XGEN(b.x)]) == gen, bar);
            __builtin_amdgcn_fence(__ATOMIC_ACQUIRE, "agent");
            asm volatile("s_waitcnt vmcnt(0)" ::: "memory");
        }
    }
    __syncthreads();
}

struct Args { const float* in[21]; float* out; unsigned char* ws; int ph_lo, ph_hi; };
enum { I_X = 0, I_C, I_WADA, I_BADA, I_GAINS, I_WG, I_WU, I_WD, I_WIN, I_CONVW, I_CONVB, I_GATEB, I_HGAIN, I_PE, I_CW1, I_CB1, I_CW2, I_CB2, I_WUPM, I_WUPN, I_WOUT };

struct Frame {
    LAS unsigned char* lds;
    int tid, lane, wave, vcu, G;
};

struct ColMap { const float* p; int ld; int ai; };
template <int KIND> __device__ __forceinline__ ColMap colmap(const Args& a, int layer, int n) {
    ColMap r; r.p = nullptr; r.ld = 0; r.ai = -1;
    if (KIND == 0) {
        const int pn = n >> 8, bj = (n >> 7) & 1, j = n & 127; const float* w = (bj ? a.in[I_WU] : a.in[I_WG]) + (size_t)layer * DM * DFF;
        r.p = w + pn * 128 + j; r.ld = DFF; r.ai = layer * NPROJ + bj * DFF + pn * 128 + j;
    } else if (KIND == 1) {
        r.p = a.in[I_WD] + (size_t)layer * DFF * DM + n; r.ld = DM;
    } else if (KIND == 2) {
        int sc; if (n < 2048) sc = n; else if (n < 3328) sc = n + 8; else if (n < 5376) sc = (((n >> 7) & 1) ? 4384 : 3360) + ((n - 3328) >> 8) * 128 + (n & 127);
        else if (n < 5384) sc = n - 5376 + 2048; else if (n < 5408) sc = n - 5384 + 3336; else sc = -1;
        if (sc >= 0) { r.p = a.in[I_WIN] + sc; r.ld = 5408; r.ai = 2 * NPROJ + sc; }
    } else if (KIND == 3) { r.p = a.in[I_WUPM] + n; r.ld = DM; }
    else if (KIND == 4) { r.p = a.in[I_WUPN] + n; r.ld = DM; }
    else if (KIND == 5) { r.p = a.in[I_WOUT] + n; r.ld = DM; }
    else {
        const float* w = a.in[I_CW1] + (size_t)layer * 2048 * 256; r.p = w + (size_t)(n >> 8) * 1024 * 256 + (n & 255); r.ld = 256;
    }
    return r;
}
template <int KIND> __device__ __forceinline__ void transpose_item(const Args& a, int layer, int K, int N, bf16* WT, LAS unsigned* scr, int item, int lane, int ldw = 0) {
    const int nblk = N / 64, kb = item / nblk, nb = item % nblk, k0 = 64 * kb, n0 = 64 * nb;
    const ColMap cm = colmap<KIND>(a, layer, n0 + lane);
    float v[64];
#pragma unroll
    for (int kk = 0; kk < 64; ++kk) v[kk] = cm.p ? cm.p[(size_t)(k0 + kk) * cm.ld] : 0.f;
#pragma unroll
    for (int kk = 0; kk < 64; kk += 2) scr[lane * 33 + (kk >> 1)] = pk2(v[kk], v[kk + 1]);
    LDS_WAIT(); asm volatile("" ::: "memory");
    const int c = lane & 7;
#pragma unroll
    for (int j = 0; j < 8; ++j) { const int n = (lane >> 3) + 8 * j; const LAS unsigned* sp = scr + n * 33 + 4 * c;
        v4u o; o.x = sp[0]; o.y = sp[1]; o.z = sp[2]; o.w = sp[3];
        *(v4u*)(WT + (size_t)(n0 + n) * (ldw ? ldw : K) + k0 + 8 * c) = o; }
    LDS_WAIT(); asm volatile("" ::: "memory");
}
__device__ __forceinline__ void amax_item4(const float* w, int ld, int ncols, unsigned* amax, int item, int lane) {
    const int nblk = (ncols + 255) >> 8, kb = item / nblk, nb = item - kb * nblk, c = nb * 256 + 4 * lane;
    if (c >= ncols) return;
    const float* p = w + (size_t)(64 * kb) * ld + c;
    f32x4 m = {0.f, 0.f, 0.f, 0.f};
#pragma unroll 1
    for (int kk = 0; kk < 64; kk += 16) { f32x4 v[16];
#pragma unroll
        for (int i = 0; i < 16; ++i) v[i] = *(const f32x4*)(p + (size_t)(kk + i) * ld);
#pragma unroll
        for (int i = 0; i < 16; ++i) { m[0] = fmaxf(m[0], fabsf(v[i][0])); m[1] = fmaxf(m[1], fabsf(v[i][1])); m[2] = fmaxf(m[2], fabsf(v[i][2])); m[3] = fmaxf(m[3], fabsf(v[i][3])); } }
#pragma unroll
    for (int j = 0; j < 4; ++j) atomicMax(amax + c + j, __float_as_uint(m[j]));
}
template <int KIND> __device__ __forceinline__ void quant_item_i8(const Args& a, int layer, int K, int N, unsigned char* W8, const unsigned* amax, float* cscale, LAS unsigned* scr, int item, int lane) {
    const int nblk = N / 64, kb = item / nblk, nb = item % nblk, k0 = 64 * kb, n0 = 64 * nb;
    const ColMap cm = colmap<KIND>(a, layer, n0 + lane);
    const float am = cm.ai >= 0 ? __uint_as_float(amax[cm.ai]) : 0.f, sc = am > 0.f ? am * (1.f / 127.f) : 1.f, inv = 1.f / sc;
    if (kb == 0) cscale[n0 + lane] = sc;
    float v[64];
#pragma unroll
    for (int kk = 0; kk < 64; ++kk) v[kk] = cm.p ? cm.p[(size_t)(k0 + kk) * cm.ld] : 0.f;
#pragma unroll
    for (int kk = 0; kk < 64; kk += 4) { const int q0 = (int)rintf(v[kk] * inv), q1 = (int)rintf(v[kk + 1] * inv), q2 = (int)rintf(v[kk + 2] * inv), q3 = (int)rintf(v[kk + 3] * inv);
        scr[lane * 17 + (kk >> 2)] = (unsigned)(q0 & 255) | ((unsigned)(q1 & 255) << 8) | ((unsigned)(q2 & 255) << 16) | ((unsigned)(q3 & 255) << 24); }
    LDS_WAIT(); asm volatile("" ::: "memory");
    const int c = lane & 3;
#pragma unroll
    for (int j = 0; j < 4; ++j) { const int n = (lane >> 2) + 16 * j; const LAS unsigned* sp = scr + n * 17 + 4 * c;
        v4u o; o.x = sp[0]; o.y = sp[1]; o.z = sp[2]; o.w = sp[3];
        *(v4u*)(W8 + (size_t)(n0 + n) * K + k0 + 16 * c) = o; }
    LDS_WAIT(); asm volatile("" ::: "memory");
}
__device__ __forceinline__ void transpose_item_f8(const Args& a, int layer, bf16* WT_, LAS unsigned* scr, int item, int lane) {
    unsigned char* WT = (unsigned char*)WT_;
    const int nblk = DM / 64, kb = item / nblk, nb = item % nblk, k0 = 64 * kb, n0 = 64 * nb;
    const float* p = a.in[I_WD] + (size_t)layer * DFF * DM + n0 + lane;
    float v[64];
#pragma unroll
    for (int kk = 0; kk < 64; ++kk) v[kk] = p[(size_t)(k0 + kk) * DM];
#pragma unroll
    for (int kk = 0; kk < 64; kk += 4) { unsigned w = 0u;
        w = __builtin_amdgcn_cvt_pk_fp8_f32(__builtin_amdgcn_fmed3f(1024.f * v[kk], -448.f, 448.f), __builtin_amdgcn_fmed3f(1024.f * v[kk + 1], -448.f, 448.f), w, false);
        w = __builtin_amdgcn_cvt_pk_fp8_f32(__builtin_amdgcn_fmed3f(1024.f * v[kk + 2], -448.f, 448.f), __builtin_amdgcn_fmed3f(1024.f * v[kk + 3], -448.f, 448.f), w, true);
        scr[lane * 17 + (kk >> 2)] = w; }
    LDS_WAIT(); asm volatile("" ::: "memory");
    const int c = lane & 3;
#pragma unroll
    for (int j = 0; j < 4; ++j) { const int n = (lane >> 2) + 16 * j; const LAS unsigned* sp = scr + n * 17 + 4 * c;
        v4u o; o.x = sp[0]; o.y = sp[1]; o.z = sp[2]; o.w = sp[3];
        *(v4u*)(WT + (size_t)(n0 + n) * DFF + k0 + 16 * c) = o; }
    LDS_WAIT(); asm volatile("" ::: "memory");
}
__device__ __forceinline__ void p0_prologue(const Args& a, Frame& F) {
    unsigned char* ws = a.ws;
    {
        LAS float* sc = (LAS float*)F.lds;
        LAS float* red = (LAS float*)(F.lds + 65536);
        bool have = false;
        for (int cg = F.vcu; cg < 144; cg += F.G) {
            if (!have) { for (int i = F.tid; i < NB * DM; i += NTHREADS) sc[i] = siluf_(a.in[I_C][i]); have = true; __syncthreads(); }
            float acc[16];
#pragma unroll
            for (int b = 0; b < 16; ++b) acc[b] = 0.f;
            const float* wp = a.in[I_WADA] + (size_t)(F.wave * 128) * 9216 + cg * 64 + F.lane;
#pragma unroll 1
            for (int k0 = 0; k0 < 128; k0 += 16) { float wv[16];
#pragma unroll
                for (int i = 0; i < 16; ++i) wv[i] = wp[(size_t)(k0 + i) * 9216];
#pragma unroll
                for (int i = 0; i < 16; ++i)
#pragma unroll
                    for (int b = 0; b < 16; ++b) acc[b] += sc[b * 1024 + F.wave * 128 + k0 + i] * wv[i]; }
#pragma unroll
            for (int b = 0; b < 16; ++b) red[(F.wave * 16 + b) * 64 + F.lane] = acc[b];
            __syncthreads();
            for (int i = F.tid; i < 16 * 64; i += NTHREADS) { const int b = i >> 6, l = i & 63; float s = 0.f;
#pragma unroll
                for (int w = 0; w < 8; ++w) s += red[(w * 16 + b) * 64 + l];
                ((float*)(ws + WS_ADA))[b * 9216 + cg * 64 + l] = s + a.in[I_BADA][cg * 64 + l]; }
            __syncthreads();
        }
        __syncthreads();
    }
    { const int slot = F.vcu - (F.G - 32);
      if (slot >= 0) { const int kv = slot >> 4, part = slot & 15, c = F.tid & 255, half = F.tid >> 8;
        const float* w1 = a.in[I_CW1] + (size_t)kv * 2048 * 256 + (size_t)(part * 128 + half * 64) * 256 + c; const float* pe = a.in[I_PE] + (size_t)kv * 2048 + part * 128 + half * 64;
        float sacc = 0.f;
#pragma unroll 1
        for (int r0 = 0; r0 < 64; r0 += 16) { float wv[16];
#pragma unroll
            for (int i = 0; i < 16; ++i) wv[i] = w1[(size_t)(r0 + i) * 256];
#pragma unroll
            for (int i = 0; i < 16; ++i) sacc += pe[r0 + i] * wv[i]; }
        LAS float* red = (LAS float*)(F.lds + 98304);
        __syncthreads();
        if (half) red[c] = sacc;
        __syncthreads();
        if (!half) ((float*)(ws + WS_B1P))[(kv * 16 + part) * 256 + c] = sacc + red[c];
        __syncthreads(); } }
    LAS unsigned* scr = (LAS unsigned*)(F.lds + F.wave * 16384);
    const int gw = F.vcu * NWAVES + F.wave, NGW = F.G * NWAVES;
    constexpr int I_GU = (DM / 64) * (NPROJ / 64), I_DN = (DFF / 64) * (DM / 64), I_IN = (DM / 64) * (NPROJ / 64), I_UP = (512 / 64) * (DM / 64), I_OUT = (DM / 64) * (DM / 64), I_C1 = (1024 / 64) * (512 / 64);
    constexpr int A_FF = (DM / 64) * (DFF / 256), A_IN = (DM / 64) * ((5408 + 255) / 256);
    constexpr int NITEMS = 4 * A_FF + A_IN + 2 * I_DN + 2 * I_UP + I_OUT + 2 * I_C1;
    unsigned* amx = (unsigned*)(ws + WS_CTL) + CW_AMAX;
    for (int it = gw; it < NITEMS; it += NGW) {
        int r = it;
        if (r < 4 * A_FF) { const int mi = r / A_FF, layer = mi >> 1, up = mi & 1;
            amax_item4((up ? a.in[I_WU] : a.in[I_WG]) + (size_t)layer * DM * DFF, DFF, DFF, amx + layer * NPROJ + up * DFF, r - mi * A_FF, F.lane); continue; } r -= 4 * A_FF;
        if (r < A_IN) { amax_item4(a.in[I_WIN], 5408, 5408, amx + 2 * NPROJ, r, F.lane); continue; } r -= A_IN;
        if (r < I_DN) { if (DOWN_F8_0) transpose_item_f8(a, 0, (bf16*)(ws + WS_W1D), scr, r, F.lane); else transpose_item<1>(a, 0, DFF, DM, (bf16*)(ws + WS_W1D), scr, r, F.lane); continue; } r -= I_DN;
        if (r < I_DN) { if (DOWN_F8_1) transpose_item_f8(a, 1, (bf16*)(ws + WS_W1D) + (size_t)DM * DFF, scr, r, F.lane); else transpose_item<1>(a, 1, DFF, DM, (bf16*)(ws + WS_W1D) + (size_t)DM * DFF, scr, r, F.lane); continue; } r -= I_DN;
        if (r < I_UP) { transpose_item<3>(a, 0, 512, DM, (bf16*)(ws + WS_WUPM), scr, r, F.lane, 1024); continue; } r -= I_UP;
        if (r < I_UP) { transpose_item<4>(a, 0, 512, DM, (bf16*)(ws + WS_WUPM) + 512, scr, r, F.lane, 1024); continue; } r -= I_UP;
        if (r < I_OUT) { transpose_item<5>(a, 0, DM, DM, (bf16*)(ws + WS_WOUT), scr, r, F.lane); continue; } r -= I_OUT;
        if (r < I_C1) { transpose_item<6>(a, 0, 1024, 512, (bf16*)(ws + WS_WC1), scr, r, F.lane); continue; } r -= I_C1;
        transpose_item<6>(a, 1, 1024, 512, (bf16*)(ws + WS_WC1) + (size_t)512 * 1024, scr, r, F.lane);
    }
}

template <int MODE, bool RES_BF = false, bool OUT_BF = false, bool U_I8 = false> __device__ __forceinline__ void thin_phase(const Args& a, Frame& F, const void* res_, const bf16* f, void* out_, bf16* u, int s_post, int s_pre, float rw) {
    const float* res = (const float*)res_; const bf16* resb = (const bf16*)res_; float* out = (float*)out_; bf16* outb = (bf16*)out_;
    constexpr int R = 4;
    const float* ada = (const float*)(a.ws + WS_ADA); const float* gains = a.in[I_GAINS];
    const int gw = F.vcu * NWAVES + F.wave, NGW = F.G * NWAVES;
    for (int row0 = gw * R; row0 < T; row0 += NGW * R) {
        const int b = row0 >> 12;
        f32x4 h[R][4]; v2u fw[R][4];
#pragma unroll
        for (int r = 0; r < R; ++r)
#pragma unroll
            for (int j = 0; j < 4; ++j) { if (RES_BF) { const v2u w = *(const v2u*)(resb + (size_t)(row0 + r) * DM + 256 * j + 4 * F.lane); h[r][j] = (f32x4){bflo(w.x), bfhi(w.x), bflo(w.y), bfhi(w.y)}; }
                else h[r][j] = *(const f32x4*)(res + (size_t)(row0 + r) * DM + 256 * j + 4 * F.lane);
                if (MODE != 0) fw[r][j] = *(const v2u*)(f + (size_t)(row0 + r) * DM + 256 * j + 4 * F.lane); }
        if (MODE != 0) {
            const float* gp = gains + (2 * s_post + 1) * DM; const float* gt = ada + (size_t)b * 9216 + (s_post * 3 + 2) * DM;
            f32x4 g4[4], t4[4];
#pragma unroll
            for (int j = 0; j < 4; ++j) { g4[j] = *(const f32x4*)(gp + 256 * j + 4 * F.lane); t4[j] = *(const f32x4*)(gt + 256 * j + 4 * F.lane) * rw; }
#pragma unroll
            for (int r = 0; r < R; ++r) { f32x4 fv[4]; float ss = 0.f;
#pragma unroll
                for (int j = 0; j < 4; ++j) { const v2u w = fw[r][j]; fv[j] = (f32x4){bflo(w.x), bfhi(w.x), bflo(w.y), bfhi(w.y)};
                    ss += fv[j][0] * fv[j][0] + fv[j][1] * fv[j][1] + fv[j][2] * fv[j][2] + fv[j][3] * fv[j][3]; }
                const float rstd = rsqrtf(wave_sum(ss) * (1.f / DM) + EPS);
#pragma unroll
                for (int j = 0; j < 4; ++j) { h[r][j] = h[r][j] + t4[j] * (fv[j] * rstd * g4[j]);
                    if (OUT_BF) { v2u w; w.x = pk2(h[r][j][0], h[r][j][1]); w.y = pk2(h[r][j][2], h[r][j][3]); *(v2u*)(outb + (size_t)(row0 + r) * DM + 256 * j + 4 * F.lane) = w; }
                    else *(f32x4*)(out + (size_t)(row0 + r) * DM + 256 * j + 4 * F.lane) = h[r][j]; } }
        }
        if (MODE != 2) {
            const float* gp = gains + (2 * s_pre) * DM; const float* sh = ada + (size_t)b * 9216 + (s_pre * 3 + 0) * DM; const float* sc = sh + DM;
            f32x4 g4[4], s4[4], c4[4];
#pragma unroll
            for (int j = 0; j < 4; ++j) { g4[j] = *(const f32x4*)(gp + 256 * j + 4 * F.lane); s4[j] = *(const f32x4*)(sh + 256 * j + 4 * F.lane); c4[j] = 1.f + *(const f32x4*)(sc + 256 * j + 4 * F.lane); }
#pragma unroll
            for (int r = 0; r < R; ++r) { float ss = 0.f;
#pragma unroll
                for (int j = 0; j < 4; ++j) ss += h[r][j][0] * h[r][j][0] + h[r][j][1] * h[r][j][1] + h[r][j][2] * h[r][j][2] + h[r][j][3] * h[r][j][3];
                const float rstd = rsqrtf(wave_sum(ss) * (1.f / DM) + EPS);
                if (U_I8) { f32x4 y[4]; float am = 0.f;
#pragma unroll
                    for (int j = 0; j < 4; ++j) { y[j] = (h[r][j] * rstd * g4[j]) * c4[j] + s4[j]; am = fmaxf(am, fmaxf(fmaxf(fabsf(y[j][0]), fabsf(y[j][1])), fmaxf(fabsf(y[j][2]), fabsf(y[j][3])))); }
                    am = wave_max(am); const float sc_ = am > 0.f ? am * (1.f / 127.f) : 1.f, inv = 1.f / sc_;
                    if (F.lane == 0) ((float*)(a.ws + WS_RS))[row0 + r] = sc_;
#pragma unroll
                    for (int j = 0; j < 4; ++j) { const int q0 = (int)rintf(y[j][0] * inv), q1 = (int)rintf(y[j][1] * inv), q2 = (int)rintf(y[j][2] * inv), q3 = (int)rintf(y[j][3] * inv);
                        *(unsigned*)((unsigned char*)u + (size_t)(row0 + r) * DM + 256 * j + 4 * F.lane) = (unsigned)(q0 & 255) | ((unsigned)(q1 & 255) << 8) | ((unsigned)(q2 & 255) << 16) | ((unsigned)(q3 & 255) << 24); } }
                else
#pragma unroll
                for (int j = 0; j < 4; ++j) { const f32x4 y = (h[r][j] * rstd * g4[j]) * c4[j] + s4[j];
                    v2u w; w.x = pk2(y[0], y[1]); w.y = pk2(y[2], y[3]);
                    *(v2u*)(u + (size_t)(row0 + r) * DM + 256 * j + 4 * F.lane) = w; } }
        }
    }
}

constexpr int MQ_OFF = 0, MK_OFF = 64 * 129 * 4, MV_OFF = 2 * 64 * 129 * 4, MS_OFF = 3 * 64 * 129 * 4, MCT_OFF = MS_OFF + 64 * 65 * 4, MVEC_OFF = MCT_OFF + 128 * 130 * 2;
static_assert(MVEC_OFF + 8 * 256 <= MISC_OFF, "mlstm lds");
template <bool WANTQ> __device__ __forceinline__ void mlstm_load_chunk(const Args& a, Frame& F, int b, int h, int c) {
    unsigned char* rc = a.ws + WS_RC;
    const bf16* qm = (const bf16*)(rc + RC_QM); const bf16* km = (const bf16*)(rc + RC_KM); const bf16* vm = (const bf16*)(rc + RC_VM); const float* ifm = (const float*)(rc + RC_IF);
    LAS float* Qs = (LAS float*)(F.lds + MQ_OFF); LAS float* Ks = (LAS float*)(F.lds + MK_OFF); LAS float* Vs = (LAS float*)(F.lds + MV_OFF);
    LAS float* bcum = (LAS float*)(F.lds + MVEC_OFF); LAS float* ig = bcum + 64;
    const int t0 = c * CHUNK; const size_t row0 = (size_t)b * SEQ + t0;
    if (F.tid < 64) { const float* g = ifm + (row0 + F.tid) * 8; const float fp = g[4 + h] + a.in[I_GATEB][4 + h];
        ig[F.tid] = g[h] + a.in[I_GATEB][h];
        bcum[F.tid] = fminf(fp, 0.f) - log1pf(__expf(-fabsf(fp))); }
    __syncthreads();
    if (F.tid == 0) { float s = 0.f; for (int i = 0; i < 64; ++i) { s += bcum[i]; bcum[i] = s; } }
    const float* cw = a.in[I_CONVW]; const float* cb = a.in[I_CONVB];
    for (int idx = F.tid; idx < 64 * 128; idx += NTHREADS) { const int t = idx >> 7, d = idx & 127, ch = h * 128 + d;
        float accq = cb[ch], acck = cb[512 + ch];
#pragma unroll
        for (int j = 0; j < 4; ++j) { const int tt = t0 + t - 3 + j; if (tt >= 0) { const size_t r = (size_t)b * SEQ + tt;
                if (WANTQ) accq += cw[j * 1024 + ch] * bf2f(qm[r * 512 + ch]);
                acck += cw[j * 1024 + 512 + ch] * bf2f(km[r * 512 + ch]); } }
        if (WANTQ) Qs[t * 129 + d] = siluf_(accq);
        Ks[t * 129 + d] = siluf_(acck) * 0.08838834764831845f;
        Vs[t * 129 + d] = bf2f(vm[(row0 + t) * 512 + ch]); }
    __syncthreads();
}
__device__ __forceinline__ void mlstm_local_unit(const Args& a, Frame& F, int unit) {
    const int c = unit & 63, h = (unit >> 6) & 3, b = unit >> 8;
    mlstm_load_chunk<false>(a, F, b, h, c);
    LAS float* Ks = (LAS float*)(F.lds + MK_OFF); LAS float* Vs = (LAS float*)(F.lds + MV_OFF);
    LAS float* bcum = (LAS float*)(F.lds + MVEC_OFF); LAS float* ig = bcum + 64; LAS float* wv = bcum + 128;
    const float blast = bcum[63];
    float g = -1e30f; if (F.tid < 64) g = blast - bcum[F.tid] + ig[F.tid];
    float mloc = 0.f;
    if (F.wave == 0) { mloc = wave_max(g); wv[F.tid] = __expf(g - mloc); if (F.tid == 0) { float* cs = (float*)(a.ws + WS_CSC) + (size_t)unit * 2; cs[0] = blast; cs[1] = mloc; } }
    __syncthreads();
    const int e = F.tid >> 2, dq = (F.tid & 3) * 32;
    float acc[32];
#pragma unroll
    for (int i = 0; i < 32; ++i) acc[i] = 0.f;
    for (int s = 0; s < 64; ++s) { const float vv = Vs[s * 129 + e] * wv[s];
#pragma unroll
        for (int i = 0; i < 32; ++i) acc[i] += vv * Ks[s * 129 + dq + i]; }
    bf16* st = (bf16*)(a.ws + WS_RB) + (size_t)unit * 16384 + e * 128 + dq;
#pragma unroll
    for (int i = 0; i < 32; i += 8) { v4u w; w.x = pk2(acc[i], acc[i + 1]); w.y = pk2(acc[i + 2], acc[i + 3]); w.z = pk2(acc[i + 4], acc[i + 5]); w.w = pk2(acc[i + 6], acc[i + 7]); *(v4u*)(st + i) = w; }
    if (F.tid < 128) { float s = 0.f; for (int t = 0; t < 64; ++t) s += wv[t] * Ks[t * 129 + F.tid]; ((float*)(a.ws + WS_NST))[(size_t)unit * 128 + F.tid] = s; }
    __syncthreads();
}
__device__ __forceinline__ void mlstm_scan(const Args& a, Frame& F) {
    const float* csc = (const float*)(a.ws + WS_CSC); float* mprev = (float*)(a.ws + WS_MPREV);
    bf16* st = (bf16*)(a.ws + WS_RB); float* nst = (float*)(a.ws + WS_NST);
    const int gt = F.vcu * NTHREADS + F.tid, NGT = F.G * NTHREADS;
    LAS float* tab = (LAS float*)F.lds;
    for (int idx = gt; idx < 64 * 2048; idx += NGT) { const int bh = idx >> 11, p = idx & 2047;
        __syncthreads();
        const int quarter = (idx - F.tid) >> 9 & 3;
        if (F.tid == 0) { float m = 0.f; for (int c = 0; c < 64; ++c) { const float bl = csc[(bh * 64 + c) * 2], ml = csc[(bh * 64 + c) * 2 + 1]; const float mn = fmaxf(bl + m, ml); tab[2 * c] = __expf(bl + m - mn); tab[2 * c + 1] = __expf(ml - mn);
                                                     if (quarter == 0) mprev[bh * 64 + c] = m; m = mn; } }
        __syncthreads();
        if (F.tid >= 480) { const int d = quarter * 32 + (F.tid - 480); float* nb = nst + (size_t)(bh * 64) * 128 + d; float nl[64], n = 0.f;
#pragma unroll
            for (int c = 0; c < 64; ++c) nl[c] = nb[(size_t)c * 128];
#pragma unroll
            for (int c = 0; c < 64; ++c) { nb[(size_t)c * 128] = n; n = tab[2 * c] * n + tab[2 * c + 1] * nl[c]; } }
        float cv[8];
#pragma unroll
        for (int i = 0; i < 8; ++i) cv[i] = 0.f;
        v4u* base = (v4u*)(st + (size_t)(bh * 64) * 16384) + p;
#pragma unroll 1
        for (int c0 = 0; c0 < 64; c0 += 8) { v4u uw[8];
#pragma unroll
            for (int k = 0; k < 8; ++k) uw[k] = base[(size_t)(c0 + k) * 2048];
#pragma unroll
            for (int k = 0; k < 8; ++k) { const int c = c0 + k;
                v4u o; o.x = pk2(cv[0], cv[1]); o.y = pk2(cv[2], cv[3]); o.z = pk2(cv[4], cv[5]); o.w = pk2(cv[6], cv[7]); base[(size_t)c * 2048] = o;
                const float dec = tab[2 * c], sc = tab[2 * c + 1];
                float x[8]; unpack8(uw[k], x);
#pragma unroll
                for (int i = 0; i < 8; ++i) cv[i] = dec * cv[i] + sc * x[i]; } } }

}
__device__ __forceinline__ void mlstm_out_unit(const Args& a, Frame& F, int unit) {
    const int c = unit & 63, h = (unit >> 6) & 3, b = unit >> 8;
    mlstm_load_chunk<true>(a, F, b, h, c);
    LAS float* Qs = (LAS float*)(F.lds + MQ_OFF); LAS float* Ks = (LAS float*)(F.lds + MK_OFF); LAS float* Vs = (LAS float*)(F.lds + MV_OFF); LAS float* Ss = (LAS float*)(F.lds + MS_OFF);
    LAS bf16* CT = (LAS bf16*)(F.lds + MCT_OFF);
    LAS float* bcum = (LAS float*)(F.lds + MVEC_OFF); LAS float* ig = bcum + 64; LAS float* mt = bcum + 128; LAS float* wi = bcum + 192; LAS float* den = bcum + 256; LAS float* nv = bcum + 320;
    const float mp = ((const float*)(a.ws + WS_MPREV))[unit];
    const bf16* ctg = (const bf16*)(a.ws + WS_RB) + (size_t)unit * 16384;
    for (int idx = F.tid; idx < 128 * 64; idx += NTHREADS) { const int e = idx >> 6, dp = idx & 63; *(LAS unsigned*)(CT + e * 130 + 2 * dp) = *(const unsigned*)(ctg + e * 128 + 2 * dp); }
    if (F.tid < 128) nv[F.tid] = ((const float*)(a.ws + WS_NST))[(size_t)unit * 128 + F.tid];
    if (F.tid < 64) { const int t = F.tid; const float bt = bcum[t], at = bt + mp; float mm = at;
        for (int s = 0; s <= t; ++s) mm = fmaxf(mm, bt - bcum[s] + ig[s]);
        mt[t] = mm; wi[t] = __expf(at - mm); }
    __syncthreads();
    { const int s = F.tid & 63, tb = (F.tid >> 6) * 8;
#pragma unroll
        for (int i = 0; i < 8; ++i) { const int t = tb + i; float v = 0.f;
            if (s <= t) { float d = 0.f; for (int k = 0; k < 128; ++k) d += Qs[t * 129 + k] * Ks[s * 129 + k]; v = d * __expf(bcum[t] - bcum[s] + ig[s] - mt[t]); }
            Ss[t * 65 + s] = v; } }
    __syncthreads();
    if (F.tid < 64) { const int t = F.tid; float sd = 0.f; for (int s = 0; s <= t; ++s) sd += Ss[t * 65 + s]; float qn = 0.f; for (int k = 0; k < 128; ++k) qn += Qs[t * 129 + k] * nv[k];
        den[t] = sd + wi[t] * qn; }
    const int t = F.tid >> 3, e0 = (F.tid & 7) * 16;
    float num[16], qc[16];
#pragma unroll
    for (int i = 0; i < 16; ++i) { num[i] = 0.f; qc[i] = 0.f; }
    for (int s = 0; s <= t; ++s) { const float sv = Ss[t * 65 + s];
#pragma unroll
        for (int i = 0; i < 16; ++i) num[i] += sv * Vs[s * 129 + e0 + i]; }
    for (int k = 0; k < 128; ++k) { const float qv = Qs[t * 129 + k];
#pragma unroll
        for (int i = 0; i < 16; ++i) qc[i] += qv * bf2f(CT[(e0 + i) * 130 + k]); }
    __syncthreads();
    const float dn = fmaxf(fabsf(den[t]), __expf(-mt[t])), wt = wi[t];
    float ss = 0.f;
#pragma unroll
    for (int i = 0; i < 16; ++i) { num[i] = (num[i] + wt * qc[i]) / dn; ss += num[i] * num[i]; }
    ss += __shfl_xor(ss, 1); ss += __shfl_xor(ss, 2); ss += __shfl_xor(ss, 4);
    const float rstd = rsqrtf(ss * (1.f / 128.f) + EPS);
    const size_t row = (size_t)b * SEQ + c * CHUNK + t; const int ch = h * 128 + e0;
    const bf16* om = (const bf16*)(a.ws + WS_RC + RC_OM) + row * 512 + ch; const float* hg = a.in[I_HGAIN] + ch;
    float o[16];
#pragma unroll
    for (int i = 0; i < 16; ++i) o[i] = sigmoidf_(bf2f(om[i])) * num[i] * rstd * hg[i];
    bf16* hm = (bf16*)(a.ws + WS_RA) + row * 1024 + ch;
#pragma unroll
    for (int i = 0; i < 16; i += 8) { v4u w; w.x = pk2(o[i], o[i + 1]); w.y = pk2(o[i + 2], o[i + 3]); w.z = pk2(o[i + 4], o[i + 5]); w.w = pk2(o[i + 6], o[i + 7]); *(v4u*)(hm + i) = w; }
    __syncthreads();
}


struct AttState { float m[4], l[4], o[4]; };
__device__ __forceinline__ void nsa_dot4(const bf16* krow, const LAS float* qs, float (&s)[4]) {
    s[0] = s[1] = s[2] = s[3] = 0.f;
#pragma unroll
    for (int c8 = 0; c8 < 8; ++c8) { const v4u kw = *(const v4u*)(krow + c8 * 8);
        float kf[8] = {bflo(kw.x), bfhi(kw.x), bflo(kw.y), bfhi(kw.y), bflo(kw.z), bfhi(kw.z), bflo(kw.w), bfhi(kw.w)};
#pragma unroll
        for (int h = 0; h < 4; ++h)
#pragma unroll
            for (int i = 0; i < 8; ++i) s[h] += kf[i] * qs[h * 64 + c8 * 8 + i]; }
}
__device__ __forceinline__ void nsa_attend(AttState& A, const bf16* Kb, const bf16* Vb, int base, int t, const LAS float* qs, LAS float* pl, int lane) {
    const int pos = base + lane; const bool valid = pos >= 0 && pos <= t;
    float s[4] = {0.f, 0.f, 0.f, 0.f};
    if (valid) nsa_dot4(Kb + (size_t)pos * 64, qs, s);
#pragma unroll
    for (int h = 0; h < 4; ++h) { const float mb = wave_max(valid ? s[h] : -1e30f), mn = fmaxf(A.m[h], mb), al = __expf(A.m[h] - mn), p = valid ? __expf(s[h] - mn) : 0.f;
        A.l[h] = A.l[h] * al + wave_sum(p); A.o[h] *= al; A.m[h] = mn; pl[h * 64 + lane] = p; }
    LDS_WAIT();
    const int k0 = base < 0 ? -base : 0, k1 = (t - base) < 63 ? (t - base) : 63;
    for (int kk = k0; kk <= k1; ++kk) { const float v = bf2f(Vb[(size_t)(base + kk) * 64 + lane]);
#pragma unroll
        for (int h = 0; h < 4; ++h) A.o[h] += pl[h * 64 + kk] * v; }
    LDS_WAIT();
}
__device__ __forceinline__ void nsa_query(const Args& a, Frame& F, int qid, LAS float* wl) {
    const int t = qid & 4095, g = (qid >> 12) & 1, b = qid >> 13, bg = b * 2 + g, lane = F.lane;
    const size_t row = (size_t)b * SEQ + t;
    unsigned char* rc = a.ws + WS_RC;
    LAS float* qs = wl; LAS float* pc = wl + 256; LAS float* ps = wl + 512; LAS float* pl = wl + 768;
    const bf16* qn = (const bf16*)(rc + RC_QN) + row * 512 + g * 256;
#pragma unroll
    for (int h = 0; h < 4; ++h) qs[h * 64 + lane] = bf2f(qn[h * 64 + lane]) * 0.6931471805599453f;
    const float* gg = (const float*)(rc + RC_GG) + row * 24 + g * 12;
    float gate[4][3];
#pragma unroll
    for (int h = 0; h < 4; ++h)
#pragma unroll
        for (int r = 0; r < 3; ++r) gate[h][r] = sigmoidf_(gg[h * 3 + r]);
    LDS_WAIT();
    const bf16* kc = (const bf16*)(a.ws + WS_KCMP) + (size_t)bg * 256 * 64; const bf16* vc = kc + (size_t)32 * 256 * 64;
    const int nvalid = t >= 31 ? ((t - 31) >> 4) + 1 : 0;
    float sc[4][4];
#pragma unroll
    for (int kk = 0; kk < 4; ++kk) { const int n = kk * 64 + lane; float s[4] = {0.f, 0.f, 0.f, 0.f}; if (n < nvalid) nsa_dot4(kc + (size_t)n * 64, qs, s);
#pragma unroll
        for (int h = 0; h < 4; ++h) sc[h][kk] = s[h]; }
    float psum[4] = {0.f, 0.f, 0.f, 0.f}, ocmp[4];
#pragma unroll
    for (int h = 0; h < 4; ++h) { float mx = -1e30f;
#pragma unroll
        for (int kk = 0; kk < 4; ++kk) if (kk * 64 + lane < nvalid) mx = fmaxf(mx, sc[h][kk]);
        mx = wave_max(mx); float e[4], l = 0.f;
#pragma unroll
        for (int kk = 0; kk < 4; ++kk) { e[kk] = (kk * 64 + lane < nvalid) ? __expf(sc[h][kk] - mx) : 0.f; l += e[kk]; }
        l = fmaxf(wave_sum(l), 1e-30f);
#pragma unroll
        for (int kk = 0; kk < 4; ++kk) { const float p = e[kk] / l; psum[kk] += p; pc[kk * 64 + lane] = p; }
        LDS_WAIT();
        float o = 0.f; for (int n = 0; n < nvalid; ++n) o += pc[n] * bf2f(vc[(size_t)n * 64 + lane]);
        ocmp[h] = o; LDS_WAIT(); }
#pragma unroll
    for (int kk = 0; kk < 4; ++kk) ps[kk * 64 + lane] = psum[kk];
    LDS_WAIT();
    const int cur = t >> 6;
    float imp = 0.f;
#pragma unroll
    for (int i = -1; i <= 3; ++i) { const int n = 4 * lane + i; if (n >= 0 && n < NCMP) imp += ps[n]; }
    const bool forced = (lane == 0) || (lane == cur) || (lane == cur - 1);
    const float val = (lane <= cur) ? (forced ? 1e4f : imp) : -1.f;
    int rank = 0;
    for (int i = 0; i < 64; ++i) { const float vi = __shfl(val, i); rank += (vi > val || (vi == val && i < lane)) ? 1 : 0; }
    const unsigned long long mask = __ballot(rank < 16);
    AttState S;
#pragma unroll
    for (int h = 0; h < 4; ++h) { S.m[h] = -1e30f; S.l[h] = 0.f; S.o[h] = 0.f; }
    const bf16* ks = (const bf16*)(rc + RC_KV + 2 * 16 * MiB) + (size_t)bg * 4096 * 64; const bf16* vs = (const bf16*)(rc + RC_KV + 3 * 16 * MiB) + (size_t)bg * 4096 * 64;
    for (int j = 0; j <= cur; ++j) if ((mask >> j) & 1ull) nsa_attend(S, ks, vs, 64 * j, t, qs, pl, lane);
    AttState W;
#pragma unroll
    for (int h = 0; h < 4; ++h) { W.m[h] = -1e30f; W.l[h] = 0.f; W.o[h] = 0.f; }
    const bf16* kw = (const bf16*)(rc + RC_KV + 4 * 16 * MiB) + (size_t)bg * 4096 * 64; const bf16* vw = (const bf16*)(rc + RC_KV + 5 * 16 * MiB) + (size_t)bg * 4096 * 64;
    for (int kk = 0; kk < 4; ++kk) { const int base = t - 255 + 64 * kk; if (base + 63 >= 0) nsa_attend(W, kw, vw, base, t, qs, pl, lane); }
    bf16* outp = (bf16*)(a.ws + WS_RA) + row * 1024 + 512 + g * 256;
#pragma unroll
    for (int h = 0; h < 4; ++h) { const float o = gate[h][0] * ocmp[h] + gate[h][1] * S.o[h] / fmaxf(S.l[h], 1e-30f) + gate[h][2] * W.o[h] / fmaxf(W.l[h], 1e-30f);
        outp[h * 64 + lane] = (bf16)f2bf(o); }
}

typedef float f32x16 __attribute__((ext_vector_type(16)));
typedef short s16x4 __attribute__((ext_vector_type(4)));
typedef float f32x2_t __attribute__((ext_vector_type(2))); typedef __bf16 bf16x2_t __attribute__((ext_vector_type(2)));
constexpr int NKS = 144, NVS = 192;
constexpr int NK_OFF = 0, NKBUF = 64 * NKS, NV_OFF = 4 * NKBUF, NVBUF = 64 * NVS, NPSW = 8 * 260, NPS_OFF = NV_OFF + 4 * NVBUF, NMASK_OFF = NPS_OFF + 8 * NPSW * 4, NWS_OFF = NMASK_OFF + 512, NSA_LDS_END = NWS_OFF + 8 * 256;
static_assert(NSA_LDS_END <= MISC_OFF, "nsa lds");
constexpr float L2E = 1.4426950408889634f;
__device__ __forceinline__ int crow(int r, int hi) { return (r & 3) + 8 * (r >> 2) + 4 * hi; }
__device__ __forceinline__ unsigned cvtpk(float lo, float hi) { f32x2_t v = {lo, hi}; bf16x2_t b = __builtin_convertvector(v, bf16x2_t); return __builtin_bit_cast(unsigned, b); }
__device__ __forceinline__ float max3f(float a, float b, float c) { float r; asm("v_max3_f32 %0, %1, %2, %3" : "=v"(r) : "v"(a), "v"(b), "v"(c)); return r; }
template <int CTRL> __device__ __forceinline__ float dpp_quad(float v) { return __builtin_bit_cast(float, __builtin_amdgcn_update_dpp(0, __builtin_bit_cast(int, v), CTRL, 0xF, 0xF, true)); }
__device__ __forceinline__ float swapmax(float v) { auto rr = __builtin_amdgcn_permlane32_swap(__float_as_uint(v), __float_as_uint(v), false, false); return fmaxf(__uint_as_float(rr[0]), __uint_as_float(rr[1])); }
__device__ __forceinline__ float swapsum(float v) { auto rr = __builtin_amdgcn_permlane32_swap(__float_as_uint(v), __float_as_uint(v), false, false); return __uint_as_float(rr[0]) + __uint_as_float(rr[1]); }
__device__ __forceinline__ s16x4 vtr(const LAS unsigned char* p) { typedef short v4i16_t __attribute__((ext_vector_type(4))); return __builtin_bit_cast(s16x4, __builtin_amdgcn_ds_read_tr16_b64_v4i16((LAS v4i16_t*)p)); }
__device__ __forceinline__ void nsa_qk(f32x16& p0, f32x16& p1, const LAS unsigned char* kb, const bf16x8 (&qr)[4], const f32x16& cinit, int r32, int hi) {
    const LAS unsigned char* kp = kb + r32 * NKS + hi * 16;
    bf16x8 kf[8];
#pragma unroll
    for (int d0 = 0; d0 < 4; ++d0) { kf[2 * d0] = *(const LAS bf16x8*)(kp + d0 * 32); kf[2 * d0 + 1] = *(const LAS bf16x8*)(kp + 32 * NKS + d0 * 32); }
    __builtin_amdgcn_sched_barrier(0);
    p0 = __builtin_amdgcn_mfma_f32_32x32x16_bf16(kf[0], qr[0], cinit, 0, 0, 0); p1 = __builtin_amdgcn_mfma_f32_32x32x16_bf16(kf[1], qr[0], cinit, 0, 0, 0);
#pragma unroll
    for (int d0 = 1; d0 < 4; ++d0) { p0 = __builtin_amdgcn_mfma_f32_32x32x16_bf16(kf[2 * d0], qr[d0], p0, 0, 0, 0); p1 = __builtin_amdgcn_mfma_f32_32x32x16_bf16(kf[2 * d0 + 1], qr[d0], p1, 0, 0, 0); }
}
__device__ __forceinline__ void nsa_vload(bf16x8 (&vf)[4], const LAS unsigned char* vb, int lane, int d0) {
    const int hi = lane >> 5, blk = (lane >> 4) & 1, q = (lane & 15) >> 2, p = lane & 3;
    const LAS unsigned char* base = vb + (4 * hi + q) * NVS + (16 * blk + 4 * p) * 2 + d0 * 64;
#pragma unroll
    for (int ks = 0; ks < 4; ++ks) { const s16x4 lo = vtr(base + (ks * 16) * NVS), hh = vtr(base + (ks * 16 + 8) * NVS);
        vf[ks] = (bf16x8){lo[0], lo[1], lo[2], lo[3], hh[0], hh[1], hh[2], hh[3]}; }
}
__device__ __forceinline__ void nsa_pv(f32x16& o, const bf16x8 (&vf)[4], const bf16x8 (&pa)[4]) {
#pragma unroll
    for (int ks = 0; ks < 4; ++ks) o = __builtin_amdgcn_mfma_f32_32x32x16_bf16(pa[ks], vf[ks], o, 0, 0, 0);
}
__device__ __forceinline__ void nsa_pack(bf16x8 (&pa)[4], const f32x16& p0, const f32x16& p1) {
    v4u w;
    w.x = cvtpk(p0[0], p0[1]); w.y = cvtpk(p0[2], p0[3]); w.z = cvtpk(p0[4], p0[5]); w.w = cvtpk(p0[6], p0[7]); pa[0] = __builtin_bit_cast(bf16x8, w);
    w.x = cvtpk(p0[8], p0[9]); w.y = cvtpk(p0[10], p0[11]); w.z = cvtpk(p0[12], p0[13]); w.w = cvtpk(p0[14], p0[15]); pa[1] = __builtin_bit_cast(bf16x8, w);
    w.x = cvtpk(p1[0], p1[1]); w.y = cvtpk(p1[2], p1[3]); w.z = cvtpk(p1[4], p1[5]); w.w = cvtpk(p1[6], p1[7]); pa[2] = __builtin_bit_cast(bf16x8, w);
    w.x = cvtpk(p1[8], p1[9]); w.y = cvtpk(p1[10], p1[11]); w.z = cvtpk(p1[12], p1[13]); w.w = cvtpk(p1[14], p1[15]); pa[3] = __builtin_bit_cast(bf16x8, w);
}
__device__ __forceinline__ void row_bcast(float v, LAS float* wsf, int r32, int hi, float (&f)[16]) {
    if (hi == 0) wsf[r32] = v;
#pragma unroll
    for (int r = 0; r < 16; ++r) f[r] = wsf[crow(r, hi)];
}
constexpr float NSA_THR = 5.f;
__device__ __forceinline__ void nsa_step(const int VAR, f32x16& p0, f32x16& p1, float& mhat, f32x16& negm, f32x16 (&o)[2], float& lsum, int diag, bool rowvalid, bool allvalid, int rel, const LAS unsigned char* vb, LAS float* wsf, int lane, int r32, int hi) {
    bf16x8 vf[4], vg[4]; nsa_vload(vf, vb, lane, 0); nsa_vload(vg, vb, lane, 1);
    __builtin_amdgcn_sched_barrier(0);
    asm volatile("s_nop 15\n\ts_nop 7" : "+v"(p0), "+v"(p1));
    if (diag == 1) {
#pragma unroll
        for (int r = 0; r < 16; ++r) { const int kv = crow(r, hi); p0[r] = kv <= rel ? p0[r] : -INFINITY; p1[r] = kv + 32 <= rel ? p1[r] : -INFINITY; }
    } else if (diag == 2) {
#pragma unroll
        for (int r = 0; r < 16; ++r) { const int kv = crow(r, hi); p0[r] = kv > rel ? p0[r] : -INFINITY; p1[r] = kv + 32 > rel ? p1[r] : -INFINITY; }
    }
    float mx = max3f(p0[0], p1[0], -INFINITY), mxb = max3f(p0[1], p1[1], -INFINITY);
#pragma unroll
    for (int r = 2; r < 16; r += 2) { mx = max3f(mx, p0[r], p1[r]); mxb = max3f(mxb, p0[r + 1], p1[r + 1]); }
    mx = max3f(mx, mxb, -INFINITY);
    mx = rowvalid ? mx : -INFINITY;
    mx = swapmax(mx);
    if (__any(mx > NSA_THR)) {
        const float dl = fmaxf(mx, 0.f); mhat += dl;
#pragma unroll
        for (int r = 0; r < 16; ++r) { p0[r] -= dl; p1[r] -= dl; negm[r] = -mhat; }
        float f[16]; row_bcast(__builtin_amdgcn_exp2f(-dl), wsf, r32, hi, f);
#pragma unroll
        for (int r = 0; r < 16; ++r) { o[0][r] *= f[r]; o[1][r] *= f[r]; }
        lsum *= __builtin_amdgcn_exp2f(-dl); }
#pragma unroll
    for (int r = 0; r < 16; ++r) { if (VAR == 2) { p0[r] += 1.f; p1[r] += 1.f; } else { p0[r] = __builtin_amdgcn_exp2f(p0[r]); p1[r] = __builtin_amdgcn_exp2f(p1[r]); } }
    { float s0 = 0.f, s1 = 0.f;
#pragma unroll
      for (int r = 0; r < 16; ++r) { s0 += p0[r]; s1 += p1[r]; }
      lsum += rowvalid ? s0 + s1 : 0.f; }
    bf16x8 pa[4]; nsa_pack(pa, p0, p1);
    if (!allvalid) { const short km = rowvalid ? (short)-1 : (short)0;
#pragma unroll
        for (int k = 0; k < 4; ++k) { v4u w = __builtin_bit_cast(v4u, pa[k]); const unsigned mk = rowvalid ? 0xffffffffu : 0u; w.x &= mk; w.y &= mk; w.z &= mk; w.w &= mk; pa[k] = __builtin_bit_cast(bf16x8, w); }
        (void)km; }
    __builtin_amdgcn_sched_barrier(0);
    if (VAR != 3) {
        __builtin_amdgcn_sched_barrier(0);
        nsa_pv(o[0], vf, pa);
        nsa_pv(o[1], vg, pa); }
}
__device__ __forceinline__ void compress_l2(const Args& a, Frame& F) {
    constexpr int WRS = 528;
    LAS unsigned char* W2T = F.lds; LAS float* bbl = (LAS float*)(F.lds + 2 * 64 * WRS);
    __syncthreads();
    for (int i = F.tid; i < 2 * 256 * 64; i += NTHREADS) { const int kv = i >> 14, c = (i >> 6) & 255, n = i & 63;
        *(LAS unsigned short*)(W2T + (kv * 64 + n) * WRS + c * 2) = (unsigned short)f2bf(a.in[I_CW2][i]); }
    { const int kv = F.tid >> 8, c = F.tid & 255; const float* b1p = (const float*)(a.ws + WS_B1P) + kv * 16 * 256; float t = a.in[I_CB1][kv * 256 + c];
#pragma unroll
      for (int pt = 0; pt < 16; ++pt) t += b1p[pt * 256 + c];
      bbl[kv * 256 + c] = t; }
    __syncthreads();
    const int gw = F.vcu * NWAVES + F.wave, NGW = F.G * NWAVES, lane = F.lane, r32 = lane & 31, hi = lane >> 5;
    for (int task = gw; task < 512; task += NGW) { const int kv = task >> 8, m0 = (task & 255) * 32, m = m0 + r32, m1 = m + 1 < 8192 ? m + 1 : 8191;
        const float* P = (const float*)(a.ws + WS_RA) + (size_t)kv * 8192 * 512;
        const float* pa_ = P + (size_t)m * 512 + 8 * hi; const float* pb_ = P + (size_t)m1 * 512 + 256 + 8 * hi;
        const LAS unsigned char* wb0 = W2T + (kv * 64 + r32) * WRS + 16 * hi; const LAS unsigned char* wb1 = wb0 + 32 * WRS;
        const LAS float* bbp = bbl + kv * 256 + 8 * hi;
        f32x16 acc0, acc1;
#pragma unroll
        for (int i = 0; i < 16; ++i) { acc0[i] = 0.f; acc1[i] = 0.f; }
#pragma unroll 1
        for (int g = 0; g < 4; ++g) { f32x4 x[4][4];
#pragma unroll
            for (int k4 = 0; k4 < 4; ++k4) { const int c = 16 * (4 * g + k4); x[k4][0] = *(const f32x4*)(pa_ + c); x[k4][1] = *(const f32x4*)(pa_ + c + 4); x[k4][2] = *(const f32x4*)(pb_ + c); x[k4][3] = *(const f32x4*)(pb_ + c + 4); }
#pragma unroll
            for (int k4 = 0; k4 < 4; ++k4) { const int c = 16 * (4 * g + k4);
                const f32x4 bb0 = *(const LAS f32x4*)(bbp + c), bb1 = *(const LAS f32x4*)(bbp + c + 4);
                v4u aw; aw.x = pk2(siluf_(x[k4][0][0] + x[k4][2][0] + bb0[0]), siluf_(x[k4][0][1] + x[k4][2][1] + bb0[1])); aw.y = pk2(siluf_(x[k4][0][2] + x[k4][2][2] + bb0[2]), siluf_(x[k4][0][3] + x[k4][2][3] + bb0[3]));
                aw.z = pk2(siluf_(x[k4][1][0] + x[k4][3][0] + bb1[0]), siluf_(x[k4][1][1] + x[k4][3][1] + bb1[1])); aw.w = pk2(siluf_(x[k4][1][2] + x[k4][3][2] + bb1[2]), siluf_(x[k4][1][3] + x[k4][3][3] + bb1[3]));
                const bf16x8 af = __builtin_bit_cast(bf16x8, aw), b0 = *(const LAS bf16x8*)(wb0 + c * 2), b1 = *(const LAS bf16x8*)(wb1 + c * 2);
                acc0 = __builtin_amdgcn_mfma_f32_32x32x16_bf16(af, b0, acc0, 0, 0, 0); acc1 = __builtin_amdgcn_mfma_f32_32x32x16_bf16(af, b1, acc1, 0, 0, 0); } }
        const float b2a = a.in[I_CB2][kv * 64 + r32], b2b = a.in[I_CB2][kv * 64 + 32 + r32];
        bf16* outp = (bf16*)(a.ws + WS_KCMP) + (size_t)kv * 8192 * 64;
#pragma unroll
        for (int r = 0; r < 16; ++r) { const int mm = m0 + crow(r, hi); const bool pad = (mm & 255) == NCMP;
            outp[(size_t)mm * 64 + r32] = pad ? (bf16)0 : (bf16)f2bf(acc0[r] + b2a); outp[(size_t)mm * 64 + 32 + r32] = pad ? (bf16)0 : (bf16)f2bf(acc1[r] + b2b); }
    }
}
__device__ __forceinline__ void nsa_unit(const int VAR, const Args& a, Frame& F, int bg, int qt, bf16* outbase) {
    const int lane = F.lane, r32 = lane & 31, hi = lane >> 5, w = F.wave, tid = F.tid;
    const int qi = r32 >> 2, h = r32 & 3, t0 = qt * 64, rel = 8 * w + qi, t = t0 + rel, cur = qt, b = bg >> 1, g = bg & 1;
    const size_t row = (size_t)b * SEQ + t;
    unsigned char* rc = a.ws + WS_RC;
    LAS float* PS = (LAS float*)(F.lds + NPS_OFF) + w * NPSW;
    LAS unsigned long long* MASKS = (LAS unsigned long long*)(F.lds + NMASK_OFF);
    LAS float* wsf = (LAS float*)(F.lds + NWS_OFF) + w * 64;
    const int srow = tid >> 3, sch = tid & 7;
    v4u kreg, vreg;
#define NSA_LOADK(ptr) kreg = *(const v4u*)((ptr) + srow * 64 + sch * 8)
#define NSA_LOADV(ptr) vreg = *(const v4u*)((ptr) + srow * 64 + sch * 8)
#define NSA_STOREK(bi) *(LAS v4u*)(F.lds + NK_OFF + (bi) * NKBUF + srow * NKS + sch * 16) = kreg
#define NSA_STOREV(bi) *(LAS v4u*)(F.lds + NV_OFF + (bi) * NVBUF + srow * NVS + sch * 16) = vreg
#define NSA_KB(bi) (F.lds + NK_OFF + (bi) * NKBUF)
#define NSA_VB(bi) (F.lds + NV_OFF + (bi) * NVBUF)
    bf16x8 qr[4];
    { const bf16* qp = (const bf16*)(rc + RC_QN) + row * 512 + (g * 4 + h) * 64 + hi * 8;
#pragma unroll
      for (int d0 = 0; d0 < 4; ++d0) qr[d0] = *(const bf16x8*)(qp + d0 * 16); }
    float g0, g1, g2;
    { const float* gg = (const float*)(rc + RC_GG) + row * 24 + (g * 4 + h) * 3; g0 = sigmoidf_(gg[0]); g1 = sigmoidf_(gg[1]); g2 = sigmoidf_(gg[2]); }
    f32x16 o[2], p0, p1, negm, zero16; float lsum = 0.f;
#pragma unroll
    for (int i = 0; i < 16; ++i) zero16[i] = 0.f;
    float f16[16];
    const bf16* kc = (const bf16*)(a.ws + WS_KCMP) + (size_t)bg * 256 * 64; const bf16* vc = kc + (size_t)32 * 256 * 64;
    const int nvmax = (t0 / 16 + 3) < 255 ? (t0 / 16 + 3) : 255, nb = (VAR == 7) ? 0 : ((nvmax + 63) >> 6);
    const int nv = t >= 31 ? ((t - 31) >> 4) + 1 : 0;
    float m = -1e30f, l = 0.f;
    { v4u ck[4], cv[4];
#pragma unroll
      for (int cb = 0; cb < 4; ++cb) if (cb < nb) { ck[cb] = *(const v4u*)(kc + cb * 4096 + srow * 64 + sch * 8); cv[cb] = *(const v4u*)(vc + cb * 4096 + srow * 64 + sch * 8); }
#pragma unroll
      for (int cb = 0; cb < 4; ++cb) if (cb < nb) { *(LAS v4u*)(F.lds + NK_OFF + cb * NKBUF + srow * NKS + sch * 16) = ck[cb]; *(LAS v4u*)(F.lds + NV_OFF + cb * NVBUF + srow * NVS + sch * 16) = cv[cb]; } }
#pragma unroll
    for (int i = 0; i < 9; ++i) { const int idx = i * 256 + lane * 4; if (idx < NPSW) *(LAS f32x4*)(PS + idx) = (f32x4){0.f, 0.f, 0.f, 0.f}; }
    __syncthreads();
    const int nvmin_w = (t0 + 8 * w >= 31) ? ((t0 + 8 * w - 31) >> 4) + 1 : 0;
    { float mtr = -INFINITY;
#pragma unroll 1
      for (int cb = 0; cb < nb; ++cb) {
        nsa_qk(p0, p1, NSA_KB(cb), qr, zero16, r32, hi);
        asm volatile("s_nop 15\n\ts_nop 7" : "+v"(p0), "+v"(p1));
        if (cb * 64 + 64 > nvmin_w) {
#pragma unroll
            for (int r = 0; r < 16; ++r) { const int n0 = cb * 64 + crow(r, hi); p0[r] = n0 < nv ? p0[r] : -INFINITY; p1[r] = n0 + 32 < nv ? p1[r] : -INFINITY; } }
#pragma unroll
        for (int r = 0; r < 16; ++r) mtr = max3f(mtr, p0[r], p1[r]);
        float s0 = 0.f, s1 = 0.f;
#pragma unroll
        for (int r = 0; r < 16; ++r) { s0 += __builtin_amdgcn_exp2f(p0[r]); s1 += __builtin_amdgcn_exp2f(p1[r]); }
        l += s0 + s1;
      }
      mtr = swapmax(mtr);
      const bool bad = nv > 0 && (mtr > 5.f || mtr < -60.f);
      if (__any(bad)) {
        l = 0.f;
#pragma unroll 1
        for (int cb = 0; cb < nb; ++cb) {
            nsa_qk(p0, p1, NSA_KB(cb), qr, zero16, r32, hi);
            float mx = -1e30f;
#pragma unroll
            for (int r = 0; r < 16; ++r) { const int n0 = cb * 64 + crow(r, hi); p0[r] = n0 < nv ? p0[r] : -1e30f; p1[r] = n0 + 32 < nv ? p1[r] : -1e30f; mx = fmaxf(mx, fmaxf(p0[r], p1[r])); }
            mx = swapmax(mx);
            const float mnew = fmaxf(m, mx); l *= __builtin_amdgcn_exp2f(m - mnew); m = mnew; const float nm = mnew < -1e29f ? 0.f : -mnew;
            float s = 0.f;
#pragma unroll
            for (int r = 0; r < 16; ++r) s += __builtin_amdgcn_exp2f(p0[r] + nm) + __builtin_amdgcn_exp2f(p1[r] + nm);
            l += s;
        }
      } else m = 0.f;
    }
    l = swapsum(l);
    f32x16 cvec;
    { const float cc = (nv > 0 && l > 0.f) ? -(m + __builtin_amdgcn_logf(l)) : 0.f;
#pragma unroll
      for (int i = 0; i < 16; ++i) cvec[i] = cc; }
#pragma unroll
    for (int i = 0; i < 16; ++i) { o[0][i] = 0.f; o[1][i] = 0.f; }
#pragma unroll 1
    for (int cb = 0; cb < nb; ++cb) {
        nsa_qk(p0, p1, NSA_KB(cb), qr, cvec, r32, hi);
        if (cb * 64 + 64 > nvmin_w) {
#pragma unroll
            for (int r = 0; r < 16; ++r) { const int n0 = cb * 64 + crow(r, hi); p0[r] = n0 < nv ? p0[r] : -INFINITY; p1[r] = n0 + 32 < nv ? p1[r] : -INFINITY; } }
#pragma unroll
        for (int r = 0; r < 16; ++r) { const int n0 = cb * 64 + crow(r, hi);
            p0[r] = __builtin_amdgcn_exp2f(p0[r]); p1[r] = __builtin_amdgcn_exp2f(p1[r]);
            float v0 = p0[r], v1 = p1[r]; v0 += dpp_quad<0xB1>(v0); v1 += dpp_quad<0xB1>(v1); v0 += dpp_quad<0x4E>(v0); v1 += dpp_quad<0x4E>(v1);
            if (h == 0) { PS[qi * 260 + n0] = v0; PS[qi * 260 + n0 + 32] = v1; } }
        bf16x8 pa[4]; nsa_pack(pa, p0, p1);
        { bf16x8 vf[4], vg[4]; nsa_vload(vf, NSA_VB(cb), lane, 0); nsa_vload(vg, NSA_VB(cb), lane, 1); __builtin_amdgcn_sched_barrier(0); nsa_pv(o[0], vf, pa); nsa_pv(o[1], vg, pa); }
    }
    const bf16* ks = (const bf16*)(rc + RC_KV + 2 * 16 * MiB) + (size_t)bg * 4096 * 64; const bf16* vs = (const bf16*)(rc + RC_KV + 3 * 16 * MiB) + (size_t)bg * 4096 * 64;
    const bf16* kw = (const bf16*)(rc + RC_KV + 4 * 16 * MiB) + (size_t)bg * 4096 * 64; const bf16* vw = (const bf16*)(rc + RC_KV + 5 * 16 * MiB) + (size_t)bg * 4096 * 64;
    NSA_LOADK(ks); NSA_LOADV(vs);
    if (cur >= 16) {
        unsigned key[8], thr[8];
#pragma unroll
        for (int qq = 0; qq < 8; ++qq) { const LAS float* pq = PS + qq * 260;
            const f32x4 q4 = *(const LAS f32x4*)(pq + 4 * lane);
            float imp = (q4[0] + q4[1]) + (q4[2] + q4[3]); if (lane > 0) imp += pq[4 * lane - 1];
            const bool forced = (lane == 0) || (lane == cur) || (lane == cur - 1);
            key[qq] = (lane <= cur) ? (forced ? __float_as_uint(1e4f) : __float_as_uint(imp)) + 1u : 0u; thr[qq] = 0u; }
#pragma unroll 1
        for (int bit = 30; bit >= 0; --bit) {
            unsigned long long bm[8];
#pragma unroll
            for (int qq = 0; qq < 8; ++qq) bm[qq] = __ballot(key[qq] >= (thr[qq] | (1u << bit)));
#pragma unroll
            for (int qq = 0; qq < 8; ++qq) { const int cnt = __builtin_popcount((unsigned)bm[qq]) + __builtin_popcount((unsigned)(bm[qq] >> 32)); thr[qq] = cnt >= 16 ? (thr[qq] | (1u << bit)) : thr[qq]; } }
#pragma unroll
        for (int qq = 0; qq < 8; ++qq) { const unsigned long long gt = __ballot(key[qq] > thr[qq]), eq = __ballot(key[qq] == thr[qq]);
            const int kk = 16 - (__builtin_popcount((unsigned)gt) + __builtin_popcount((unsigned)(gt >> 32))); unsigned long long rest = eq;
            for (int i = 0; i < kk; ++i) rest &= rest - 1ull;
            if (lane == 0) MASKS[w * 8 + qq] = gt | (eq ^ rest); }
    } else { if (lane < 8) MASKS[w * 8 + lane] = (2ull << cur) - 1ull; }
    __syncthreads();
    const unsigned long long mym = MASKS[w * 8 + qi];
    unsigned long long um = MASKS[lane];
#pragma unroll
    for (int off = 1; off < 64; off <<= 1) { const unsigned lo_ = __shfl_xor((unsigned)um, off), hi_ = __shfl_xor((unsigned)(um >> 32), off); um |= ((unsigned long long)hi_ << 32) | lo_; }
    um &= (2ull << cur) - 1ull;
    unsigned long long rem = ((unsigned long long)__builtin_amdgcn_readfirstlane((unsigned)(um >> 32)) << 32) | (unsigned)__builtin_amdgcn_readfirstlane((unsigned)um);
    row_bcast(g0, wsf, r32, hi, f16);
#pragma unroll
    for (int r = 0; r < 16; ++r) { PS[(2 * r) * 64 + lane] = o[0][r] * f16[r]; PS[(2 * r + 1) * 64 + lane] = o[1][r] * f16[r]; }
    float mhat = 0.f;
#pragma unroll
    for (int i = 0; i < 16; ++i) { o[0][i] = 0.f; o[1][i] = 0.f; negm[i] = 0.f; }
    lsum = 0.f;
    {
        const int j0w = cur >= 4 ? cur - 4 : 0;
        if (VAR == 6) rem = 0ull;
        int jc = __builtin_ctzll(rem | (1ull << 63)), wc = (VAR == 6) ? 1 : 0, buf = 0; rem &= rem - 1ull; if (VAR == 6) jc = cur;
        if (VAR == 6) { NSA_LOADK(ks + (size_t)jc * 4096); NSA_LOADV(vs + (size_t)jc * 4096); }
        NSA_STOREK(0); NSA_STOREV(0); __syncthreads();
#pragma unroll 1
        for (;;) {
            bool has_next = true; int jn, wn;
            if (wc == 0) { if (rem != 0ull) { jn = __builtin_ctzll(rem); rem &= rem - 1ull; wn = 0; } else { jn = j0w; wn = 1; } }
            else { jn = jc + 1; wn = 1; has_next = jc < cur; }
            if (has_next && VAR != 1) { const bf16* kp = wn ? kw : ks; const bf16* vp = wn ? vw : vs; NSA_LOADK(kp + (size_t)jn * 4096); NSA_LOADV(vp + (size_t)jn * 4096); }
            const bool rv = wc ? true : (((mym >> jc) & 1ull) != 0ull);
            const int diag = (jc == cur) ? 1 : ((wc && jc == cur - 4) ? 2 : 0);
            if (__any(rv)) {
                nsa_qk(p0, p1, NSA_KB(buf), qr, negm, r32, hi);
                nsa_step(VAR, p0, p1, mhat, negm, o, lsum, diag, rv, __all(rv), rel, NSA_VB(buf), wsf, lane, r32, hi); }
            if (has_next && VAR != 1) { NSA_STOREK(buf ^ 1); NSA_STOREV(buf ^ 1); }
            if (VAR != 4) __syncthreads();
            if (has_next && wn != wc) {
                row_bcast(g1 * __builtin_amdgcn_rcpf(swapsum(lsum)), wsf, r32, hi, f16);
#pragma unroll
                for (int r = 0; r < 16; ++r) { const float fc = f16[r]; PS[(2 * r) * 64 + lane] += o[0][r] * fc; PS[(2 * r + 1) * 64 + lane] += o[1][r] * fc; o[0][r] = 0.f; o[1][r] = 0.f; negm[r] = 0.f; }
                mhat = 0.f; lsum = 0.f;
            }
            if (!has_next) break;
            jc = jn; wc = wn; buf ^= 1;
        }
    }
    row_bcast(g2 * __builtin_amdgcn_rcpf(swapsum(lsum)), wsf, r32, hi, f16);
    bf16* outb = outbase + ((size_t)b * SEQ + t0 + 8 * w) * 1024 + 512 + g * 256 + r32;
    if (VAR == 0 || mhat == 12345.678f)
#pragma unroll
    for (int r = 0; r < 16; ++r) { const int rr = crow(r, hi), qo = rr >> 2, ho = rr & 3;
        outb[(size_t)qo * 1024 + ho * 64] = (bf16)f2bf(PS[(2 * r) * 64 + lane] + o[0][r] * f16[r]); outb[(size_t)qo * 1024 + ho * 64 + 32] = (bf16)f2bf(PS[(2 * r + 1) * 64 + lane] + o[1][r] * f16[r]); }
#undef NSA_LOADK
#undef NSA_LOADV
#undef NSA_STOREK
#undef NSA_STOREV
#undef NSA_KB
#undef NSA_VB
}

constexpr int ML_QS = 272, ML_VS = 320;
constexpr int ML_Q_OFF = 0, ML_K_OFF = 64 * ML_QS, ML_V_OFF = 2 * 64 * ML_QS, ML_CT_OFF = ML_V_OFF + 64 * ML_VS, ML_HS_OFF = ML_CT_OFF + 128 * ML_QS, ML_VEC_OFF = ML_HS_OFF + 128 * 65 * 4, ML_END = ML_VEC_OFF + 4096;
static_assert(ML_END <= MISC_OFF && 2 * 67 * 256 <= 128 * ML_QS, "mlstm mfma lds");
__device__ __forceinline__ void conv8(const LAS bf16* raw, int s, int c8, const float* cw, const float* cb, float (&out)[8]) {
    const f32x4 b0 = *(const f32x4*)(cb + c8 * 8), b1 = *(const f32x4*)(cb + c8 * 8 + 4);
    float acc[8] = {b0[0], b0[1], b0[2], b0[3], b1[0], b1[1], b1[2], b1[3]};
#pragma unroll
    for (int j = 0; j < 4; ++j) { float x[8]; unpack8(*(const LAS v4u*)(raw + (s + j) * 128 + c8 * 8), x);
        const f32x4 w0 = *(const f32x4*)(cw + j * 1024 + c8 * 8), w1 = *(const f32x4*)(cw + j * 1024 + c8 * 8 + 4);
        acc[0] += w0[0] * x[0]; acc[1] += w0[1] * x[1]; acc[2] += w0[2] * x[2]; acc[3] += w0[3] * x[3]; acc[4] += w1[0] * x[4]; acc[5] += w1[1] * x[5]; acc[6] += w1[2] * x[6]; acc[7] += w1[3] * x[7]; }
#pragma unroll
    for (int i = 0; i < 8; ++i) out[i] = siluf_(acc[i]);
}
__device__ __forceinline__ void mlstm_gates(const Args& a, Frame& F, int h, size_t row0, LAS float* bcum, LAS float* ig) {
    if (F.wave == 0) { const float* g = (const float*)(a.ws + WS_RC + RC_IF) + (row0 + F.lane) * 8; const float fp = g[4 + h] + a.in[I_GATEB][4 + h];
        ig[F.lane] = g[h] + a.in[I_GATEB][h];
        float v = fminf(fp, 0.f) - log1pf(__expf(-fabsf(fp)));
#pragma unroll
        for (int off = 1; off < 64; off <<= 1) { const float u = __shfl_up(v, off); if (F.lane >= off) v += u; }
        bcum[F.lane] = v; }
}
__device__ __forceinline__ void mlstm_stage_raw(Frame& F, const bf16* src, int b, int h, int t0, LAS bf16* raw) {
    for (int idx = F.tid; idx < 67 * 16; idx += NTHREADS) { const int rr = idx >> 4, c8 = idx & 15, tt = t0 - 3 + rr;
        v4u v = (v4u){0u, 0u, 0u, 0u}; if (tt >= 0) v = *(const v4u*)(src + ((size_t)b * SEQ + tt) * 512 + h * 128 + c8 * 8);
        *(LAS v4u*)(raw + rr * 128 + c8 * 8) = v; }
}
__device__ __forceinline__ void conv8r(const v4u (&tap)[4], int c8, const float* cw, const float* cb, float (&out)[8]) {
    const f32x4 b0 = *(const f32x4*)(cb + c8 * 8), b1 = *(const f32x4*)(cb + c8 * 8 + 4);
    float acc[8] = {b0[0], b0[1], b0[2], b0[3], b1[0], b1[1], b1[2], b1[3]};
#pragma unroll
    for (int j = 0; j < 4; ++j) { float x[8]; unpack8(tap[j], x);
        const f32x4 w0 = *(const f32x4*)(cw + j * 1024 + c8 * 8), w1 = *(const f32x4*)(cw + j * 1024 + c8 * 8 + 4);
        acc[0] += w0[0] * x[0]; acc[1] += w0[1] * x[1]; acc[2] += w0[2] * x[2]; acc[3] += w0[3] * x[3]; acc[4] += w1[0] * x[4]; acc[5] += w1[1] * x[5]; acc[6] += w1[2] * x[6]; acc[7] += w1[3] * x[7]; }
#pragma unroll
    for (int i = 0; i < 8; ++i) out[i] = siluf_(acc[i]);
}
__device__ __forceinline__ void load_taps(v4u (&tap)[4], const bf16* src, int b, int h, int t0, int s, int c8) {
#pragma unroll
    for (int j = 0; j < 4; ++j) { const int tt = t0 + s - 3 + j; tap[j] = (v4u){0u, 0u, 0u, 0u}; if (tt >= 0) tap[j] = *(const v4u*)(src + ((size_t)b * SEQ + tt) * 512 + h * 128 + c8 * 8); }
}
__device__ __forceinline__ void mlstm_gates_lane(const Args& a, int h, size_t row0, int lane, float& igv, float& bc) {
    const float* g = (const float*)(a.ws + WS_RC + RC_IF) + (row0 + lane) * 8; const float fp = g[4 + h] + a.in[I_GATEB][4 + h];
    igv = g[h] + a.in[I_GATEB][h];
    float v = fminf(fp, 0.f) - log1pf(__expf(-fabsf(fp)));
#pragma unroll
    for (int off = 1; off < 64; off <<= 1) { const float u = __shfl_up(v, off); if (lane >= off) v += u; }
    bc = v;
}
__device__ __forceinline__ void mlstm_local_mfma(const Args& a, Frame& F, int pair) {
    const int unit0 = 2 * pair, c0 = unit0 & 63, h = (unit0 >> 6) & 3, b = unit0 >> 8, lane = F.lane, w = F.wave, hi = lane >> 5, r32 = lane & 31;
    unsigned char* rc = a.ws + WS_RC;
    constexpr int LPB = 2 * 64 * ML_VS;
    v4u tk[2][2][4], vv[2][2]; float g0[2], g1[2];
#pragma unroll
    for (int j = 0; j < 2; ++j) { const int t0 = (c0 + j) * CHUNK; const size_t row0 = (size_t)b * SEQ + t0;
#pragma unroll
        for (int u = 0; u < 2; ++u) { const int it = F.tid + u * NTHREADS, s = it >> 4, c8 = it & 15;
            load_taps(tk[j][u], (const bf16*)(rc + RC_KM), b, h, t0, s, c8);
            vv[j][u] = *(const v4u*)((const bf16*)(rc + RC_VM) + (row0 + s) * 512 + h * 128 + c8 * 8); }
        const float* g = (const float*)(rc + RC_IF) + (row0 + lane) * 8; g0[j] = g[h]; g1[j] = g[4 + h]; }
    float wvv[2];
#pragma unroll
    for (int j = 0; j < 2; ++j) { const float fp = g1[j] + a.in[I_GATEB][4 + h], igv = g0[j] + a.in[I_GATEB][h];
        float v = fminf(fp, 0.f) - log1pf(__expf(-fabsf(fp)));
#pragma unroll
        for (int off = 1; off < 64; off <<= 1) { const float u = __shfl_up(v, off); if (lane >= off) v += u; }
        const float bc = v, blast = __shfl(bc, 63), gv = blast - bc + igv, mloc = wave_max(gv); wvv[j] = __expf(gv - mloc);
        if (F.tid == 0) { float* cs = (float*)(a.ws + WS_CSC) + (size_t)(unit0 + j) * 2; cs[0] = blast; cs[1] = mloc; } }
    __syncthreads();
    { const float* cw = a.in[I_CONVW] + 512 + h * 128; const float* cb = a.in[I_CONVB] + 512 + h * 128;
#pragma unroll
      for (int j = 0; j < 2; ++j) { LAS unsigned char* LK = F.lds + j * LPB; LAS unsigned char* LV = LK + 64 * ML_VS;
#pragma unroll
        for (int u = 0; u < 2; ++u) { const int it = F.tid + u * NTHREADS, s = it >> 4, c8 = it & 15; float k8[8]; conv8r(tk[j][u], c8, cw, cb, k8);
          const float sc = 0.08838834764831845f * __shfl(wvv[j], s & 63);
          v4u o; o.x = pk2(k8[0] * sc, k8[1] * sc); o.y = pk2(k8[2] * sc, k8[3] * sc); o.z = pk2(k8[4] * sc, k8[5] * sc); o.w = pk2(k8[6] * sc, k8[7] * sc);
          *(LAS v4u*)(LK + s * ML_VS + c8 * 16) = o; *(LAS v4u*)(LV + s * ML_VS + c8 * 16) = vv[j][u]; } } }
    __syncthreads();
    if (F.tid < 256) { const int j = F.tid >> 7, col = F.tid & 127; const LAS unsigned char* LK = F.lds + j * LPB; float sacc = 0.f;
#pragma unroll
        for (int s = 0; s < 64; ++s) sacc += bf2f(*(const LAS bf16*)(LK + s * ML_VS + col * 2));
        ((float*)(a.ws + WS_NST))[(size_t)(unit0 + j) * 128 + col] = sacc; }
    const int et = w >> 1, dt0 = (w & 1) * 2, blk = (lane >> 4) & 1, q = (lane & 15) >> 2, p = lane & 3;
#pragma unroll
    for (int j = 0; j < 2; ++j) { const LAS unsigned char* LK = F.lds + j * LPB; const LAS unsigned char* LV = LK + 64 * ML_VS;
        f32x16 acc[2];
#pragma unroll
        for (int i = 0; i < 16; ++i) { acc[0][i] = 0.f; acc[1][i] = 0.f; }
        const LAS unsigned char* abase = LV + (8 * hi + q) * ML_VS + (et * 32 + 16 * blk + 4 * p) * 2;
        const LAS unsigned char* bbase = LK + (8 * hi + q) * ML_VS + (dt0 * 32 + 16 * blk + 4 * p) * 2;
#pragma unroll
        for (int ks = 0; ks < 4; ++ks) { const s16x4 a0 = vtr(abase + ks * 16 * ML_VS), a1 = vtr(abase + (ks * 16 + 4) * ML_VS);
            const bf16x8 af = (bf16x8){a0[0], a0[1], a0[2], a0[3], a1[0], a1[1], a1[2], a1[3]};
#pragma unroll
            for (int n = 0; n < 2; ++n) { const s16x4 b0 = vtr(bbase + ks * 16 * ML_VS + n * 64), b1 = vtr(bbase + (ks * 16 + 4) * ML_VS + n * 64);
                const bf16x8 bfr = (bf16x8){b0[0], b0[1], b0[2], b0[3], b1[0], b1[1], b1[2], b1[3]};
                acc[n] = __builtin_amdgcn_mfma_f32_32x32x16_bf16(af, bfr, acc[n], 0, 0, 0); } }
        bf16* st = (bf16*)(a.ws + WS_RB) + (size_t)(unit0 + j) * 16384;
#pragma unroll
        for (int n = 0; n < 2; ++n)
#pragma unroll
            for (int r = 0; r < 16; ++r) st[(et * 32 + crow(r, hi)) * 128 + (dt0 + n) * 32 + r32] = (bf16)f2bf(acc[n][r]); }
}
__device__ __forceinline__ void mlstm_out_load(const Args& a, Frame& F, int unit, v4u (&tq)[2][4], v4u (&tk)[2][4], v4u (&vv)[2], float& nvr, float& mp, float& g0, float& g1) {
    const int c = unit & 63, h = (unit >> 6) & 3, b = unit >> 8, t0 = c * CHUNK;
    const size_t row0 = (size_t)b * SEQ + t0;
    unsigned char* rc = a.ws + WS_RC;
#pragma unroll
    for (int u = 0; u < 2; ++u) { const int it = F.tid + u * NTHREADS, s = it >> 4, c8 = it & 15;
        load_taps(tq[u], (const bf16*)(rc + RC_QM), b, h, t0, s, c8); load_taps(tk[u], (const bf16*)(rc + RC_KM), b, h, t0, s, c8);
        vv[u] = *(const v4u*)((const bf16*)(rc + RC_VM) + (row0 + s) * 512 + h * 128 + c8 * 8); }
    nvr = 0.f; if (F.tid < 128) nvr = ((const float*)(a.ws + WS_NST))[(size_t)unit * 128 + F.tid];
    mp = ((const float*)(a.ws + WS_MPREV))[unit];
    g0 = 0.f; g1 = 0.f; if (F.wave == 0) { const float* g = (const float*)(rc + RC_IF) + (row0 + F.lane) * 8; g0 = g[h]; g1 = g[4 + h]; }
}
__device__ __forceinline__ void mlstm_out_mfma(const Args& a, Frame& F, int unit, int next_unit, v4u (&tq)[2][4], v4u (&tk)[2][4], v4u (&vv)[2], float& nvr_io, float& mp_io, float& g0_io, float& g1_io) {
    const int c = unit & 63, h = (unit >> 6) & 3, b = unit >> 8, t0 = c * CHUNK, lane = F.lane, w = F.wave, hi = lane >> 5, r32 = lane & 31;
    const size_t row0 = (size_t)b * SEQ + t0;
    unsigned char* rc = a.ws + WS_RC;
    LAS unsigned char* QB = F.lds + ML_Q_OFF; LAS unsigned char* KB = F.lds + ML_K_OFF; LAS unsigned char* VB = F.lds + ML_V_OFF;
    LAS float* HS = (LAS float*)(F.lds + ML_HS_OFF);
    LAS float* bcum = (LAS float*)(F.lds + ML_VEC_OFF); LAS float* ig = bcum + 64; LAS float* nv = bcum + 192; LAS float* ssq = bcum + 320;
    const bf16* ctg = (const bf16*)(a.ws + WS_RB) + (size_t)unit * 16384;
    const int te = F.tid >> 3, e0 = (F.tid & 7) * 16;
    const float nvr = nvr_io, mp = mp_io;
    float igv = 0.f, bc = 0.f;
    if (w == 0) { const float fp = g1_io + a.in[I_GATEB][4 + h]; igv = g0_io + a.in[I_GATEB][h];
        float v = fminf(fp, 0.f) - log1pf(__expf(-fabsf(fp)));
#pragma unroll
        for (int off = 1; off < 64; off <<= 1) { const float u = __shfl_up(v, off); if (lane >= off) v += u; }
        bc = v; }
    __syncthreads();
    if (w == 0) { ig[lane] = igv - bc; bcum[lane] = bc; }
    if (F.tid < 128) nv[F.tid] = nvr;
    { const float* cwq = a.in[I_CONVW] + h * 128; const float* cbq = a.in[I_CONVB] + h * 128;
#pragma unroll
      for (int u = 0; u < 2; ++u) { const int it = F.tid + u * NTHREADS, s = it >> 4, c8 = it & 15; float x8[8];
          conv8r(tq[u], c8, cwq, cbq, x8);
          v4u o; o.x = pk2(x8[0], x8[1]); o.y = pk2(x8[2], x8[3]); o.z = pk2(x8[4], x8[5]); o.w = pk2(x8[6], x8[7]);
          *(LAS v4u*)(QB + s * ML_QS + c8 * 16) = o;
          conv8r(tk[u], c8, cwq + 512, cbq + 512, x8); const float sc = 0.08838834764831845f;
          o.x = pk2(x8[0] * sc, x8[1] * sc); o.y = pk2(x8[2] * sc, x8[3] * sc); o.z = pk2(x8[4] * sc, x8[5] * sc); o.w = pk2(x8[6] * sc, x8[7] * sc);
          *(LAS v4u*)(KB + s * ML_QS + c8 * 16) = o;
          *(LAS v4u*)(VB + s * ML_VS + c8 * 16) = vv[u]; } }
    __syncthreads();
    const int et = w & 3, tt = w >> 2, t = tt * 32 + r32, blk = (lane >> 4) & 1, q = (lane & 15) >> 2, p = lane & 3;
    bf16x8 cf[8];
#pragma unroll
    for (int d0 = 0; d0 < 8; ++d0) cf[d0] = *(const bf16x8*)(ctg + (et * 32 + r32) * 128 + d0 * 16 + hi * 8);
    v4u omr[2]; { const bf16* om = (const bf16*)(rc + RC_OM) + (row0 + te) * 512 + h * 128 + e0; omr[0] = *(const v4u*)om; omr[1] = *(const v4u*)(om + 8); }

    bf16x8 qf[8];
#pragma unroll
    for (int d0 = 0; d0 < 8; ++d0) qf[d0] = *(const LAS bf16x8*)(QB + t * ML_QS + d0 * 32 + hi * 16);
    float qn = 0.f;
#pragma unroll
    for (int d0 = 0; d0 < 8; ++d0) { float x[8]; unpack8(__builtin_bit_cast(v4u, qf[d0]), x); const f32x4 n0 = *(const LAS f32x4*)(nv + d0 * 16 + hi * 8), n1 = *(const LAS f32x4*)(nv + d0 * 16 + hi * 8 + 4);
        qn += x[0] * n0[0] + x[1] * n0[1] + x[2] * n0[2] + x[3] * n0[3] + x[4] * n1[0] + x[5] * n1[1] + x[6] * n1[2] + x[7] * n1[3]; }
    qn = swapsum(qn);
    f32x16 p0, p1;
#pragma unroll
    for (int i = 0; i < 16; ++i) { p0[i] = 0.f; p1[i] = 0.f; }
#pragma unroll
    for (int hf = 0; hf < 2; ++hf) { bf16x8 kf[8];
#pragma unroll
        for (int dd = 0; dd < 4; ++dd) { const int d0 = hf * 4 + dd; kf[2 * dd] = *(const LAS bf16x8*)(KB + r32 * ML_QS + d0 * 32 + hi * 16); kf[2 * dd + 1] = *(const LAS bf16x8*)(KB + (32 + r32) * ML_QS + d0 * 32 + hi * 16); }
        __builtin_amdgcn_sched_barrier(0);
#pragma unroll
        for (int dd = 0; dd < 4; ++dd) { const int d0 = hf * 4 + dd; p0 = __builtin_amdgcn_mfma_f32_32x32x16_bf16(kf[2 * dd], qf[d0], p0, 0, 0, 0); p1 = __builtin_amdgcn_mfma_f32_32x32x16_bf16(kf[2 * dd + 1], qf[d0], p1, 0, 0, 0); } }
    const float bt = bcum[t], at = bt + mp;
    float mt = at;
#pragma unroll
    for (int r = 0; r < 16; ++r) { const int s0 = crow(r, hi), s1 = s0 + 32; const float a0 = ig[s0], a1 = ig[s1];
        if (s0 <= t) mt = fmaxf(mt, bt + a0); if (s1 <= t) mt = fmaxf(mt, bt + a1); }
    mt = swapmax(mt);
    float sden = 0.f;
#pragma unroll
    for (int r = 0; r < 16; ++r) { const int s0 = crow(r, hi), s1 = s0 + 32; const float a0 = ig[s0], a1 = ig[s1];
        p0[r] = s0 <= t ? p0[r] * __expf(bt + a0 - mt) : 0.f; p1[r] = s1 <= t ? p1[r] * __expf(bt + a1 - mt) : 0.f; sden += p0[r] + p1[r]; }
    sden = swapsum(sden);
    const float wi = __expf(at - mt), den = sden + wi * qn, dn = fmaxf(fabsf(den), __expf(-mt));
    bf16x8 pa[4]; nsa_pack(pa, p0, p1);
    f32x16 acc, acc2;
#pragma unroll
    for (int i = 0; i < 16; ++i) { acc[i] = 0.f; acc2[i] = 0.f; }
    { const LAS unsigned char* vbase = VB + (4 * hi + q) * ML_VS + (et * 32 + 16 * blk + 4 * p) * 2;
#pragma unroll
      for (int ks = 0; ks < 4; ++ks) { const s16x4 a0 = vtr(vbase + ks * 16 * ML_VS), a1 = vtr(vbase + (ks * 16 + 8) * ML_VS);
          const bf16x8 af = (bf16x8){a0[0], a0[1], a0[2], a0[3], a1[0], a1[1], a1[2], a1[3]};
          acc = __builtin_amdgcn_mfma_f32_32x32x16_bf16(af, pa[ks], acc, 0, 0, 0); } }
#pragma unroll
    for (int d0 = 0; d0 < 8; ++d0) acc2 = __builtin_amdgcn_mfma_f32_32x32x16_bf16(cf[d0], qf[d0], acc2, 0, 0, 0);
    float ss = 0.f; const float rdn = 1.f / dn;
#pragma unroll
    for (int r = 0; r < 16; ++r) { const float hv = (acc[r] + wi * acc2[r]) * rdn; ss += hv * hv; HS[(et * 32 + crow(r, hi)) * 65 + t] = hv; }
    ss = swapsum(ss);
    if (hi == 0) ssq[et * 64 + t] = ss;
    __builtin_amdgcn_sched_barrier(0);
    mlstm_out_load(a, F, next_unit < 4096 ? next_unit : unit, tq, tk, vv, nvr_io, mp_io, g0_io, g1_io);
    __builtin_amdgcn_sched_barrier(0);
    __syncthreads();
    { const float rstd = rsqrtf((ssq[te] + ssq[64 + te] + ssq[128 + te] + ssq[192 + te]) * (1.f / 128.f) + EPS);
      const size_t row = row0 + te; const int ch = h * 128 + e0; const LAS float* hgl = (const LAS float*)(F.lds + ML_CT_OFF);
      float o[16], og[16]; unpack8(omr[0], *(float(*)[8])&og[0]); unpack8(omr[1], *(float(*)[8])&og[8]);
#pragma unroll
      for (int i = 0; i < 16; ++i) o[i] = sigmoidf_(og[i]) * HS[(e0 + i) * 65 + te] * rstd * hgl[ch + i];
      bf16* hm = (bf16*)(a.ws + WS_RA) + row * 1024 + ch;
#pragma unroll
      for (int i = 0; i < 16; i += 8) { v4u wv4; wv4.x = pk2(o[i], o[i + 1]); wv4.y = pk2(o[i + 2], o[i + 3]); wv4.z = pk2(o[i + 4], o[i + 5]); wv4.w = pk2(o[i + 6], o[i + 7]); *(v4u*)(hm + i) = wv4; } }
}

__global__ void __launch_bounds__(NTHREADS, 2) mk_fwd(Args args) {
    extern __shared__ __attribute__((aligned(16))) unsigned char lds[];
    Frame F;
    F.lds = (LAS unsigned char*)lds;
    F.tid = threadIdx.x; F.lane = F.tid & 63; F.wave = __builtin_amdgcn_readfirstlane(F.tid >> 6);
    F.G = gridDim.x; { const int bx = blockIdx.x; F.vcu = (F.G % 8 == 0) ? (bx % 8) * (F.G / 8) + bx / 8 : bx; }
    volatile LAS unsigned* MISC = (volatile LAS unsigned*)(F.lds + MISC_OFF);
    if (F.tid < 64) MISC[F.tid] = 0u;
    __syncthreads();
    unsigned char* ws = args.ws;
    gu32* ctl = (gu32*)(ws + WS_CTL);
    XcdBarrier bar; bar.bar = (unsigned*)ctl + CW_BAR; bar.x = 0; bar.st = nullptr;
    if (MK_N_LAUNCHES == 1) bar = xcd_barrier_post((unsigned*)ctl + CW_BAR, MISC + 8);
    const int lo = args.ph_lo, hi = args.ph_hi;
#define IN(k) (lo <= (k) && (k) < hi)
#define SEAM(k) do { if (IN(k) && IN((k) + 1)) xcd_barrier(bar); } while (0)
    bf16* U = (bf16*)(ws + WS_RA); bf16* Fb = (bf16*)(ws + WS_RB); bf16* HID = (bf16*)(ws + WS_RC);
    PG8_LAS unsigned char* ring = (PG8_LAS unsigned char*)lds;

    if (IN(0)) { p0_prologue(args, F); } SEAM(0);
    if (IN(1)) { thin_phase<0, false, false, true>(args, F, args.in[I_X], nullptr, nullptr, U, 0, 0, 0.f);
        { LAS unsigned* scr = (LAS unsigned*)(F.lds + F.wave * 16384); const int gw = F.vcu * NWAVES + F.wave, NGW = F.G * NWAVES; constexpr int I_Q = (DM / 64) * (NPROJ / 64);
          const unsigned* am = (const unsigned*)(ws + WS_CTL) + CW_AMAX;
          for (int it = gw; it < 3 * I_Q; it += NGW) { const int layer = it / I_Q, r = it - layer * I_Q;
              if (layer < 2) quant_item_i8<0>(args, layer, DM, NPROJ, (unsigned char*)(ws + WS_W1T) + (size_t)layer * NPROJ * DM, am, (float*)(ws + WS_CS1) + layer * NPROJ, scr, r, F.lane);
              else quant_item_i8<2>(args, 0, DM, NPROJ, (unsigned char*)(ws + WS_WIN), am, (float*)(ws + WS_CS1) + 2 * NPROJ, scr, r, F.lane); } }
    } SEAM(1);
    if (IN(2)) { pg8::Gemm g{U, (const bf16*)(ws + WS_W1T), T, NPROJ, DM / 2, DM / 2, DM / 2, 0}; pg8::StaticOrder S; S.init(T, NPROJ, F.G, (int)blockIdx.x);
        pg8::EpiSwiGLUI8<DOWN_F8_0> E{(unsigned char*)HID, (const float*)(ws + WS_RS), (const float*)(ws + WS_CS1)}; pg8::gemm_phase<pg8::EpiSwiGLUI8<DOWN_F8_0>, pg8::StaticOrder, true, true, false, 0x7f7f7f7f, 0x7f7f7f7f, true>(ring, g, S, E); } SEAM(2);
    if (IN(3)) { pg8::StaticOrder S; S.init(T, DM, F.G, (int)blockIdx.x); pg8::EpiStore E{Fb, DM}; const bf16* wd = (const bf16*)(ws + WS_W1D);
        if constexpr (DOWN_F8_0) { pg8::Gemm g{HID, wd, T, DM, DFF / 2, DFF / 2, DFF / 2, 0}; pg8::gemm_phase<pg8::EpiStore, pg8::StaticOrder, true, true, true, 0x75757575, 0x7c7c7c7c>(ring, g, S, E); }
        else { pg8::Gemm g{HID, wd, T, DM, DFF, DFF, DFF, 0}; pg8::gemm_phase<pg8::EpiStore, pg8::StaticOrder, true, true>(ring, g, S, E); } } SEAM(3);
    if (IN(4)) { thin_phase<1, false, true, true>(args, F, args.in[I_X], Fb, args.out, U, 0, 1, 0.5f); } SEAM(4);
    if (IN(5)) { pg8::Gemm g{U, (const bf16*)(ws + WS_WIN), T, NPROJ, DM / 2, DM / 2, DM / 2, 0}; pg8::StaticOrder S; S.init(T, NPROJ, F.G, (int)blockIdx.x);
        pg8::EpiProj E{ws + WS_RC, (const float*)(ws + WS_RS), (const float*)(ws + WS_CS1) + 2 * NPROJ}; pg8::gemm_phase<pg8::EpiProj, pg8::StaticOrder, true, true, false, 0x7f7f7f7f, 0x7f7f7f7f, true>(ring, g, S, E); } SEAM(5);
    if (IN(6)) {
        const int bx = (int)blockIdx.x;
        if (bx < 128) { const int kv = bx >> 6; pg8::Gemm g{(const bf16*)(ws + WS_RC + RC_KV + (size_t)kv * 16 * MiB), (const bf16*)(ws + WS_WC1) + (size_t)kv * 512 * 1024, 8192, 512, 1024, 1024, 1024, 0};
            pg8::StaticOrder S; S.init(8192, 512, 64, bx & 63);
            pg8::EpiStoreF32 E{(float*)(ws + WS_RA) + (size_t)kv * 8192 * 512, 512}; pg8::gemm_phase<pg8::EpiStoreF32, pg8::StaticOrder, false, true>(ring, g, S, E); }
        __syncthreads();
#ifdef MLSTM_REF
        for (;;) { if (F.tid == 0) MISC[16] = atomicAdd((unsigned*)ctl + CW_QUEUE, 1u); __syncthreads(); const unsigned unit = MISC[16]; __syncthreads(); if (unit >= 4096u) break; mlstm_local_unit(args, F, (int)unit); }
#else
        { unsigned ticket = 0u; if (F.tid == 0) ticket = atomicAdd((unsigned*)ctl + CW_QUEUE, 1u);
          for (;;) { unsigned nxt = 0u;
              if (F.tid == 0) { MISC[16] = ticket; nxt = atomicAdd((unsigned*)ctl + CW_QUEUE, 1u); }
              __syncthreads(); const unsigned unit = MISC[16]; __syncthreads(); if (unit >= 2048u) break;
              mlstm_local_mfma(args, F, (int)unit); ticket = nxt; } }
#endif
    } SEAM(6);
    if (IN(7)) {
#ifdef PROBE_P7_PART
        if (!(hi - lo == 1 && PROBE_P7_PART == 2)) mlstm_scan(args, F);
        if (!(hi - lo == 1 && PROBE_P7_PART == 1)) compress_l2(args, F);
#else
        mlstm_scan(args, F); compress_l2(args, F);
#endif
    } SEAM(7);
    if (IN(8)) {
#ifdef MLSTM_REF
        for (int unit = F.vcu; unit < 4096; unit += F.G) mlstm_out_unit(args, F, unit);
#else
#ifdef PROBE_P8_PART
        if (!(hi - lo == 1 && PROBE_P8_PART == 2))
#endif
        { v4u tq[2][4], tk[2][4], vv[2]; float nvr = 0.f, mp = 0.f, g0 = 0.f, g1 = 0.f;
          ((LAS float*)(F.lds + ML_CT_OFF))[F.tid] = args.in[I_HGAIN][F.tid];
          if (F.vcu < 4096) mlstm_out_load(args, F, F.vcu, tq, tk, vv, nvr, mp, g0, g1);
          for (int unit = F.vcu; unit < 4096; unit += F.G) mlstm_out_mfma(args, F, unit, unit + F.G, tq, tk, vv, nvr, mp, g0, g1); }
#endif
        __syncthreads();
#ifdef NSA_DEBUG
        xcd_barrier(bar);
        for (int pidx = F.vcu; pidx < 1024; pidx += F.G) { const int bg = pidx >> 5, i = ((pidx >> 8) & 1) ? 31 - (pidx & 31) : (pidx & 31);
            nsa_unit(0, args, F, bg, 63 - i, (bf16*)(ws + WS_RC + RC_QM)); nsa_unit(0, args, F, bg, i, (bf16*)(ws + WS_RC + RC_QM)); }
        __syncthreads();
        { LAS float* wl = (LAS float*)(F.lds + F.wave * 4096); const int gw = F.vcu * NWAVES + F.wave, NGW = F.G * NWAVES;
          for (int q = gw; q < NB * NG * SEQ; q += NGW) nsa_query(args, F, q, wl); }
        xcd_barrier(bar);
        { const bf16* A = (const bf16*)(ws + WS_RA + 64 * MiB); const bf16* B = (const bf16*)(ws + WS_RC + RC_QM); float sd = 0.f, sa = 0.f;
          for (size_t i = (size_t)F.vcu * NTHREADS + F.tid; i < (size_t)T * 512; i += (size_t)F.G * NTHREADS) { const float x = bf2f(A[i]), y = bf2f(B[i]); sd += (x - y) * (x - y); sa += x * x; }
          sd = wave_sum(sd); sa = wave_sum(sa);
          if (F.lane == 0) { atomicAdd((float*)ctl + 80, sd); atomicAdd((float*)ctl + 81, sa); } }
#else
#ifdef PROBE_P8_PART
        if (!(hi - lo == 1 && PROBE_P8_PART == 1))
#endif
#ifdef PROBE_NSA_VAR
        { const int var = (hi - lo == 1) ? PROBE_NSA_VAR : 0;
        for (int pidx = F.vcu; pidx < 1024; pidx += F.G) { const int bg = pidx >> 5, i = ((pidx >> 8) & 1) ? 31 - (pidx & 31) : (pidx & 31);
            nsa_unit(var, args, F, bg, 63 - i, (bf16*)(ws + WS_RA)); nsa_unit(var, args, F, bg, i, (bf16*)(ws + WS_RA)); } }
#else
        for (int pidx = F.vcu; pidx < 1024; pidx += F.G) { const int bg = pidx >> 5, i = ((pidx >> 8) & 1) ? 31 - (pidx & 31) : (pidx & 31);
            nsa_unit(0, args, F, bg, 63 - i, (bf16*)(ws + WS_RA)); nsa_unit(0, args, F, bg, i, (bf16*)(ws + WS_RA)); }
#endif
#endif
    } SEAM(8);
    if (IN(9)) { pg8::Gemm g{(const bf16*)(ws + WS_RA), (const bf16*)(ws + WS_WUPM), T, DM, 512, 1024, 1024, 1024}; pg8::SegOrder S; S.init(T, DM, F.G, (int)blockIdx.x);
        pg8::EpiMergeFused E{(bf16*)(ws + WS_RC + RC_MERGED), (const bf16*)(ws + WS_RC + RC_GM), (const bf16*)(ws + WS_RC + RC_GN)};
        pg8::gemm_phase<pg8::EpiMergeFused, pg8::SegOrder, true, true>(ring, g, S, E); } SEAM(9);
    if (IN(10)) { pg8::Gemm g{(const bf16*)(ws + WS_RC + RC_MERGED), (const bf16*)(ws + WS_WOUT), T, DM, DM, DM, DM, 0}; pg8::StaticOrder S; S.init(T, DM, F.G, (int)blockIdx.x);
        pg8::EpiStore E{Fb, DM}; pg8::gemm_phase<pg8::EpiStore, pg8::StaticOrder, true, true>(ring, g, S, E); } SEAM(10);
    if (IN(11)) { thin_phase<1, true, true, true>(args, F, args.out, Fb, ws + WS_RC + 512 * MiB, U, 1, 2, 1.0f); } SEAM(11);
    if (IN(12)) { pg8::Gemm g{U, (const bf16*)(ws + WS_W1T + (size_t)NPROJ * DM), T, NPROJ, DM / 2, DM / 2, DM / 2, 0}; pg8::StaticOrder S; S.init(T, NPROJ, F.G, (int)blockIdx.x);
        pg8::EpiSwiGLUI8<DOWN_F8_1> E{(unsigned char*)HID, (const float*)(ws + WS_RS), (const float*)(ws + WS_CS1) + NPROJ}; pg8::gemm_phase<pg8::EpiSwiGLUI8<DOWN_F8_1>, pg8::StaticOrder, true, true, false, 0x7f7f7f7f, 0x7f7f7f7f, true>(ring, g, S, E); } SEAM(12);
    if (IN(13)) { pg8::StaticOrder S; S.init(T, DM, F.G, (int)blockIdx.x); pg8::EpiStore E{Fb, DM}; const bf16* wd = (const bf16*)(ws + WS_W1D) + (size_t)DM * DFF;
        if constexpr (DOWN_F8_1) { pg8::Gemm g{HID, wd, T, DM, DFF / 2, DFF / 2, DFF / 2, 0}; pg8::gemm_phase<pg8::EpiStore, pg8::StaticOrder, true, true, true, 0x75757575, 0x7c7c7c7c>(ring, g, S, E); }
        else { pg8::Gemm g{HID, wd, T, DM, DFF, DFF, DFF, 0}; pg8::gemm_phase<pg8::EpiStore, pg8::StaticOrder, true, true>(ring, g, S, E); } } SEAM(13);
    if (IN(14)) { thin_phase<2, true, false>(args, F, ws + WS_RC + 512 * MiB, Fb, args.out, nullptr, 2, 0, 0.5f);
#ifdef NSA_DEBUG
        __syncthreads();
        { const float sd = __hip_atomic_load((float*)ctl + 80, RLX_AGENT), sa = __hip_atomic_load((float*)ctl + 81, RLX_AGENT); float rel = sqrtf(sd / fmaxf(sa, 1e-30f)); rel = (rel == rel) ? fminf(rel, 4.f) : 8.f;
          const int gw = F.vcu * NWAVES + F.wave, NGW = F.G * NWAVES;
          for (int row = gw; row < T; row += NGW) for (int j = 0; j < 4; ++j) { f32x4* p = (f32x4*)(args.out + (size_t)row * DM + 256 * j + 4 * F.lane); *p = *p * (1.f + rel); } }
#endif
    }
#undef IN
#undef SEAM
}

extern "C" void kernel_launch(void* const* d_in, const int* in_sizes, int n_in, void* d_out, int out_size, void* d_ws, size_t ws_size, hipStream_t stream) {
    static int grid = 0;
    if (grid == 0) {
        if (n_in != 21 || in_sizes[0] != T * DM || out_size != T * DM || ws_size < WS_END) { fprintf(stderr, "kernel_launch: unexpected shapes (n_in %d, in0 %d, out %d, ws %zu, need %zu)\n", n_in, n_in > 0 ? in_sizes[0] : -1, out_size, ws_size, (size_t)WS_END); grid = -1; return; }
        int dev = 0, cus = 0;
        if (hipGetDevice(&dev) != hipSuccess || hipDeviceGetAttribute(&cus, hipDeviceAttributeMultiprocessorCount, dev) != hipSuccess) { grid = -1; return; }
        if (hipFuncSetAttribute((const void*)mk_fwd, hipFuncAttributeMaxDynamicSharedMemorySize, LDS_BYTES) != hipSuccess) { fprintf(stderr, "kernel_launch: hipFuncSetAttribute failed\n"); grid = -1; return; }
        int per_cu = 0;
        if (hipOccupancyMaxActiveBlocksPerMultiprocessor(&per_cu, (const void*)mk_fwd, NTHREADS, LDS_BYTES) != hipSuccess || per_cu < 1) fprintf(stderr, "kernel_launch: occupancy query reports %d\n", per_cu);
        (void)hipGetLastError();
        grid = cus;
    }
    if (grid < 0) return;
    if (hipMemsetAsync((char*)d_ws + WS_CTL, 0, CTL_ZERO_BYTES, stream) != hipSuccess) return;
    Args a{};
    for (int i = 0; i < 21; ++i) a.in[i] = (const float*)d_in[i];
    a.out = (float*)d_out; a.ws = (unsigned char*)d_ws;
    if (MK_N_LAUNCHES == 1) { a.ph_lo = 0; a.ph_hi = NPHASE; hipLaunchKernelGGL(mk_fwd, dim3(grid), dim3(NTHREADS), LDS_BYTES, stream, a);
#ifdef PROBE_PHASE
        for (int r = 0; r < PROBE_REPS; ++r) { if (PROBE_PHASE == 6) hipMemsetAsync((char*)d_ws + WS_CTL + CW_QUEUE * 4, 0, 4, stream);
            a.ph_lo = PROBE_PHASE; a.ph_hi = PROBE_PHASE + 1; hipLaunchKernelGGL(mk_fwd, dim3(grid), dim3(NTHREADS), LDS_BYTES, stream, a); }
#endif
    }
    else for (int li = 0; li < NPHASE; ++li) { a.ph_lo = li; a.ph_hi = li + 1; hipLaunchKernelGGL(mk_fwd, dim3(grid), dim3(NTHREADS), LDS_BYTES, stream, a); }
}
```
